# Optimizing an MI355X kernel written in HIP

```python
import jax, jax.numpy as jnp
from jax import lax
import numpy as np


D_MODEL = 2048
BATCH = 2
SEQ = 4096
DEPTH = 2

HEAD_DIM = 128
N_HEADS = 4
BRANCH_WIDTH = N_HEADS * HEAD_DIM
N_BRANCHES = 4
MOBA_BLOCK = 256
MOBA_TOPK = 3
MOBA_Q_CHUNK = 64
FOX_Q_BLOCK = 128
HGRN_CHUNK = 64
POOL_WINDOWS = (2, 4, 8, 16)
POOL_GROUP_DIM = BRANCH_WIDTH // 4
ROPE_THETA = 10000.0
MLP_HIDDEN = 4 * D_MODEL
N_MEM = 256
N_XA_HEADS = 4
XA_HEAD_DIM = 128
NORM_EPS = 1e-6
MASK_VALUE = -1e30
IN_SIZES = (BRANCH_WIDTH,) * 3 + (BRANCH_WIDTH,) * 3 + (N_HEADS,) + (BRANCH_WIDTH,) * 4 + (BRANCH_WIDTH,) + (N_BRANCHES * D_MODEL,)
D_IN = sum(IN_SIZES)

kernel_name = 'hybrid_gated_moba_fox_hgrn2_pool'


def rms_norm(x, g):
    xf = x.astype(jnp.float32)
    y = xf * lax.rsqrt(jnp.mean(xf * xf, axis=-1, keepdims=True) + NORM_EPS)
    return (y * g.astype(jnp.float32)).astype(x.dtype)


def split_heads(y, n):
    B, T, W = y.shape
    return y.reshape(B, T, n, W // n).transpose(0, 2, 1, 3)


def merge_heads(y):
    B, H, T, D = y.shape
    return y.transpose(0, 2, 1, 3).reshape(B, T, H * D)


def rope(x):
    T, D = x.shape[2], x.shape[3]
    half = D // 2
    inv_freq = ROPE_THETA ** (-jnp.arange(half, dtype=jnp.float32) * 2.0 / D)
    ang = jnp.arange(T, dtype=jnp.float32)[:, None] * inv_freq[None, :]
    cos, sin = jnp.cos(ang), jnp.sin(ang)
    xf = x.astype(jnp.float32)
    x1, x2 = xf[..., :half], xf[..., half:]
    return jnp.concatenate([x1 * cos - x2 * sin, x2 * cos + x1 * sin], axis=-1).astype(x.dtype)


def moba_attention(q, k, v):
    B, H, T, D = q.shape
    q, k = rope(q), rope(k)
    nb = -(-T // MOBA_BLOCK)
    pad = nb * MOBA_BLOCK - T
    kp = jnp.pad(k, ((0, 0), (0, 0), (0, pad), (0, 0)))
    vp = jnp.pad(v, ((0, 0), (0, 0), (0, pad), (0, 0)))
    kb = kp.reshape(B, H, nb, MOBA_BLOCK, D)
    vb = vp.reshape(B, H, nb, MOBA_BLOCK, D)
    kbar = jnp.mean(kb.astype(jnp.float32), axis=3)
    gate = jnp.einsum('bhtd,bhnd->bhtn', q.astype(jnp.float32), kbar)
    qblk = jnp.arange(T) // MOBA_BLOCK
    past = jnp.arange(nb)[None, :] < qblk[:, None]
    gate = jnp.where(past, gate, MASK_VALUE)
    n_sel = min(MOBA_TOPK, nb)
    _, idx = lax.top_k(gate, n_sel)
    scale = D ** -0.5
    gather = jax.vmap(jax.vmap(lambda a, i: a[i]))
    n_chunks = T // MOBA_Q_CHUNK

    def chunk(c):
        t0 = c * MOBA_Q_CHUNK
        blk = t0 // MOBA_BLOCK
        qc = lax.dynamic_slice_in_dim(q, t0, MOBA_Q_CHUNK, axis=2)
        ic = lax.dynamic_slice_in_dim(idx, t0, MOBA_Q_CHUNK, axis=2)
        ks = gather(kb, ic)
        vs = gather(vb, ic)
        s_sel = jnp.einsum('bhqd,bhqnkd->bhqnk', qc, ks).astype(jnp.float32) * scale
        valid = jnp.arange(n_sel) < blk
        s_sel = jnp.where(valid[:, None], s_sel, MASK_VALUE)
        ko = lax.dynamic_slice_in_dim(kp, blk * MOBA_BLOCK, MOBA_BLOCK, axis=2)
        vo = lax.dynamic_slice_in_dim(vp, blk * MOBA_BLOCK, MOBA_BLOCK, axis=2)
        s_own = jnp.einsum('bhqd,bhkd->bhqk', qc, ko).astype(jnp.float32) * scale
        causal = (blk * MOBA_BLOCK + jnp.arange(MOBA_BLOCK))[None, :] <= (t0 + jnp.arange(MOBA_Q_CHUNK))[:, None]
        s_own = jnp.where(causal, s_own, MASK_VALUE)
        logits = jnp.concatenate([s_sel.reshape(B, H, MOBA_Q_CHUNK, n_sel * MOBA_BLOCK), s_own], axis=-1)
        p = jax.nn.softmax(logits, axis=-1).astype(v.dtype)
        p_sel = p[..., :n_sel * MOBA_BLOCK].reshape(B, H, MOBA_Q_CHUNK, n_sel, MOBA_BLOCK)
        p_own = p[..., n_sel * MOBA_BLOCK:]
        return jnp.einsum('bhqnk,bhqnkd->bhqd', p_sel, vs) + jnp.einsum('bhqk,bhkd->bhqd', p_own, vo)

    out = lax.map(chunk, jnp.arange(n_chunks))
    return out.transpose(1, 2, 0, 3, 4).reshape(B, H, T, D)


def forgetting_attention(q, k, v, f_logit):
    B, H, T, D = q.shape
    c = jnp.cumsum(jax.nn.log_sigmoid(f_logit.astype(jnp.float32)), axis=-1)
    scale = D ** -0.5

    def block(i):
        t0 = i * FOX_Q_BLOCK
        qb = lax.dynamic_slice_in_dim(q, t0, FOX_Q_BLOCK, axis=2)
        cb = lax.dynamic_slice_in_dim(c, t0, FOX_Q_BLOCK, axis=2)
        s = jnp.einsum('bhqd,bhkd->bhqk', qb, k).astype(jnp.float32) * scale
        s = s + cb[..., :, None] - c[:, :, None, :]
        mask = jnp.arange(T)[None, :] <= (t0 + jnp.arange(FOX_Q_BLOCK))[:, None]
        p = jax.nn.softmax(jnp.where(mask, s, MASK_VALUE), axis=-1).astype(v.dtype)
        return jnp.einsum('bhqk,bhkd->bhqd', p, v)

    out = lax.map(block, jnp.arange(T // FOX_Q_BLOCK))
    return out.transpose(1, 2, 0, 3, 4).reshape(B, H, T, D)


def hgrn2(q, f_logit, v, g, lb, norm_g):
    B, H, T, D = q.shape
    Dv = v.shape[-1]
    dt = q.dtype
    z = f_logit.astype(jnp.float32)
    lbh = lb.astype(jnp.float32).reshape(1, H, 1, D)
    f = lbh + (1.0 - lbh) * jax.nn.sigmoid(z)
    log_f = jnp.log(f)
    k = (1.0 - lbh) * jax.nn.sigmoid(-z)
    n = T // HGRN_CHUNK
    C = HGRN_CHUNK

    def chunks(a):
        return a.astype(jnp.float32).reshape(B, H, n, C, a.shape[-1]).transpose(2, 0, 1, 3, 4)

    causal = jnp.tril(jnp.ones((C, C), dtype=bool))

    def step(S, xs):
        qc, kc, vc, lf = xs
        b = jnp.cumsum(lf, axis=2)
        b_last = b[:, :, -1:, :]
        inter = jnp.einsum('bhcd,bhde->bhce', qc * jnp.exp(b), S)
        diff = b[:, :, :, None, :] - b[:, :, None, :, :]
        decay = jnp.exp(jnp.where(causal[:, :, None], diff, MASK_VALUE))
        att = jnp.einsum('bhtd,bhsd,bhtsd->bhts', qc, kc, decay)
        intra = jnp.einsum('bhts,bhse->bhte', att, vc)
        S = jnp.exp(b_last[:, :, 0, :])[..., None] * S + jnp.einsum('bhsd,bhse->bhde', kc * jnp.exp(b_last - b), vc)
        return S, inter + intra

    S0 = jnp.zeros((B, H, D, Dv), jnp.float32)
    _, o = lax.scan(step, S0, (chunks(q), chunks(k), chunks(v), chunks(log_f)))
    o = o.transpose(1, 2, 0, 3, 4).reshape(B, H, T, Dv)
    o = o * lax.rsqrt(jnp.mean(o * o, axis=-1, keepdims=True) + NORM_EPS) * norm_g.astype(jnp.float32).reshape(1, H, 1, Dv)
    o = o.transpose(0, 2, 1, 3).reshape(B, T, H * Dv)
    return (o * jax.nn.silu(g.astype(jnp.float32))).astype(dt)


def multiscale_pool(y, w_pool, scale):
    B, T, _ = y.shape
    G = len(POOL_WINDOWS)
    C = POOL_GROUP_DIM
    yg = y.astype(jnp.float32).reshape(B, T, G, C)
    cs = jnp.concatenate([jnp.zeros((B, 1, G, C), jnp.float32), jnp.cumsum(yg, axis=1)], axis=1)
    end = jnp.arange(1, T + 1)
    start = jnp.maximum(end[:, None] - jnp.array(POOL_WINDOWS, dtype=jnp.int32)[None, :], 0)
    lo = cs[:, start, jnp.arange(G)[None, :], :]
    mean = (cs[:, 1:] - lo) / (end[:, None] - start).astype(jnp.float32)[None, :, :, None]
    pooled = (mean - yg).astype(y.dtype)
    out = jnp.einsum('btgc,gce->btge', pooled, w_pool).reshape(B, T, G * C)
    return out * scale


def hybrid_mixer(h, w_in, f_bias, lb, hgrn_norm, pool_w, pool_scale, w_branch, w_out):
    B, T, _ = h.shape
    z = h @ w_in
    (mq, mk, mv, fq, fk, fv, ff, hq, hf, hi, hg, pin, gl) = jnp.split(z, np.cumsum(IN_SIZES)[:-1].tolist(), axis=-1)
    y_a = merge_heads(moba_attention(split_heads(mq, N_HEADS), split_heads(mk, N_HEADS), split_heads(mv, N_HEADS)))
    f_logit = (ff + f_bias).transpose(0, 2, 1)
    y_b = merge_heads(forgetting_attention(split_heads(fq, N_HEADS), split_heads(fk, N_HEADS), split_heads(fv, N_HEADS), f_logit))
    y_c = hgrn2(split_heads(hq, N_HEADS), split_heads(hf, N_HEADS), split_heads(hi, N_HEADS), hg, lb, hgrn_norm)
    y_d = multiscale_pool(pin, pool_w, pool_scale)
    branches = jnp.stack([y_a, y_b, y_c, y_d], axis=2)
    proj = jnp.einsum('btnc,ncd->btnd', branches, w_branch)
    gates = jax.nn.sigmoid(gl.reshape(B, T, N_BRANCHES, D_MODEL))
    return jnp.sum(gates * proj, axis=2) @ w_out


def memory_cross_attention(h, m, wq, wkv, wo):
    q = split_heads(h @ wq, N_XA_HEADS)
    k, v = jnp.split(m @ wkv, 2, axis=-1)
    k, v = split_heads(k, N_XA_HEADS), split_heads(v, N_XA_HEADS)
    s = jnp.einsum('bhtd,bhmd->bhtm', q, k).astype(jnp.float32) * XA_HEAD_DIM ** -0.5
    p = jax.nn.softmax(s, axis=-1).astype(v.dtype)
    return merge_heads(jnp.einsum('bhtm,bhmd->bhtd', p, v)) @ wo


def squared_relu_mlp(h, w_up, w_down):
    return jnp.square(jax.nn.relu(h @ w_up)) @ w_down


def setup_inputs(seed: int = 0) -> dict:
    key = jax.random.key(seed)
    ks = jax.random.split(key, 24)
    f32 = jnp.float32
    L = DEPTH
    XW = N_XA_HEADS * XA_HEAD_DIM

    def w(k, shape, fan_in):
        return jax.random.normal(k, shape, f32) * fan_in ** -0.5

    def gain(k, shape):
        return 1.0 + 0.02 * jax.random.normal(k, shape, f32)

    return {
        'x': jax.random.normal(ks[0], (BATCH, SEQ, D_MODEL), f32),
        'mem': jax.random.normal(ks[1], (BATCH, N_MEM, D_MODEL), f32),
        'hgrn_lb_logits': 0.5 * jax.random.normal(ks[2], (L, BRANCH_WIDTH), f32),
        'mix_norm_pre': gain(ks[3], (L, D_MODEL)),
        'mix_norm_post': gain(ks[4], (L, D_MODEL)),
        'w_in': w(ks[5], (L, D_MODEL, D_IN), D_MODEL),
        'fox_f_bias': 2.0 + 0.5 * jax.random.normal(ks[6], (L, N_HEADS), f32),
        'hgrn_out_norm': gain(ks[7], (L, BRANCH_WIDTH)),
        'pool_w': w(ks[8], (L, len(POOL_WINDOWS), POOL_GROUP_DIM, POOL_GROUP_DIM), POOL_GROUP_DIM),
        'pool_scale': gain(ks[9], (L, BRANCH_WIDTH)),
        'w_branch': w(ks[10], (L, N_BRANCHES, BRANCH_WIDTH, D_MODEL), BRANCH_WIDTH),
        'w_mix_out': w(ks[11], (L, D_MODEL, D_MODEL), D_MODEL),
        'xa_norm_pre': gain(ks[12], (L, D_MODEL)),
        'xa_norm_mem': gain(ks[13], (L, D_MODEL)),
        'xa_norm_post': gain(ks[14], (L, D_MODEL)),
        'xa_wq': w(ks[15], (L, D_MODEL, XW), D_MODEL),
        'xa_wkv': w(ks[16], (L, D_MODEL, 2 * XW), D_MODEL),
        'xa_wo': w(ks[17], (L, XW, D_MODEL), XW),
        'mlp_norm_pre': gain(ks[18], (L, D_MODEL)),
        'mlp_norm_post': gain(ks[19], (L, D_MODEL)),
        'mlp_w_up': w(ks[20], (L, D_MODEL, MLP_HIDDEN), D_MODEL),
        'mlp_w_down': w(ks[21], (L, MLP_HIDDEN, D_MODEL), MLP_HIDDEN),
    }


def reference(x, mem, hgrn_lb_logits, mix_norm_pre, mix_norm_post, w_in, fox_f_bias, hgrn_out_norm, pool_w, pool_scale, w_branch, w_mix_out, xa_norm_pre, xa_norm_mem, xa_norm_post, xa_wq, xa_wkv, xa_wo, mlp_norm_pre, mlp_norm_post, mlp_w_up, mlp_w_down):
    P = jax.nn.softmax(hgrn_lb_logits.astype(jnp.float32), axis=0)
    lower_bounds = jnp.cumsum(P, axis=0) - P[0:1]
    h = x
    for l in range(DEPTH):
        a = hybrid_mixer(rms_norm(h, mix_norm_pre[l]), w_in[l], fox_f_bias[l], lower_bounds[l], hgrn_out_norm[l], pool_w[l], pool_scale[l], w_branch[l], w_mix_out[l])
        h = h + rms_norm(a, mix_norm_post[l])
        c = memory_cross_attention(rms_norm(h, xa_norm_pre[l]), rms_norm(mem, xa_norm_mem[l]), xa_wq[l], xa_wkv[l], xa_wo[l])
        h = h + rms_norm(c, xa_norm_post[l])
        m = squared_relu_mlp(rms_norm(h, mlp_norm_pre[l]), mlp_w_up[l], mlp_w_down[l])
        h = h + rms_norm(m, mlp_norm_post[l])
    return h
```

```cpp
#include <hip/hip_runtime.h>
#include <hip/hip_cooperative_groups.h>
#include <cstdio>
#include <cstdint>
namespace cg = cooperative_groups;

#define LAS __attribute__((address_space(3)))
typedef unsigned short bf16_t;
typedef short bf16x8 __attribute__((ext_vector_type(8)));
typedef short s16x4 __attribute__((ext_vector_type(4)));
typedef float f32x4 __attribute__((ext_vector_type(4)));
typedef float f32x16 __attribute__((ext_vector_type(16)));
typedef unsigned u32x4 __attribute__((ext_vector_type(4)));
typedef unsigned u32x2 __attribute__((ext_vector_type(2)));

constexpr int BATCH = 2, SEQ = 4096, DM = 2048, M = BATCH * SEQ, DEPTH = 2;
constexpr int DIN_SRC = 13828, NZ = 13824;
constexpr int Z_MQ = 0, Z_MK = 512, Z_MV = 1024, Z_FQ = 1536, Z_FK = 2048, Z_FV = 2560, Z_HQ = 3072, Z_HF = 3584, Z_HI = 4096, Z_HG = 4608, Z_PIN = 5120, Z_GL = 5632;
constexpr int FF_SRC_COL = 3072;
constexpr int NH = 4, HD = 128, BW = 512, HID = 8192, NMEM = 256;
constexpr float EPS = 1e-6f, MASKV = -1e30f, LOG2E = 1.4426950408889634f;

constexpr size_t MiB = 1u << 20;
constexpr size_t SZ_WIN = (size_t)NZ * DM * 2, SZ_WBR = (size_t)4 * DM * BW * 2, SZ_WOUT = (size_t)DM * DM * 2, SZ_WXQ = (size_t)BW * DM * 2, SZ_WXKV = (size_t)1024 * DM * 2,
                 SZ_WXO = (size_t)DM * BW * 2, SZ_WUP = (size_t)HID * DM * 2, SZ_WDN = (size_t)DM * HID * 2;
constexpr size_t SZ_WL = SZ_WIN + SZ_WBR + SZ_WOUT + SZ_WXQ + SZ_WXKV + SZ_WXO + SZ_WUP + SZ_WDN;
constexpr size_t OFF_W = 0;
constexpr size_t OFF_Z = ((OFF_W + 2 * SZ_WL + MiB - 1) / MiB) * MiB;
constexpr size_t OFF_HN = OFF_Z + (((size_t)M * NZ * 2 + MiB - 1) / MiB) * MiB;
constexpr size_t OFF_Y = OFF_HN + (size_t)M * DM * 2;
constexpr size_t OFF_MIX = OFF_Y + (size_t)4 * M * BW * 2;
constexpr size_t OFF_SRC = OFF_MIX + (size_t)M * DM * 2;
constexpr size_t OFF_XQ = OFF_SRC + (size_t)M * DM * 2;
constexpr size_t OFF_XO = OFF_XQ + (size_t)M * BW * 2;
constexpr size_t OFF_HS = OFF_XO + (size_t)M * BW * 2;
constexpr size_t OFF_HDEC = OFF_HS + (size_t)512 * 128 * 128 * 4;
constexpr size_t OFF_KBAR = OFF_HDEC + (size_t)512 * 128 * 4;
constexpr size_t OFF_CF = OFF_KBAR + (size_t)2 * 4 * 16 * 128 * 4;
constexpr size_t OFF_FF = OFF_CF + (size_t)8 * 4096 * 4;
constexpr size_t OFF_MEMN = OFF_FF + (size_t)M * 4 * 4;
constexpr size_t OFF_MEMKV = OFF_MEMN + (size_t)2 * 512 * DM * 2;
constexpr size_t OFF_LB = OFF_MEMKV + (size_t)2 * 512 * 1024 * 2;
constexpr size_t OFF_BAR = OFF_LB + 2 * 512 * 4;
constexpr size_t CTL_BYTES = 131072;
constexpr size_t OFF_XB = OFF_BAR + CTL_BYTES;
constexpr size_t WS_END = OFF_XB + 2 * (size_t)M * 8 * 4;

__device__ __forceinline__ int otid0() { int t = threadIdx.x; asm volatile("" : "+v"(t)); return t; }
namespace pg8 {
constexpr int BM = 256, BK = 64, HALF = 128, HTB = HALF * BK * 2, STAGE_BYTES = 8 * HTB, NXCD = 8, WGM = 4;
__host__ __device__ __forceinline__ int lds_byte(int r, int c) { const int st = (r >> 4) * 2 + (c >> 5), rr = r & 15, cc = c & 31, ob = rr * 64 + cc * 2; return st * 1024 + (ob ^ (((ob >> 9) & 1) << 5)); }
__host__ __device__ __forceinline__ void stage_rc(int b, int& R, int& C) { const int st = b / 1024, sb = b % 1024, swz = sb ^ (((sb >> 9) & 1) << 5); R = (st >> 1) * 16 + swz / 64; C = (st & 1) * 32 + (swz % 64) / 2; }
__host__ __device__ __forceinline__ int perm32(int rho) { const int n = rho >> 4, i = rho & 15; return 8 * (i >> 2) + 4 * n + (i & 3); }

struct Unit { int pm, pn, n; long aoff, boff, ooff; };
struct Gemm { const bf16_t* A; const bf16_t* Bt; int M, N, K, lda, ldb; };

struct StaticOrder {
    int nM, nN, nwg, G, c, nsub, c0, ksp; long astr, bstr, ostr;
    __device__ void init(int M_, int N_, int G_, int c_, int nsub_ = 1, long astr_ = 0, long bstr_ = 0, int c0_ = 0, int ksp_ = 1, long ostr_ = 0) { nM = M_ / BM; nN = N_ / BM; nwg = nM * nN; G = G_; c = c_; nsub = nsub_; astr = astr_; bstr = bstr_; c0 = c0_; ksp = ksp_; ostr = ostr_; }
    __device__ bool next(int i, Unit& u) const {
        if (c < c0) return false;
        const int ti = i / nsub; u.n = i - ti * nsub;
        const long L = (long)ti * G + (c - c0); if (L >= (long)nwg * ksp) return false;
        const int split = (int)(L / nwg);
        int wgid = (int)(L - (long)split * nwg); { const int q = nwg / NXCD, r = nwg % NXCD, xcd = wgid % NXCD, off = wgid / NXCD; wgid = (xcd < r ? xcd * (q + 1) : r * (q + 1) + (xcd - r) * q) + off; }
        const int nig = WGM * nN, gid = wgid / nig, fm = gid * WGM, gsz = (nM - fm) < WGM ? (nM - fm) : WGM;
        u.pm = fm + ((wgid % nig) % gsz); u.pn = (wgid % nig) / gsz; u.aoff = (u.n + split) * astr; u.boff = (u.n + split) * bstr; u.ooff = split * ostr; return true;
    }
};

typedef float f32x2_t __attribute__((ext_vector_type(2))); typedef __bf16 bf16x2_t __attribute__((ext_vector_type(2)));
__device__ __forceinline__ unsigned cvt_pk_bf16(float lo, float hi) { f32x2_t v = {lo, hi}; bf16x2_t b = __builtin_convertvector(v, bf16x2_t); return __builtin_bit_cast(unsigned, b); }
__device__ __forceinline__ float bf_lo(unsigned w) { return __uint_as_float(w << 16); }
__device__ __forceinline__ float bf_hi(unsigned w) { return __uint_as_float(w & 0xffff0000u); }
__device__ __forceinline__ float sigmoidf_(float x) { return __builtin_amdgcn_rcpf(1.0f + __builtin_amdgcn_exp2f(-x * LOG2E)); }

#define RLX_AGENT __ATOMIC_RELAXED, __HIP_MEMORY_SCOPE_AGENT
struct Epi {
    static constexpr bool PERM = true;
    bf16_t* O; int ldc; const bf16_t* G; int ldg; int MODE;
    const float* hold; float* hout; bf16_t* hn; const float* gpost; const float* gpre; float* xb1; float* xb2; unsigned* cnt1; unsigned* cnt2; int has_next;
    __device__ __forceinline__ void operator()(const f32x4 (&acc)[2][2][4][2], const Unit& u, int wr, int wc, int fr, int fq) const {
        const int row0 = u.pm * BM + wr * 64 + fr, col0 = u.pn * BM + wc * 32 + 8 * fq;
#pragma unroll
        for (int ai = 0; ai < 2; ++ai)
#pragma unroll
            for (int m = 0; m < 4; ++m) { const size_t row = (size_t)(row0 + ai * HALF + m * 16); bf16_t* rowp = O + u.ooff + row * ldc + col0;
#pragma unroll
                for (int bj = 0; bj < 2; ++bj) { f32x4 v0 = acc[ai][bj][m][0], v1 = acc[ai][bj][m][1];
                    if (MODE == 1) {
#pragma unroll
                        for (int e = 0; e < 4; ++e) { const float a = fmaxf(v0[e], 0.f), b = fmaxf(v1[e], 0.f); v0[e] = a * a; v1[e] = b * b; } }
                    if (MODE == 2) {
                        const u32x4 g = *(const u32x4*)(G + row * ldg + (size_t)u.n * DM + col0 + bj * HALF);
                        v0[0] *= sigmoidf_(bf_lo(g.x)); v0[1] *= sigmoidf_(bf_hi(g.x)); v0[2] *= sigmoidf_(bf_lo(g.y)); v0[3] *= sigmoidf_(bf_hi(g.y));
                        v1[0] *= sigmoidf_(bf_lo(g.z)); v1[1] *= sigmoidf_(bf_hi(g.z)); v1[2] *= sigmoidf_(bf_lo(g.w)); v1[3] *= sigmoidf_(bf_hi(g.w));
                        if (u.n > 0) { const u32x4 o = *(const u32x4*)(rowp + bj * HALF);
                            v0[0] += bf_lo(o.x); v0[1] += bf_hi(o.x); v0[2] += bf_lo(o.y); v0[3] += bf_hi(o.y); v1[0] += bf_lo(o.z); v1[1] += bf_hi(o.z); v1[2] += bf_lo(o.w); v1[3] += bf_hi(o.w); } }
                    u32x4 w; w.x = cvt_pk_bf16(v0[0], v0[1]); w.y = cvt_pk_bf16(v0[2], v0[3]); w.z = cvt_pk_bf16(v1[0], v1[1]); w.w = cvt_pk_bf16(v1[2], v1[3]);
                    *(u32x4*)(rowp + bj * HALF) = w; } }
    }
    __device__ __forceinline__ void panel_rstd(const f32x4 (&v)[2][2][4][2], const Unit& u, int wr, int wc, int fr, int fq, LAS unsigned char* lds, int tid, float* xb, unsigned* cnt) const {
        LAS float* Pt = (LAS float*)lds; LAS float* St = (LAS float*)(lds + 4096);
        const int wid = __builtin_amdgcn_readfirstlane(tid >> 6), lane = tid & 63;
#pragma unroll
        for (int ai = 0; ai < 2; ++ai)
#pragma unroll
            for (int m = 0; m < 4; ++m) { float s = 0.f;
#pragma unroll
                for (int bj = 0; bj < 2; ++bj)
#pragma unroll
                    for (int n = 0; n < 2; ++n) { const f32x4 x = v[ai][bj][m][n]; s += (x[0] * x[0] + x[1] * x[1]) + (x[2] * x[2] + x[3] * x[3]); }
                s += __shfl_xor(s, 16); s += __shfl_xor(s, 32);
                if (fq == 0) Pt[(ai * HALF + wr * 64 + m * 16 + fr) * 4 + wc] = s; }
        asm volatile("s_waitcnt lgkmcnt(0)" ::: "memory"); __builtin_amdgcn_s_barrier(); asm volatile("" ::: "memory");
        if (tid < 256) { const float tot = (Pt[tid * 4 + 0] + Pt[tid * 4 + 1]) + (Pt[tid * 4 + 2] + Pt[tid * 4 + 3]);
            __hip_atomic_store(xb + (size_t)(u.pm * BM + tid) * 8 + u.pn, tot, RLX_AGENT); }
        asm volatile("s_waitcnt vmcnt(0)" ::: "memory");
        if (tid < 256 && lane == 0) __hip_atomic_fetch_add(cnt + 64 * u.pm, 1u, RLX_AGENT);
        if (wid == 0) { unsigned sp = 0;
            while ((unsigned)__builtin_amdgcn_readfirstlane(__hip_atomic_load(cnt + 64 * u.pm, RLX_AGENT)) < 32u) { __builtin_amdgcn_s_sleep(1); if (++sp > (1u << 22)) break; }
            __builtin_amdgcn_fence(__ATOMIC_ACQUIRE, "agent"); }
        asm volatile("s_waitcnt vmcnt(0) lgkmcnt(0)" ::: "memory"); __builtin_amdgcn_s_barrier(); asm volatile("" ::: "memory");
        if (tid < 256) { const float* sl = xb + (size_t)(u.pm * BM + tid) * 8; float q = 0.f;
#pragma unroll
            for (int t = 0; t < 8; ++t) q += __hip_atomic_load(sl + t, RLX_AGENT);
            St[tid] = 1.0f / sqrtf(q * (1.0f / DM) + EPS); }
        asm volatile("s_waitcnt lgkmcnt(0)" ::: "memory"); __builtin_amdgcn_s_barrier(); asm volatile("" ::: "memory");
    }
    __device__ __forceinline__ void fused(f32x4 (&acc)[2][2][4][2], const Unit& u, int wr, int wc, int fr, int fq, LAS unsigned char* lds, int tid) const {
        const LAS float* St = (const LAS float*)(lds + 4096);
        const int col0 = u.pn * BM + wc * 32 + 8 * fq;
        panel_rstd(acc, u, wr, wc, fr, fq, lds, tid, xb1, cnt1);
        {   f32x4 gp[2][2];
#pragma unroll
            for (int bj = 0; bj < 2; ++bj)
#pragma unroll
                for (int n = 0; n < 2; ++n) gp[bj][n] = *(const f32x4*)(gpost + col0 + bj * HALF + 4 * n);
#pragma unroll
            for (int ai = 0; ai < 2; ++ai)
#pragma unroll
                for (int m = 0; m < 4; ++m) { const int r = ai * HALF + wr * 64 + m * 16 + fr; const float rs = St[r]; const size_t off = (size_t)(u.pm * BM + r) * DM + col0;
#pragma unroll
                    for (int bj = 0; bj < 2; ++bj)
#pragma unroll
                        for (int n = 0; n < 2; ++n) { const f32x4 ho = *(const f32x4*)(hold + off + bj * HALF + 4 * n); acc[ai][bj][m][n] = ho + acc[ai][bj][m][n] * rs * gp[bj][n]; }
                    if (!has_next) {
#pragma unroll
                        for (int bj = 0; bj < 2; ++bj)
#pragma unroll
                            for (int n = 0; n < 2; ++n) *(f32x4*)(hout + off + bj * HALF + 4 * n) = acc[ai][bj][m][n]; }
                    if (m & 1) asm volatile("" ::: "memory"); } }
        if (!has_next) return;
        panel_rstd(acc, u, wr, wc, fr, fq, lds, tid, xb2, cnt2);
        {   f32x4 gp[2][2];
#pragma unroll
            for (int bj = 0; bj < 2; ++bj)
#pragma unroll
                for (int n = 0; n < 2; ++n) gp[bj][n] = *(const f32x4*)(gpre + col0 + bj * HALF + 4 * n);
#pragma unroll
            for (int ai = 0; ai < 2; ++ai)
#pragma unroll
                for (int m = 0; m < 4; ++m) { const int r = ai * HALF + wr * 64 + m * 16 + fr; const float rs = St[r]; const size_t off = (size_t)(u.pm * BM + r) * DM + col0;
#pragma unroll
                    for (int bj = 0; bj < 2; ++bj) { const f32x4 x0 = acc[ai][bj][m][0], x1 = acc[ai][bj][m][1];
                        *(f32x4*)(hout + off + bj * HALF) = x0; *(f32x4*)(hout + off + bj * HALF + 4) = x1;
                        const f32x4 y0 = x0 * rs * gp[bj][0], y1 = x1 * rs * gp[bj][1];
                        u32x4 w; w.x = cvt_pk_bf16(y0[0], y0[1]); w.y = cvt_pk_bf16(y0[2], y0[3]); w.z = cvt_pk_bf16(y1[0], y1[1]); w.w = cvt_pk_bf16(y1[2], y1[3]);
                        *(u32x4*)(hn + off + bj * HALF) = w; }
                    if (m & 1) asm volatile("" ::: "memory"); } }
    }
};

template <class EpiT, class Sched>
__device__ __forceinline__ void gemm_phase(LAS unsigned char* lds, const Gemm g, const Sched& S, const EpiT& E) {
    const int tid = otid0(), wid = __builtin_amdgcn_readfirstlane(tid >> 6), lane = tid & 63, wr = wid >> 2, wc = wid & 3, fr = lane & 15, fq = lane >> 4;
    const int K = g.K, nt = K / BK;
    unsigned voffA[2], voffB[2];
#pragma unroll
    for (int i = 0; i < 2; ++i) { int R, C; stage_rc(tid * 16 + i * 8192, R, C); const int Rb = EpiT::PERM ? ((R & ~31) + perm32(R & 31)) : R;
        voffA[i] = (unsigned)(R * g.lda + C) * 2u; voffB[i] = (unsigned)(Rb * g.ldb + C) * 2u; }
    const size_t kstep = (size_t)(BK * 2);
    const size_t hstepA = (size_t)HALF * g.lda * 2, hstepB = (size_t)HALF * g.ldb * 2;
    const size_t tstepA = 2 * hstepA, tstepB = 2 * hstepB;
    const unsigned ldsw = (unsigned)wid * 1024u;
    const int aoff = lds_byte(wr * 64 + fr, fq * 8), boff = lds_byte(wc * 32 + fr, fq * 8);
#define PG8_SA(b, h) (((b) * 2 + (h)) * HTB)
#define PG8_SB(b, h) ((4 + (b) * 2 + (h)) * HTB)
#define PG8_STAGE(bufoff, gbase, voff) do { _Pragma("unroll") for (int _i = 0; _i < 2; ++_i) \
        __builtin_amdgcn_global_load_lds((const unsigned*)((const char*)(gbase) + (voff)[_i]), (LAS unsigned*)(lds + (bufoff) + ldsw + _i * 8192), 16, 0, 0); } while (0)
#define PG8_LDA(dst, b, h) do { _Pragma("unroll") for (int m = 0; m < 4; ++m) _Pragma("unroll") for (int k = 0; k < 2; ++k) dst[m][k] = *(const LAS bf16x8*)(lds + PG8_SA(b, h) + aoff + m * 2048 + k * 1024); } while (0)
#define PG8_LDB(dst, b, h) do { _Pragma("unroll") for (int n = 0; n < 2; ++n) _Pragma("unroll") for (int k = 0; k < 2; ++k) dst[n][k] = *(const LAS bf16x8*)(lds + PG8_SB(b, h) + boff + n * 2048 + k * 1024); } while (0)
#define PG8_MMA(ai, bj, At, Bt) do { __builtin_amdgcn_s_setprio(1); _Pragma("unroll") for (int m = 0; m < 4; ++m) _Pragma("unroll") for (int n = 0; n < 2; ++n) _Pragma("unroll") for (int k = 0; k < 2; ++k) \
        acc[ai][bj][m][n] = __builtin_amdgcn_mfma_f32_16x16x32_bf16(Bt[n][k], At[m][k], acc[ai][bj][m][n], 0, 0, 0); __builtin_amdgcn_s_setprio(0); } while (0)
#define PG8_WAIT_V(n) asm volatile("s_waitcnt vmcnt(" #n ")" ::: "memory")
#define PG8_WAIT_L(n) asm volatile("s_waitcnt lgkmcnt(" #n ")" ::: "memory")
#define PG8_BAR __builtin_amdgcn_s_barrier()
#define PG8_SCHED __builtin_amdgcn_sched_barrier(0)
    Unit cur, nxt; int ui = 0;
    if (!S.next(0, cur)) return;
    f32x4 acc[2][2][4][2];
#pragma unroll
    for (int a = 0; a < 2; ++a)
#pragma unroll
        for (int b = 0; b < 2; ++b)
#pragma unroll
            for (int m = 0; m < 4; ++m)
#pragma unroll
                for (int n = 0; n < 2; ++n) acc[a][b][m][n] = (f32x4){0.f, 0.f, 0.f, 0.f};
    bf16x8 At[4][2], B0[2][2], B1[2][2];
    const char* cA = (const char*)g.A + (size_t)cur.pm * tstepA + cur.aoff; const char* cB = (const char*)g.Bt + (size_t)cur.pn * tstepB + cur.boff;
    PG8_STAGE(PG8_SB(0, 0), cB, voffB); PG8_STAGE(PG8_SB(0, 1), cB + hstepB, voffB); PG8_STAGE(PG8_SA(0, 0), cA, voffA); PG8_STAGE(PG8_SA(0, 1), cA + hstepA, voffA);
    if (wr == 1) PG8_BAR;
    PG8_WAIT_V(2); PG8_BAR;
    PG8_STAGE(PG8_SB(1, 0), cB + kstep, voffB); PG8_STAGE(PG8_SA(1, 0), cA + kstep, voffA); PG8_STAGE(PG8_SB(1, 1), cB + hstepB + kstep, voffB);
    PG8_WAIT_V(6); PG8_BAR;
    for (;;) {
        const bool has_next = S.next(ui + 1, nxt);
        const char* nA = has_next ? (const char*)g.A + (size_t)nxt.pm * tstepA + nxt.aoff : cA; const char* nB = has_next ? (const char*)g.Bt + (size_t)nxt.pn * tstepB + nxt.boff : cB;
        for (int t = 0; t < nt; t += 2) {
            const bool last = (t == nt - 2);
            const char* a1 = cA + (size_t)(t + 1) * kstep;
            const char* a2 = last ? nA : cA + (size_t)(t + 2) * kstep; const char* b2 = last ? nB : cB + (size_t)(t + 2) * kstep;
            const char* a3 = a2 + kstep; const char* b3 = b2 + kstep;
            PG8_LDB(B0, 0, 0); PG8_LDB(B1, 0, 1); PG8_SCHED; PG8_LDA(At, 0, 0); PG8_STAGE(PG8_SA(1, 1), a1 + hstepA, voffA);
            PG8_WAIT_V(8); PG8_WAIT_L(0); PG8_BAR; PG8_MMA(0, 0, At, B0); PG8_MMA(0, 1, At, B1); PG8_BAR; PG8_SCHED;
            PG8_LDA(At, 0, 1); PG8_STAGE(PG8_SB(0, 0), b2, voffB); PG8_STAGE(PG8_SB(0, 1), b2 + hstepB, voffB); PG8_STAGE(PG8_SA(0, 0), a2, voffA);
            PG8_WAIT_V(8); PG8_WAIT_L(0); PG8_BAR; PG8_MMA(1, 0, At, B0); PG8_MMA(1, 1, At, B1); PG8_BAR; PG8_SCHED;
            PG8_LDB(B0, 1, 0); PG8_LDB(B1, 1, 1); PG8_SCHED; PG8_LDA(At, 1, 0); PG8_STAGE(PG8_SA(0, 1), a2 + hstepA, voffA);
            PG8_WAIT_V(8); PG8_WAIT_L(0); PG8_BAR; PG8_MMA(0, 0, At, B0); PG8_MMA(0, 1, At, B1); PG8_BAR; PG8_SCHED;
            PG8_LDA(At, 1, 1); PG8_STAGE(PG8_SB(1, 0), b3, voffB); PG8_STAGE(PG8_SB(1, 1), b3 + hstepB, voffB); PG8_STAGE(PG8_SA(1, 0), a3, voffA);
            PG8_WAIT_V(8); PG8_WAIT_L(0); PG8_BAR; PG8_MMA(1, 0, At, B0); PG8_MMA(1, 1, At, B1); PG8_BAR; PG8_SCHED;
        }
        if (wr == 0) PG8_BAR;
        if (E.MODE != 3) E(acc, cur, wr, wc, fr, fq);
        if (!has_next) break;
#pragma unroll
        for (int a = 0; a < 2; ++a)
#pragma unroll
            for (int b = 0; b < 2; ++b)
#pragma unroll
                for (int m = 0; m < 4; ++m)
#pragma unroll
                    for (int n = 0; n < 2; ++n) acc[a][b][m][n] = (f32x4){0.f, 0.f, 0.f, 0.f};
        cur = nxt; cA = nA; cB = nB; ++ui;
        if (wr == 1) PG8_BAR;
    }
    PG8_WAIT_V(0);
    PG8_BAR;
    if (E.MODE == 3) E.fused(acc, cur, wr, wc, fr, fq, lds, tid);
#undef PG8_SA
#undef PG8_SB
#undef PG8_STAGE
#undef PG8_LDA
#undef PG8_LDB
#undef PG8_MMA
#undef PG8_WAIT_V
#undef PG8_WAIT_L
#undef PG8_BAR
#undef PG8_SCHED
}
}
using pg8::cvt_pk_bf16; using pg8::bf_lo; using pg8::bf_hi; using pg8::sigmoidf_;

struct Params {
    const float *x, *mem, *lb_logits, *mix_norm_pre, *mix_norm_post, *w_in, *fox_f_bias, *hgrn_out_norm, *pool_w, *pool_scale, *w_branch, *w_mix_out,
                *xa_norm_pre, *xa_norm_mem, *xa_norm_post, *xa_wq, *xa_wkv, *xa_wo, *mlp_norm_pre, *mlp_norm_post, *mlp_w_up, *mlp_w_down;
    float* out; unsigned char* ws;
};
__device__ __forceinline__ float wave_sum(float v) {
#pragma unroll
    for (int o = 1; o < 64; o <<= 1) v += __shfl_xor(v, o);
    return v;
}
__device__ __forceinline__ unsigned f2bf(float f) { unsigned u = __builtin_bit_cast(unsigned, f); return (u + 0x7fffu + ((u >> 16) & 1u)) >> 16; }
__device__ __forceinline__ unsigned pk2(float lo, float hi) { return f2bf(lo) | (f2bf(hi) << 16); }
__device__ __forceinline__ float bf2f(bf16_t v) { return __uint_as_float((unsigned)v << 16); }
#define LDS_WAIT() asm volatile("s_waitcnt lgkmcnt(0)" ::: "memory")
__device__ __forceinline__ int otid() { int t = threadIdx.x; asm volatile("" : "+v"(t)); return t; }

struct TrItem { const float* src; bf16_t* dst; int K; };
__device__ __forceinline__ TrItem tr_decode(const float* W, int ldw, int K, int ncols, bf16_t* WT, int item) {
    const int nblk = ncols / 32, kb = item / nblk, nb = item - kb * nblk; TrItem t; t.src = W + (size_t)(64 * kb) * ldw + 32 * nb; t.dst = WT + (size_t)(32 * nb) * K + 64 * kb; t.K = K; return t;
}
__device__ __forceinline__ void tr_load(const TrItem& t, int ldw, int lane, f32x4 (&v)[8]) {
#pragma unroll
    for (int i = 0; i < 8; ++i) v[i] = *(const f32x4*)(t.src + (size_t)(8 * i + (lane >> 3)) * ldw + 4 * (lane & 7));
}
__device__ __forceinline__ void tr_process(const TrItem& t, LAS float* scr, int lane, const f32x4 (&v)[8]) {
#pragma unroll
    for (int i = 0; i < 8; ++i) { LAS float* d = scr + (8 * i + (lane >> 3)) * 33 + 4 * (lane & 7); d[0] = v[i][0]; d[1] = v[i][1]; d[2] = v[i][2]; d[3] = v[i][3]; }
    LDS_WAIT(); asm volatile("" ::: "memory");
    const int c = lane & 7;
#pragma unroll
    for (int j = 0; j < 4; ++j) { const int n = (lane >> 3) + 8 * j; const LAS float* s = scr + (8 * c) * 33 + n;
        u32x4 o; o.x = pk2(s[0 * 33], s[1 * 33]); o.y = pk2(s[2 * 33], s[3 * 33]); o.z = pk2(s[4 * 33], s[5 * 33]); o.w = pk2(s[6 * 33], s[7 * 33]);
        *(u32x4*)(t.dst + (size_t)n * t.K + 8 * c) = o; }
    LDS_WAIT(); asm volatile("" ::: "memory");
}

__device__ __forceinline__ void row_pass(const bool HAS_SRC, const bool HAS_NEXT, const bool HAS_FF, int lane, const bf16_t* src, const float* gpost, const float* hin, float* hout, const float* gpre, bf16_t* hn, const LAS float* wff, float* ff) {
    asm volatile("" : "+v"(lane));
    f32x4 h[8];
#pragma unroll
    for (int j = 0; j < 8; ++j) h[j] = *(const f32x4*)(hin + 4 * lane + 256 * j);
    if (HAS_SRC) {
        f32x4 s[8]; float ss = 0.f;
#pragma unroll
        for (int j = 0; j < 8; ++j) { const u32x2 w = *(const u32x2*)(src + 4 * lane + 256 * j); s[j] = (f32x4){bf_lo(w.x), bf_hi(w.x), bf_lo(w.y), bf_hi(w.y)};
            ss += (s[j][0] * s[j][0] + s[j][1] * s[j][1]) + (s[j][2] * s[j][2] + s[j][3] * s[j][3]); }
        const float r1 = 1.0f / sqrtf(wave_sum(ss) * (1.0f / DM) + EPS);
#pragma unroll
        for (int j = 0; j < 8; ++j) { const f32x4 g = *(const f32x4*)(gpost + 4 * lane + 256 * j); h[j] = h[j] + s[j] * r1 * g; *(f32x4*)(hout + 4 * lane + 256 * j) = h[j]; }
    }
    if (HAS_NEXT) {
        float ss = 0.f;
#pragma unroll
        for (int j = 0; j < 8; ++j) ss += (h[j][0] * h[j][0] + h[j][1] * h[j][1]) + (h[j][2] * h[j][2] + h[j][3] * h[j][3]);
        const float r2 = 1.0f / sqrtf(wave_sum(ss) * (1.0f / DM) + EPS);
        f32x4 fa = (f32x4){0.f, 0.f, 0.f, 0.f};
#pragma unroll
        for (int j = 0; j < 8; ++j) { const f32x4 g = *(const f32x4*)(gpre + 4 * lane + 256 * j); const f32x4 y = h[j] * r2 * g;
            u32x2 w; w.x = pk2(y[0], y[1]); w.y = pk2(y[2], y[3]); *(u32x2*)(hn + 4 * lane + 256 * j) = w;
            if (HAS_FF) {
#pragma unroll
                for (int e = 0; e < 4; ++e) { const f32x4 wv = *(const LAS f32x4*)(wff + (4 * lane + 256 * j + e) * 4); fa = fa + wv * y[e]; } } }
        if (HAS_FF) { fa[0] = wave_sum(fa[0]); fa[1] = wave_sum(fa[1]); fa[2] = wave_sum(fa[2]); fa[3] = wave_sum(fa[3]); if (lane == 0) *(f32x4*)ff = fa; }
    }
}

constexpr int AT_KSTR = 272, AT_VSTR = 320, AT_KBUF = 64 * AT_KSTR, AT_VBUF = 64 * AT_VSTR;
constexpr int AT_K0 = 0, AT_V0 = 2 * AT_KBUF, AT_CK = AT_V0 + 2 * AT_VBUF, AT_KBAR = AT_CK + 512, AT_VOTE = AT_KBAR + 8192, AT_END = AT_VOTE + 64;
typedef short v4i16_t __attribute__((ext_vector_type(4)));
__device__ __forceinline__ s16x4 vtr(LAS const unsigned char* p) { return __builtin_bit_cast(s16x4, __builtin_amdgcn_ds_read_tr16_b64_v4i16((LAS v4i16_t*)p)); }

template <int MODE>
__device__ __forceinline__ void attn_unit(LAS unsigned char* lds, const bf16_t* Qb, int ldq, const bf16_t* Kb, const bf16_t* Vb, int ldkv, bf16_t* Ob, int ldo, int q0, int ntiles, const float* cf, const float* kbar, size_t qsplit = 0, const unsigned* kmaxp = nullptr) {
    const int tid = otid(), lane = tid & 63, wid = __builtin_amdgcn_readfirstlane(tid >> 6), qg = wid & 3, kh = wid >> 2, r32 = lane & 31, h = lane >> 5;
    const int qrow = q0 + 32 * qg + r32;
    const float C2 = 0.08838834764831845f * LOG2E;
    bf16x8 qf[8];
    { const bf16_t* qp = Qb + (size_t)qrow * ldq + 8 * h;
      if (MODE == 2 && qsplit) {
#pragma unroll
          for (int s = 0; s < 8; ++s) { float a[8];
#pragma unroll
              for (int e = 0; e < 8; ++e) a[e] = 0.f;
#pragma unroll
              for (int ks = 0; ks < 4; ++ks) { const u32x4 w = *(const u32x4*)(qp + ks * qsplit + 16 * s);
                  a[0] += bf_lo(w.x); a[1] += bf_hi(w.x); a[2] += bf_lo(w.y); a[3] += bf_hi(w.y); a[4] += bf_lo(w.z); a[5] += bf_hi(w.z); a[6] += bf_lo(w.w); a[7] += bf_hi(w.w); }
              u32x4 o; o.x = cvt_pk_bf16(a[0], a[1]); o.y = cvt_pk_bf16(a[2], a[3]); o.z = cvt_pk_bf16(a[4], a[5]); o.w = cvt_pk_bf16(a[6], a[7]); qf[s] = __builtin_bit_cast(bf16x8, o); }
      } else {
#pragma unroll
          for (int s = 0; s < 8; ++s) qf[s] = *(const bf16x8*)(qp + 16 * s); } }
    unsigned sel = 0; const int blk = q0 >> 8;
    if (MODE == 0) {
        LAS float* kbl = (LAS float*)(lds + AT_KBAR);
        *(LAS f32x4*)(kbl + 4 * tid) = *(const f32x4*)(kbar + 4 * tid);
        __syncthreads();
        if (blk <= 3) sel = (1u << blk) - 1u;
        else {
            unsigned qw[32];
            { const bf16_t* qp = Qb + (size_t)qrow * ldq + 64 * h;
#pragma unroll
              for (int c8 = 0; c8 < 8; ++c8) { const u32x4 w = *(const u32x4*)(qp + 8 * c8); qw[4 * c8] = w.x; qw[4 * c8 + 1] = w.y; qw[4 * c8 + 2] = w.z; qw[4 * c8 + 3] = w.w; } }
            float v1 = -3.0e38f, v2 = -3.0e38f, v3 = -3.0e38f; int i1 = 0, i2 = 0, i3 = 0;
#pragma unroll 1
            for (int j = 0; j < blk; ++j) { float g = 0.f; const LAS float* kb = kbl + j * 128 + 64 * h;
#pragma unroll
                for (int c4 = 0; c4 < 16; ++c4) { const f32x4 a = *(const LAS f32x4*)(kb + 4 * c4);
                    g += (bf_lo(qw[2 * c4]) * a[0] + bf_hi(qw[2 * c4]) * a[1]) + (bf_lo(qw[2 * c4 + 1]) * a[2] + bf_hi(qw[2 * c4 + 1]) * a[3]); }
                g += __shfl_xor(g, 32);
                if (g > v1) { v3 = v2; i3 = i2; v2 = v1; i2 = i1; v1 = g; i1 = j; }
                else if (g > v2) { v3 = v2; i3 = i2; v2 = g; i2 = j; }
                else if (g > v3) { v3 = g; i3 = j; } }
            sel = (1u << i1) | (1u << i2) | (1u << i3);
        }
    }
    float cq2 = 0.f, qkb = 0.f;
    if (MODE == 1) { cq2 = cf[qrow] * LOG2E;
        float qs = 0.f;
#pragma unroll
        for (int s8 = 0; s8 < 8; ++s8) { const u32x4 w = __builtin_bit_cast(u32x4, qf[s8]);
            const float a0 = bf_lo(w.x), a1 = bf_hi(w.x), a2 = bf_lo(w.y), a3 = bf_hi(w.y), a4 = bf_lo(w.z), a5 = bf_hi(w.z), a6 = bf_lo(w.w), a7 = bf_hi(w.w);
            qs += (a0 * a0 + a1 * a1) + (a2 * a2 + a3 * a3) + (a4 * a4 + a5 * a5) + (a6 * a6 + a7 * a7); }
        qs += __shfl_xor(qs, 32);
        qkb = C2 * sqrtf(qs) * sqrtf(__uint_as_float(*kmaxp)) * 1.01f + 1.0f; }
    LAS unsigned* vote = (LAS unsigned*)(lds + AT_VOTE);
    float m_run = MASKV, l_run = 0.f;
    f32x16 o[4];
#pragma unroll
    for (int d = 0; d < 4; ++d)
#pragma unroll
        for (int r = 0; r < 16; ++r) o[d][r] = 0.f;
    u32x4 kreg[2][2], vreg[2][2]; float ckreg[2] = {0.f, 0.f};
    const int srow = tid >> 4, sch = tid & 15;
#define AT_LOAD(j, S_) do { _Pragma("unroll") for (int i_ = 0; i_ < 2; ++i_) { const size_t go = (size_t)(64 * (j) + srow + 32 * i_) * ldkv + sch * 8; kreg[S_][i_] = *(const u32x4*)(Kb + go); vreg[S_][i_] = *(const u32x4*)(Vb + go); } \
        if (MODE == 1 && tid < 64) ckreg[S_] = cf[64 * (j) + tid] * LOG2E; } while (0)
#define AT_STORE(b, S_) do { _Pragma("unroll") for (int i_ = 0; i_ < 2; ++i_) { *(LAS u32x4*)(lds + AT_K0 + (b) * AT_KBUF + (srow + 32 * i_) * AT_KSTR + sch * 16) = kreg[S_][i_]; \
        *(LAS u32x4*)(lds + AT_V0 + (b) * AT_VBUF + (srow + 32 * i_) * AT_VSTR + sch * 16) = vreg[S_][i_]; } if (MODE == 1 && tid < 64) *(LAS float*)(lds + AT_CK + (b) * 256 + tid * 4) = ckreg[S_]; } while (0)
    AT_LOAD(ntiles - 1, 0); AT_LOAD(ntiles - 2, 1); AT_STORE(0, 0);
    __syncthreads();
    bool done = false;
#pragma unroll 1
    for (int it0 = 0; it0 < ntiles; it0 += 2) {
#pragma unroll
      for (int half = 0; half < 2; ++half) {
        const int it = it0 + half, j = ntiles - 1 - it, cur = half;
        if (it + 2 < ntiles) AT_LOAD(j - 2, half);
        const int kv0 = 64 * j + 32 * kh;
        bool act = true;
        if (MODE != 2) act = !(kv0 > q0 + 32 * qg + 31);
        if (MODE == 1) {
            const float ckmin = *(LAS const float*)(lds + AT_CK + cur * 256 + (32 * kh + 31) * 4);
            const bool dead = __all((qkb + cq2 - ckmin) < (m_run - 40.0f));
            act = act && !dead;
            if (lane == 0) vote[(it & 1) * 8 + wid] = dead ? 0u : 1u;
        }
        if (act) {
            f32x16 p;
#pragma unroll
            for (int r = 0; r < 16; ++r) p[r] = 0.f;
            { LAS const unsigned char* kp = lds + AT_K0 + cur * AT_KBUF + (32 * kh + r32) * AT_KSTR + 16 * h;
#pragma unroll
              for (int s = 0; s < 8; ++s) { const bf16x8 kf = *(LAS const bf16x8*)(kp + 32 * s); p = __builtin_amdgcn_mfma_f32_32x32x16_bf16(kf, qf[s], p, 0, 0, 0); } }
            bool lane_on = true;
            if (MODE == 0) { const int jb = j >> 2; lane_on = (jb == blk) || ((sel >> jb) & 1u); }
            const bool need_mask = (MODE != 2) && ((kv0 + 31 > q0 + 32 * qg) || (MODE == 0 && __any(!lane_on)));
            float mx = MASKV;
            if (MODE == 1) {
#pragma unroll
                for (int g4 = 0; g4 < 4; ++g4) { const f32x4 ck4 = *(LAS const f32x4*)(lds + AT_CK + cur * 256 + (32 * kh + 8 * g4 + 4 * h) * 4);
#pragma unroll
                    for (int e = 0; e < 4; ++e) p[4 * g4 + e] = p[4 * g4 + e] * C2 + (cq2 - ck4[e]); }
            } else {
#pragma unroll
                for (int r = 0; r < 16; ++r) p[r] *= C2;
            }
            if (need_mask) {
#pragma unroll
                for (int r = 0; r < 16; ++r) { const int kvl = (r & 3) + 8 * (r >> 2) + 4 * h; if ((kv0 + kvl > qrow) || !lane_on) p[r] = MASKV; }
            }
#pragma unroll
            for (int r = 0; r < 16; ++r) mx = fmaxf(mx, p[r]);
            mx = fmaxf(mx, __shfl_xor(mx, 32));
            if (__any(mx > m_run)) {
                const float m_new = fmaxf(m_run, mx), alpha = __builtin_amdgcn_exp2f(m_run - m_new); m_run = m_new; l_run *= alpha;
#pragma unroll
                for (int d = 0; d < 4; ++d)
#pragma unroll
                    for (int r = 0; r < 16; ++r) o[d][r] *= alpha;
            }
            float ps = 0.f;
#pragma unroll
            for (int r = 0; r < 16; ++r) { p[r] = __builtin_amdgcn_exp2f(p[r] - m_run); ps += p[r]; }
            l_run += ps;
            bf16x8 pb[2];
#pragma unroll
            for (int s2 = 0; s2 < 2; ++s2) { u32x4 w; w.x = cvt_pk_bf16(p[8 * s2 + 0], p[8 * s2 + 1]); w.y = cvt_pk_bf16(p[8 * s2 + 2], p[8 * s2 + 3]); w.z = cvt_pk_bf16(p[8 * s2 + 4], p[8 * s2 + 5]); w.w = cvt_pk_bf16(p[8 * s2 + 6], p[8 * s2 + 7]);
                pb[s2] = __builtin_bit_cast(bf16x8, w); }
            LAS const unsigned char* vp = lds + AT_V0 + cur * AT_VBUF + (32 * kh + 4 * h + ((lane & 15) >> 2)) * AT_VSTR + (16 * ((lane >> 4) & 1) + 4 * (lane & 3)) * 2;
#pragma unroll
            for (int d = 0; d < 4; ++d)
#pragma unroll
                for (int s2 = 0; s2 < 2; ++s2) { const s16x4 lo = vtr(vp + (16 * s2) * AT_VSTR + 64 * d), hi = vtr(vp + (16 * s2 + 8) * AT_VSTR + 64 * d);
                    const bf16x8 vf = (bf16x8){lo[0], lo[1], lo[2], lo[3], hi[0], hi[1], hi[2], hi[3]};
                    o[d] = __builtin_amdgcn_mfma_f32_32x32x16_bf16(vf, pb[s2], o[d], 0, 0, 0); }
        }
        if (it + 1 < ntiles) AT_STORE(half ^ 1, half ^ 1);
        __syncthreads();
        if (MODE == 1) { const u32x4 v0 = *(LAS const u32x4*)(vote + (it & 1) * 8), v1 = *(LAS const u32x4*)(vote + (it & 1) * 8 + 4);
            if (((v0.x | v0.y) | (v0.z | v0.w) | (v1.x | v1.y) | (v1.z | v1.w)) == 0u) { done = true; break; } }
      }
      if (done) break;
    }
#undef AT_LOAD
#undef AT_STORE
    l_run += __shfl_xor(l_run, 32);
    LAS float* mrg = (LAS float*)lds;
    const int mi = qg * 64 + lane;
    if (kh == 1) {
#pragma unroll
        for (int d = 0; d < 4; ++d)
#pragma unroll
            for (int r = 0; r < 16; ++r) mrg[(d * 16 + r) * 256 + mi] = o[d][r];
        mrg[64 * 256 + mi] = m_run; mrg[65 * 256 + mi] = l_run;
    }
    __syncthreads();
    if (kh == 0) {
        const float m1 = mrg[64 * 256 + mi], l1 = mrg[65 * 256 + mi];
        const float mt = fmaxf(m_run, m1), a0 = __builtin_amdgcn_exp2f(m_run - mt), a1 = __builtin_amdgcn_exp2f(m1 - mt);
        const float inv = 1.0f / (l_run * a0 + l1 * a1);
        bf16_t* op = Ob + (size_t)qrow * ldo + 4 * h;
#pragma unroll
        for (int d = 0; d < 4; ++d)
#pragma unroll
            for (int g4 = 0; g4 < 4; ++g4) { float v[4];
#pragma unroll
                for (int e = 0; e < 4; ++e) { const int r = 4 * g4 + e; v[e] = (o[d][r] * a0 + mrg[(d * 16 + r) * 256 + mi] * a1) * inv; }
                u32x2 w; w.x = cvt_pk_bf16(v[0], v[1]); w.y = cvt_pk_bf16(v[2], v[3]); *(u32x2*)(op + 32 * d + 8 * g4) = w; }
    }
    __syncthreads();
}

__device__ __forceinline__ void rope_item(LAS unsigned char* lds, bf16_t* z, float* kbar_all, int it) {
    const int isk = it >> 7, b = (it >> 6) & 1, blk = (it >> 2) & 15, hh = it & 3, tid = otid(), tg = tid >> 6, dp = tid & 63;
    const int col = (isk ? Z_MK : Z_MQ) + hh * HD + dp;
    const float inv_freq = exp2f(-(float)dp * (13.287712379549449f / 64.0f));
    float s1 = 0.f, s2 = 0.f;
#pragma unroll 1
    for (int i0 = 0; i0 < 32; i0 += 8) {
        float x1[8], x2[8];
#pragma unroll
        for (int i = 0; i < 8; ++i) { const bf16_t* p = z + (size_t)(b * SEQ + blk * 256 + tg * 32 + i0 + i) * NZ + col; x1[i] = bf2f(p[0]); x2[i] = bf2f(p[64]); }
#pragma unroll
        for (int i = 0; i < 8; ++i) { const int t = blk * 256 + tg * 32 + i0 + i; bf16_t* p = z + (size_t)(b * SEQ + t) * NZ + col;
            const float ang = (float)t * inv_freq;
            double rev = (double)ang * 0.15915494309189535; rev -= floor(rev);
            const float rf = (float)rev, sn = __builtin_amdgcn_sinf(rf), cs = __builtin_amdgcn_cosf(rf);
            const float o1 = x1[i] * cs - x2[i] * sn, o2 = x2[i] * cs + x1[i] * sn;
            p[0] = (bf16_t)f2bf(o1); p[64] = (bf16_t)f2bf(o2); s1 += o1; s2 += o2; }
    }
    if (isk) {
        LAS float* red = (LAS float*)lds;
        red[tg * 128 + dp] = s1; red[tg * 128 + 64 + dp] = s2;
        __syncthreads();
        if (tid < 128) { float a = 0.f;
#pragma unroll
            for (int g = 0; g < 8; ++g) a += red[g * 128 + tid];
            kbar_all[((size_t)(b * NH + hh) * 16 + blk) * 128 + tid] = a * (1.0f / 256.0f); }
        __syncthreads();
    }
}
__device__ __forceinline__ void kmax_item(const bf16_t* z, unsigned* kmax2, int it) {
    const int b = it >> 6, blk = (it >> 2) & 15, hh = it & 3, tid = otid(), row = tid >> 1, hf = tid & 1;
    const bf16_t* p = z + (size_t)(b * SEQ + blk * 256 + row) * NZ + Z_FK + hh * HD + 64 * hf; float ss = 0.f;
#pragma unroll
    for (int c8 = 0; c8 < 8; ++c8) { const u32x4 w = *(const u32x4*)(p + 8 * c8);
        const float a0 = bf_lo(w.x), a1 = bf_hi(w.x), a2 = bf_lo(w.y), a3 = bf_hi(w.y), a4 = bf_lo(w.z), a5 = bf_hi(w.z), a6 = bf_lo(w.w), a7 = bf_hi(w.w);
        ss += (a0 * a0 + a1 * a1) + (a2 * a2 + a3 * a3) + (a4 * a4 + a5 * a5) + (a6 * a6 + a7 * a7); }
    ss += __shfl_xor(ss, 1);
#pragma unroll
    for (int o = 2; o < 64; o <<= 1) ss = fmaxf(ss, __shfl_xor(ss, o));
    if ((tid & 63) == 0) atomicMax(kmax2 + b * NH + hh, __float_as_uint(ss));
}
__device__ __forceinline__ float log_sigmoid_(float x) { return fminf(x, 0.f) - log1pf(expf(-fabsf(x))); }
__device__ __forceinline__ void cumsum_item(LAS unsigned char* lds, const float* ff, const float* bias, float* cf, int it) {
    const int b = it >> 2, hh = it & 3, tid = otid(), lane = tid & 63, wid = tid >> 6;
    const float bi = bias[hh]; float v[8]; float run = 0.f;
#pragma unroll
    for (int i = 0; i < 8; ++i) { run += log_sigmoid_(ff[(size_t)(b * SEQ + tid * 8 + i) * 4 + hh] + bi); v[i] = run; }
    float sc = run;
#pragma unroll
    for (int o = 1; o < 64; o <<= 1) { const float t = __shfl_up(sc, o); if (lane >= o) sc += t; }
    LAS float* wt = (LAS float*)lds;
    if (lane == 63) wt[wid] = sc;
    __syncthreads();
    float off = sc - run;
    for (int w = 0; w < wid; ++w) off += wt[w];
#pragma unroll
    for (int i = 0; i < 8; ++i) cf[(size_t)(b * NH + hh) * SEQ + tid * 8 + i] = v[i] + off;
    __syncthreads();
}
template <int W>
__device__ __forceinline__ void pool_rows(const bf16_t* z, bf16_t* y3, int r0, int c) {
    float v[32 + W - 1];
    const int bstart = r0 & ~(SEQ - 1);
#pragma unroll
    for (int i = 0; i < 32 + W - 1; ++i) { const int row = r0 - (W - 1) + i; v[i] = (row >= bstart) ? bf2f(z[(size_t)row * NZ + Z_PIN + c]) : 0.f; }
    float s = 0.f;
#pragma unroll
    for (int i = 0; i < W - 1; ++i) s += v[i];
#pragma unroll
    for (int t = 0; t < 32; ++t) { s += v[t + W - 1]; const int tl = (r0 + t) & (SEQ - 1); const float cnt = (float)((tl + 1 < W) ? (tl + 1) : W);
        y3[(size_t)(r0 + t) * BW + c] = (bf16_t)f2bf(s / cnt - v[t + W - 1]); s -= v[t]; }
}
__device__ __forceinline__ void pool_item(const bf16_t* z, bf16_t* y3, int it) {
    const int c = otid(), g = __builtin_amdgcn_readfirstlane(c >> 7);
    if (g == 0) pool_rows<2>(z, y3, it * 32, c); else if (g == 1) pool_rows<4>(z, y3, it * 32, c); else if (g == 2) pool_rows<8>(z, y3, it * 32, c); else pool_rows<16>(z, y3, it * 32, c);
}

constexpr int HG_STR = 132;
constexpr int HG_Q = 0, HG_K = 64 * HG_STR * 4, HG_B = 2 * 64 * HG_STR * 4, HG_ATT = 3 * 64 * HG_STR * 4, HG_TOT = HG_ATT + 64 * 65 * 4;
__device__ __forceinline__ float hgrn_lb(const float* lbl, int layer, int c) { if (layer == 0) return 0.f; const float g0 = lbl[c], g1 = lbl[512 + c]; return 1.0f / (1.0f + expf(g0 - g1)); }
template <bool WITH_Q>
__device__ __forceinline__ void hgrn_load(LAS unsigned char* lds, const bf16_t* z, const float* lbl, int layer, int row0, int hh) {
    const int tid = otid();
    LAS float* Qm = (LAS float*)(lds + HG_Q); LAS float* Km = (LAS float*)(lds + HG_K); LAS float* Bm = (LAS float*)(lds + HG_B); LAS float* tot = (LAS float*)(lds + HG_TOT);
    { const int d8 = (tid & 15) * 8, r0 = tid >> 4;
#pragma unroll
      for (int rr = 0; rr < 2; ++rr) { const int r = r0 + 32 * rr; const bf16_t* zp = z + (size_t)(row0 + r) * NZ + hh * HD + d8;
          const u32x4 wf = *(const u32x4*)(zp + Z_HF); const unsigned wfa[4] = {wf.x, wf.y, wf.z, wf.w};
          u32x4 wq = (u32x4){0, 0, 0, 0}; if (WITH_Q) wq = *(const u32x4*)(zp + Z_HQ); const unsigned wqa[4] = {wq.x, wq.y, wq.z, wq.w};
#pragma unroll
          for (int e = 0; e < 8; ++e) { const unsigned w = wfa[e >> 1]; const float zf = (e & 1) ? bf_hi(w) : bf_lo(w);
              const float lb = hgrn_lb(lbl, layer, hh * HD + d8 + e), sg = 1.0f / (1.0f + expf(-zf));
              Bm[r * HG_STR + d8 + e] = __builtin_amdgcn_logf(lb + (1.0f - lb) * sg);     Km[r * HG_STR + d8 + e] = (1.0f - lb) * (1.0f - sg);
              if (WITH_Q) { const unsigned q = wqa[e >> 1]; Qm[r * HG_STR + d8 + e] = (e & 1) ? bf_hi(q) : bf_lo(q); } } } }
    __syncthreads();
    const int d = tid & 127, qr = tid >> 7; float run = 0.f;
#pragma unroll
    for (int i = 0; i < 16; ++i) { run += Bm[(16 * qr + i) * HG_STR + d]; Bm[(16 * qr + i) * HG_STR + d] = run; }
    tot[qr * 128 + d] = run;
    __syncthreads();
    float off = 0.f;
    for (int q2 = 0; q2 < qr; ++q2) off += tot[q2 * 128 + d];
#pragma unroll
    for (int i = 0; i < 16; ++i) Bm[(16 * qr + i) * HG_STR + d] += off;
    __syncthreads();
}
__device__ __forceinline__ void hgrn_local_item(LAS unsigned char* lds, const bf16_t* z, const float* lbl, int layer, float* HS, float* HDEC, int it) {
    const int b = it >> 8, hh = (it >> 6) & 3, c = it & 63, row0 = b * SEQ + c * 64, tid = otid();
    hgrn_load<false>(lds, z, lbl, layer, row0, hh);
    LAS float* Vm = (LAS float*)(lds + HG_Q); LAS float* Km = (LAS float*)(lds + HG_K); LAS float* Bm = (LAS float*)(lds + HG_B);
    { const int d8 = (tid & 15) * 8, r0 = tid >> 4;
#pragma unroll
      for (int rr = 0; rr < 2; ++rr) { const int r = r0 + 32 * rr; const u32x4 wv = *(const u32x4*)(z + (size_t)(row0 + r) * NZ + Z_HI + hh * HD + d8); const unsigned wa[4] = {wv.x, wv.y, wv.z, wv.w};
#pragma unroll
          for (int e = 0; e < 8; ++e) Vm[r * HG_STR + d8 + e] = (e & 1) ? bf_hi(wa[e >> 1]) : bf_lo(wa[e >> 1]); } }
    { const int d = tid & 127, qr = tid >> 7; const float bl = Bm[63 * HG_STR + d];
#pragma unroll
      for (int i = 0; i < 16; ++i) { const int s = 16 * qr + i; Km[s * HG_STR + d] *= __builtin_amdgcn_exp2f(bl - Bm[s * HG_STR + d]); }
      if (qr == 0) HDEC[(size_t)it * 128 + d] = __builtin_amdgcn_exp2f(bl); }
    __syncthreads();
    { const int wv = __builtin_amdgcn_readfirstlane(tid >> 6), ln = tid & 63, r32 = ln & 31, h2 = ln >> 5, eb = wv & 3;
      float* dst = HS + (size_t)it * 16384;
#pragma unroll
      for (int q = 0; q < 2; ++q) { const int db = (wv >> 2) * 2 + q; f32x16 c;
#pragma unroll
          for (int r = 0; r < 16; ++r) c[r] = 0.f;
#pragma unroll 8
          for (int kk = 0; kk < 32; ++kk) { const float av = Km[(2 * kk + h2) * HG_STR + 32 * db + r32], bv = Vm[(2 * kk + h2) * HG_STR + 32 * eb + r32];
              c = __builtin_amdgcn_mfma_f32_32x32x2f32(av, bv, c, 0, 0, 0); }
#pragma unroll
          for (int r = 0; r < 16; ++r) dst[(32 * db + (r & 3) + 8 * (r >> 2) + 4 * h2) * 128 + 32 * eb + r32] = c[r]; } }
    __syncthreads();
}
__device__ __forceinline__ void hgrn_scan(float* HS, const float* HDEC, int gtid, int gthreads) {
    for (int el = gtid; el < 8 * 16384; el += gthreads) { const int bh = el >> 14, de = el & 16383, d = de >> 7; float st = 0.f;
        float* p = HS + (size_t)bh * 64 * 16384 + de; const float* dc = HDEC + (size_t)bh * 64 * 128 + d;
#pragma unroll 8
        for (int c = 0; c < 64; ++c) { const float t = p[(size_t)c * 16384]; p[(size_t)c * 16384] = st; st = dc[c * 128] * st + t; } }
}
__device__ __forceinline__ void hgrn_out_item(LAS unsigned char* lds, const bf16_t* z, const float* lbl, int layer, const float* HS, const float* norm_g, bf16_t* y2, int it) {
    const int b = it >> 8, hh = (it >> 6) & 3, c = it & 63, row0 = b * SEQ + c * 64, tid = otid();
    hgrn_load<true>(lds, z, lbl, layer, row0, hh);
    LAS float* Qm = (LAS float*)(lds + HG_Q); LAS float* Km = (LAS float*)(lds + HG_K); LAS float* Bm = (LAS float*)(lds + HG_B); LAS float* At = (LAS float*)(lds + HG_ATT);
    { const int d8 = (tid & 15) * 8, r0 = tid >> 4;
#pragma unroll
      for (int rr = 0; rr < 2; ++rr) { const int r = r0 + 32 * rr;
#pragma unroll
          for (int e = 0; e < 8; ++e) { const float dl = Bm[r * HG_STR + d8 + e] - Bm[31 * HG_STR + d8 + e];
              Qm[r * HG_STR + d8 + e] *= __builtin_amdgcn_exp2f(dl); Km[r * HG_STR + d8 + e] *= __builtin_amdgcn_exp2f(-dl); } } }
    __syncthreads();
    { const int t = tid >> 3, sg = tid & 7; float a[8];
#pragma unroll
      for (int j = 0; j < 8; ++j) a[j] = 0.f;
      for (int d = 0; d < 128; d += 4) { const f32x4 q = *(const LAS f32x4*)(Qm + t * HG_STR + d);
#pragma unroll
          for (int j = 0; j < 8; ++j) { const int s = sg + 8 * j; if (s <= t) { const f32x4 k = *(const LAS f32x4*)(Km + s * HG_STR + d);
              a[j] += (q[0] * k[0] + q[1] * k[1]) + (q[2] * k[2] + q[3] * k[3]); } } }
#pragma unroll
      for (int j = 0; j < 8; ++j) At[t * 65 + sg + 8 * j] = a[j]; }
    __syncthreads();
    const float* Sg = HS + (size_t)it * 16384;
    f32x4 sreg[4];
#pragma unroll
    for (int i = 0; i < 4; ++i) sreg[i] = *(const f32x4*)(Sg + (size_t)(tid + 512 * i) * 4);
    { const int d8 = (tid & 15) * 8, r0 = tid >> 4;
#pragma unroll
      for (int rr = 0; rr < 2; ++rr) { const int r = r0 + 32 * rr; const u32x4 wv = *(const u32x4*)(z + (size_t)(row0 + r) * NZ + Z_HI + hh * HD + d8); const unsigned wa[4] = {wv.x, wv.y, wv.z, wv.w};
#pragma unroll
          for (int e = 0; e < 8; ++e) { Km[r * HG_STR + d8 + e] = (e & 1) ? bf_hi(wa[e >> 1]) : bf_lo(wa[e >> 1]); Qm[r * HG_STR + d8 + e] *= __builtin_amdgcn_exp2f(Bm[31 * HG_STR + d8 + e]); } } }
    __syncthreads();
    const int wv = __builtin_amdgcn_readfirstlane(tid >> 6), ln = tid & 63, r32 = ln & 31, h2 = ln >> 5, tb = wv >> 2, eb = wv & 3;
    f32x16 oc;
#pragma unroll
    for (int r = 0; r < 16; ++r) oc[r] = 0.f;
#pragma unroll 1
    for (int hf = 0; hf < 2; ++hf) {
#pragma unroll
        for (int i = 0; i < 4; ++i) { const int f4 = tid + 512 * i, dr = f4 >> 5, ec = (f4 & 31) * 4; *(LAS f32x4*)(Bm + dr * HG_STR + ec) = sreg[i]; }
        __syncthreads();
        if (hf == 0) {
#pragma unroll
            for (int i = 0; i < 4; ++i) sreg[i] = *(const f32x4*)(Sg + 8192 + (size_t)(tid + 512 * i) * 4); }
#pragma unroll 8
        for (int kk = 0; kk < 32; ++kk) { const float av = Qm[(32 * tb + r32) * HG_STR + 64 * hf + 2 * kk + h2], bv = Bm[(2 * kk + h2) * HG_STR + 32 * eb + r32];
            oc = __builtin_amdgcn_mfma_f32_32x32x2f32(av, bv, oc, 0, 0, 0); }
        __syncthreads();
    }
#pragma unroll 8
    for (int kk = 0; kk < 32; ++kk) { const float av = At[(32 * tb + r32) * 65 + 2 * kk + h2], bv = Km[(2 * kk + h2) * HG_STR + 32 * eb + r32];
        oc = __builtin_amdgcn_mfma_f32_32x32x2f32(av, bv, oc, 0, 0, 0); }
    { LAS float* red = Bm;
#pragma unroll
      for (int r = 0; r < 16; ++r) { float ss = oc[r] * oc[r];
#pragma unroll
          for (int o = 1; o < 32; o <<= 1) ss += __shfl_xor(ss, o);
          if (r32 == 0) red[(32 * tb + (r & 3) + 8 * (r >> 2) + 4 * h2) * 4 + eb] = ss; }
      __syncthreads();
      const int e = 32 * eb + r32; const float ng = norm_g[hh * HD + e];
#pragma unroll
      for (int r = 0; r < 16; ++r) { const int t = 32 * tb + (r & 3) + 8 * (r >> 2) + 4 * h2; const f32x4 pr = *(const LAS f32x4*)(red + t * 4);
          const float rs = 1.0f / sqrtf(((pr[0] + pr[1]) + (pr[2] + pr[3])) * (1.0f / 128.0f) + EPS);
          const size_t row = (size_t)(row0 + t); const float g = bf2f(z[row * NZ + Z_HG + hh * HD + e]);
          y2[row * BW + hh * HD + e] = (bf16_t)f2bf(oc[r] * rs * ng * g * sigmoidf_(g)); } }
    __syncthreads();
}

__device__ __forceinline__ void wpool_item(const float* pool_w, const float* pool_scale, const float* wb3, bf16_t* dst, int it) {
    const int g = (it >> 5) & 3, c0 = ((it >> 2) & 7) * 16, nn = (it & 3) * 512 + otid();
    float acc[16];
#pragma unroll
    for (int i = 0; i < 16; ++i) acc[i] = 0.f;
    for (int e = 0; e < 128; ++e) { const float wb = wb3[(size_t)(g * 128 + e) * DM + nn] * pool_scale[g * 128 + e];
#pragma unroll
        for (int i = 0; i < 16; ++i) acc[i] += pool_w[((size_t)g * 128 + c0 + i) * 128 + e] * wb; }
    u32x4 w0, w1; w0.x = pk2(acc[0], acc[1]); w0.y = pk2(acc[2], acc[3]); w0.z = pk2(acc[4], acc[5]); w0.w = pk2(acc[6], acc[7]);
    w1.x = pk2(acc[8], acc[9]); w1.y = pk2(acc[10], acc[11]); w1.z = pk2(acc[12], acc[13]); w1.w = pk2(acc[14], acc[15]);
    bf16_t* p = dst + (size_t)nn * BW + g * 128 + c0; *(u32x4*)p = w0; *(u32x4*)(p + 8) = w1;
}

__device__ __forceinline__ void load_wff(LAS float* dst, const float* win) {
    const int tid = otid();
#pragma unroll
    for (int i = 0; i < 4; ++i) { const int k = tid + 512 * i; *(LAS f32x4*)(dst + 4 * k) = *(const f32x4*)(win + (size_t)k * DIN_SRC + FF_SRC_COL); }
    __syncthreads();
}
__device__ __forceinline__ void ff_row(int lane, const bf16_t* hn, const LAS float* wff, float* ff) {
    asm volatile("" : "+v"(lane));
    f32x4 fa = (f32x4){0.f, 0.f, 0.f, 0.f};
#pragma unroll
    for (int j = 0; j < 8; ++j) { const u32x2 w = *(const u32x2*)(hn + 4 * lane + 256 * j); const float y[4] = {bf_lo(w.x), bf_hi(w.x), bf_lo(w.y), bf_hi(w.y)};
#pragma unroll
        for (int e = 0; e < 4; ++e) { const f32x4 wv = *(const LAS f32x4*)(wff + (4 * lane + 256 * j + e) * 4); fa = fa + wv * y[e]; } }
    fa[0] = wave_sum(fa[0]); fa[1] = wave_sum(fa[1]); fa[2] = wave_sum(fa[2]); fa[3] = wave_sum(fa[3]); if (lane == 0) *(f32x4*)ff = fa;
}
constexpr int LDS_BYTES = 147456;
struct LayerW { bf16_t *win, *wbr, *wout, *wxq, *wxkv, *wxo, *wup, *wdn; };
__device__ __forceinline__ LayerW layer_w(unsigned char* ws, int l) {
    LayerW w; unsigned char* p = ws + OFF_W + (size_t)l * SZ_WL;
    w.win = (bf16_t*)p; p += SZ_WIN; w.wbr = (bf16_t*)p; p += SZ_WBR; w.wout = (bf16_t*)p; p += SZ_WOUT; w.wxq = (bf16_t*)p; p += SZ_WXQ;
    w.wxkv = (bf16_t*)p; p += SZ_WXKV; w.wxo = (bf16_t*)p; p += SZ_WXO; w.wup = (bf16_t*)p; p += SZ_WUP; w.wdn = (bf16_t*)p; return w;
}
constexpr int I_INA = 32 * 96, I_INB = 32 * 336, I_BR = 8 * 64, I_OUT = 32 * 64, I_XQ = 32 * 16, I_XKV = 32 * 32, I_XO = 8 * 64, I_UP = 32 * 256, I_DN = 128 * 64;
constexpr int I_LAYER = I_INA + I_INB + 3 * I_BR + I_OUT + I_XQ + I_XKV + I_XO + I_UP + I_DN;
constexpr int TR_TOTAL = 2 * I_LAYER;
constexpr int TR_DEFER_C = 12288, TR_DEFER_A = 3200;
constexpr int TR_P0_END = TR_TOTAL - TR_DEFER_C - TR_DEFER_A, TR_A_END = TR_TOTAL - TR_DEFER_C;
static_assert(TR_P0_END >= I_LAYER + (I_LAYER - I_UP - I_DN), "only layer-1 MLP weights may be deferred");
__device__ __forceinline__ TrItem tr_item(const Params& P, unsigned char* ws, int it, int& ldw_) {
    const int l = it / I_LAYER; int r = it - l * I_LAYER; const LayerW w = layer_w(ws, l);
    const float* src; int K, nc; bf16_t* dst;
    if (r < I_INA) { src = P.w_in + (size_t)l * DM * DIN_SRC; ldw_ = DIN_SRC; K = DM; nc = 3072; dst = w.win; }
    else if ((r -= I_INA) < I_INB) { src = P.w_in + (size_t)l * DM * DIN_SRC + 3076; ldw_ = DIN_SRC; K = DM; nc = 10752; dst = w.win + (size_t)3072 * DM; }
    else if ((r -= I_INB) < 3 * I_BR) { const int n = r / I_BR; r -= n * I_BR; src = P.w_branch + ((size_t)l * 4 + n) * BW * DM; ldw_ = DM; K = BW; nc = DM; dst = w.wbr + (size_t)n * DM * BW; }
    else if ((r -= 3 * I_BR) < I_OUT) { src = P.w_mix_out + (size_t)l * DM * DM; ldw_ = DM; K = DM; nc = DM; dst = w.wout; }
    else if ((r -= I_OUT) < I_XQ) { src = P.xa_wq + (size_t)l * DM * BW; ldw_ = BW; K = DM; nc = BW; dst = w.wxq; }
    else if ((r -= I_XQ) < I_XKV) { src = P.xa_wkv + (size_t)l * DM * 1024; ldw_ = 1024; K = DM; nc = 1024; dst = w.wxkv; }
    else if ((r -= I_XKV) < I_XO) { src = P.xa_wo + (size_t)l * BW * DM; ldw_ = DM; K = BW; nc = DM; dst = w.wxo; }
    else if ((r -= I_XO) < I_UP) { src = P.mlp_w_up + (size_t)l * DM * HID; ldw_ = HID; K = DM; nc = HID; dst = w.wup; }
    else { r -= I_UP; src = P.mlp_w_down + (size_t)l * HID * DM; ldw_ = DM; K = HID; nc = DM; dst = w.wdn; }
    return tr_decode(src, ldw_, K, nc, dst, r);
}
__device__ __forceinline__ void tr_run(const Params& P, unsigned char* ws, LAS float* scr, int lane, int it0, int it_end, int worker, int nworkers) {
    int it = it0 + worker; TrItem c0, c1, c2; c0.src = nullptr; c0.dst = nullptr; c0.K = 0; c1 = c0; c2 = c0; f32x4 v0[8], v1[8], v2[8]; int ldt = 0;
    if (it < it_end) { c0 = tr_item(P, ws, it, ldt); tr_load(c0, ldt, lane, v0); }
    if (it + nworkers < it_end) { c1 = tr_item(P, ws, it + nworkers, ldt); tr_load(c1, ldt, lane, v1); }
#define TR_STEP(VC, CC, VF, CF_) { if (it >= it_end) break; const int n2 = it + 2 * nworkers; if (n2 < it_end) { CF_ = tr_item(P, ws, n2, ldt); tr_load(CF_, ldt, lane, VF); } tr_process(CC, scr, lane, VC); it += nworkers; }
#pragma unroll 1
    for (;;) {
        TR_STEP(v0, c0, v2, c2)
        TR_STEP(v1, c1, v0, c0)
        TR_STEP(v2, c2, v1, c1)
    }
#undef TR_STEP
}
#ifndef PHM
#define PHM 0xFFFFFFFFu
#endif
#define GRID_SYNC() do { asm volatile("s_waitcnt vmcnt(0) lgkmcnt(0)" ::: "memory"); __syncthreads(); \
    if (otid() == 0) { __builtin_amdgcn_fence(__ATOMIC_RELEASE, "agent"); asm volatile("s_waitcnt vmcnt(0)" ::: "memory"); \
        bar_gen += 1u; const unsigned target_ = bar_gen * (unsigned)G; \
        __hip_atomic_fetch_add(bar_ctr, 1u, __ATOMIC_RELAXED, __HIP_MEMORY_SCOPE_AGENT); \
        while (__hip_atomic_load(bar_ctr, __ATOMIC_RELAXED, __HIP_MEMORY_SCOPE_AGENT) < target_) __builtin_amdgcn_s_sleep(1); \
        __builtin_amdgcn_fence(__ATOMIC_ACQUIRE, "agent"); asm volatile("s_waitcnt vmcnt(0)" ::: "memory"); } \
    __syncthreads(); } while (0)

__global__ void __launch_bounds__(512, 2) fwd_megakernel(Params P) {
    extern __shared__ __attribute__((aligned(16))) unsigned char lds_raw[];
    LAS unsigned char* lds = (LAS unsigned char*)lds_raw;
    cg::grid_group grid = cg::this_grid();
    unsigned* bar_ctr = (unsigned*)(P.ws + OFF_BAR); unsigned bar_gen = 0u;
    if (blockIdx.x == 0) { unsigned* ctl = (unsigned*)(P.ws + OFF_BAR); const int t_ = otid();
        for (int i = t_; i < (int)(CTL_BYTES / 16); i += 512) *(u32x4*)(ctl + 4 * i) = (u32x4){0u, 0u, 0u, 0u};
        asm volatile("s_waitcnt vmcnt(0)" ::: "memory"); __syncthreads();
        if (t_ < 64) { __builtin_amdgcn_fence(__ATOMIC_RELEASE, "agent"); asm volatile("s_waitcnt vmcnt(0)" ::: "memory"); } __syncthreads(); }
    grid.sync();
    __builtin_amdgcn_fence(__ATOMIC_ACQUIRE, "agent"); asm volatile("s_waitcnt vmcnt(0)" ::: "memory"); __syncthreads();
    const int G = gridDim.x, bx = blockIdx.x, NGW = G * 8;
#define TID_VARS const int tid = otid(), lane = tid & 63, wave = __builtin_amdgcn_readfirstlane(tid >> 6), gw = bx * 8 + wave; (void)lane; (void)gw;
#define WS_PTRS unsigned char* ws = P.ws; asm volatile("" : "+s"(ws)); \
    bf16_t* Z = (bf16_t*)(ws + OFF_Z); bf16_t* HN = (bf16_t*)(ws + OFF_HN); bf16_t* Y = (bf16_t*)(ws + OFF_Y); bf16_t* MIX = (bf16_t*)(ws + OFF_MIX); \
    bf16_t* SRC = (bf16_t*)(ws + OFF_SRC); bf16_t* XQ = (bf16_t*)(ws + OFF_XQ); bf16_t* XO = (bf16_t*)(ws + OFF_XO); \
    float* HS = (float*)(ws + OFF_HS); float* HDEC = (float*)(ws + OFF_HDEC); float* KBAR = (float*)(ws + OFF_KBAR); float* CF = (float*)(ws + OFF_CF); float* FF = (float*)(ws + OFF_FF); \
    bf16_t* MEMN = (bf16_t*)(ws + OFF_MEMN); bf16_t* MEMKV = (bf16_t*)(ws + OFF_MEMKV); (void)Z; (void)HN; (void)Y; (void)MIX; (void)SRC; (void)XQ; (void)XO; (void)HS; (void)HDEC; (void)KBAR; (void)CF; (void)FF; (void)MEMN; (void)MEMKV;
    if (PHM & 1u) {
        WS_PTRS TID_VARS
        LAS float* scr = (LAS float*)(lds + wave * 8448);
        LAS float* wffl = (LAS float*)(lds + 69632);
        load_wff(wffl, P.w_in);
        tr_run(P, ws, scr, lane, 0, (G == 256 ? TR_P0_END : TR_TOTAL), gw, NGW);
#pragma unroll 1
        for (int it = bx; it < 256; it += G) { const int l = it >> 7; const LayerW w = layer_w(ws, l);
            wpool_item(P.pool_w + (size_t)l * 4 * 128 * 128, P.pool_scale + l * BW, P.w_branch + ((size_t)l * 4 + 3) * BW * DM, w.wbr + (size_t)3 * DM * BW, it); }
#pragma unroll 1
        for (int r = gw; r < 1024 + M; r += NGW) {
            if (r < 1024) { const int l = r >> 9, rr = r & 511;
                row_pass(false, true, false, lane, nullptr, nullptr, P.mem + (size_t)rr * DM, nullptr, P.xa_norm_mem + l * DM, MEMN + (size_t)r * DM, nullptr, nullptr); }
            else { const int r2 = r - 1024; row_pass(false, true, true, lane, nullptr, nullptr, P.x + (size_t)r2 * DM, nullptr, P.mix_norm_pre, HN + (size_t)r2 * DM, wffl, FF + (size_t)r2 * 4); }
        }
    }
    GRID_SYNC();

#pragma unroll 1
#ifndef PH_END
#define PH_END (14 * DEPTH)
#endif
    for (int ph = 0; ph < PH_END; ++ph) {
        const int l = ph / 14, k = ph - 14 * l;
        const bool fused_ok = (G >= 256);
        if (fused_ok && (k == 6 || k == 10 || (k == 13 && l + 1 == DEPTH))) continue;
        WS_PTRS TID_VARS
        const LayerW w = layer_w(ws, l);
        const bool is_gemm = (k == 0) | (k == 4) | (k == 5) | (k == 7) | (k == 9) | (k == 11) | (k == 12);
        if (is_gemm && ((PHM >> (k + 1)) & 1u)) {
            const int njobs = (k == 0 && l == 0) ? 1 + DEPTH : 1;
#pragma unroll 1
            for (int job = 0; job < njobs; ++job) {
                pg8::Gemm g; pg8::StaticOrder S; pg8::Epi E; E.G = nullptr; E.ldg = 0; E.MODE = 0;
                E.hold = nullptr; E.hout = nullptr; E.hn = nullptr; E.gpost = nullptr; E.gpre = nullptr; E.xb1 = nullptr; E.xb2 = nullptr; E.cnt1 = nullptr; E.cnt2 = nullptr; E.has_next = 0;
                int nsub = 1, c0 = 0, ksp = 1, ld = 0; long astr = 0, bstr = 0, ostr = 0; g.M = M;
                if (k == 0 && job == 0) { g.A = HN; g.Bt = w.win; g.N = NZ; g.K = DM; E.O = Z; }
                else if (k == 0) { const int l2 = job - 1; const LayerW w2 = layer_w(ws, l2);
                    g.A = MEMN + (size_t)l2 * 512 * DM; g.Bt = w2.wxkv; g.M = 512; g.N = 1024; g.K = DM; E.O = MEMKV + (size_t)l2 * 512 * 1024; c0 = (G >= 208 ? 192 : 0) + 8 * l2; }
                else if (k == 4) { g.A = Y; g.Bt = w.wbr; g.N = DM; g.K = BW; E.O = MIX; E.G = Z + Z_GL; E.ldg = NZ; E.MODE = 2; nsub = 4; astr = (long)M * BW * 2; bstr = (long)DM * BW * 2; }
                else if (k == 5) { g.A = MIX; g.Bt = w.wout; g.N = DM; g.K = DM; E.O = SRC; }
                else if (k == 7) { g.A = HN; g.Bt = w.wxq; g.N = BW; g.K = BW; ld = DM; E.O = MIX; ksp = 4; astr = BW * 2; bstr = BW * 2; ostr = (long)M * BW; }
                else if (k == 9) { g.A = XO; g.Bt = w.wxo; g.N = DM; g.K = BW; E.O = SRC; }
                else if (k == 11) { g.A = HN; g.Bt = w.wup; g.N = HID; g.K = DM; E.O = Z; E.MODE = 1; }
                else { g.A = Z; g.Bt = w.wdn; g.N = DM; g.K = HID; E.O = SRC; }
                if (fused_ok && (k == 5 || k == 9 || k == 12)) { const int gi = (k == 5) ? 0 : (k == 9) ? 1 : 2;
                    E.MODE = 3; E.hold = (l == 0 && k == 5) ? P.x : P.out; E.hout = P.out; E.hn = HN; E.has_next = !(k == 12 && l + 1 == DEPTH);
                    E.gpost = (k == 5 ? P.mix_norm_post : k == 9 ? P.xa_norm_post : P.mlp_norm_post) + l * DM;
                    E.gpre = (k == 5 ? P.xa_norm_pre + l * DM : k == 9 ? P.mlp_norm_pre + l * DM : P.mix_norm_pre + (l + 1 < DEPTH ? l + 1 : 0) * DM);
                    E.xb1 = (float*)(ws + OFF_XB); E.xb2 = E.xb1 + (size_t)M * 8;
                    E.cnt1 = (unsigned*)(ws + OFF_BAR + 4096) + (size_t)(((l * 3 + gi) * 2 + 0) * 32) * 64; E.cnt2 = E.cnt1 + 32 * 64; }
                E.ldc = g.N; g.lda = ld ? ld : g.K; g.ldb = ld ? ld : g.K;
                S.init(g.M, g.N, G, bx, nsub, astr, bstr, c0, ksp, ostr);
                pg8::gemm_phase(lds, g, S, E);
            }
            if (k == 0 && l == 0 && G == 256 && bx >= 216) tr_run(P, ws, (LAS float*)(lds + wave * 8448), lane, TR_P0_END, TR_A_END, (bx - 216) * 8 + wave, 40 * 8);
            if (k == 0) { const int cb = (G >= 216) ? 208 : 0; if (bx >= cb && bx < cb + 8) cumsum_item(lds, FF, P.fox_f_bias + l * NH, CF, bx - cb); }
        } else if (k == 1 && (PHM & 4u)) {
#pragma unroll 1
            for (int it = bx; it < 1160; it += G) {
                if (it < 256) rope_item(lds, Z, KBAR, it);
                else if (it < 264) { }
                else if (it < 776) hgrn_local_item(lds, Z, P.lb_logits, l, HS, HDEC, it - 264);
                else if (it < 1032) pool_item(Z, Y + (size_t)3 * M * BW, it - 776);
                else kmax_item(Z, (unsigned*)(ws + OFF_BAR + 2048) + l * 8, it - 1032);
            }
        } else if (k == 2 && (PHM & 8u)) {
#pragma unroll 1
            for (int p = bx; p < 256; p += G) {
                const int type = p >> 7, bh = (p >> 4) & 7, s = p & 15, b = bh >> 2, hh = bh & 3;
                const bf16_t* zb = Z + (size_t)b * SEQ * NZ + hh * HD;
#pragma unroll 1
                for (int kk = 0; kk < 2; ++kk) { const int qi = kk ? s : 31 - s;
                    if (type == 0) attn_unit<0>(lds, zb + Z_MQ, NZ, zb + Z_MK, zb + Z_MV, NZ, Y + (size_t)b * SEQ * BW + hh * HD, BW, qi * 128, 2 * qi + 2, nullptr, KBAR + (size_t)bh * 2048);
                    else attn_unit<1>(lds, zb + Z_FQ, NZ, zb + Z_FK, zb + Z_FV, NZ, Y + (size_t)M * BW + (size_t)b * SEQ * BW + hh * HD, BW, qi * 128, 2 * qi + 2, CF + (size_t)bh * SEQ, nullptr, 0, (const unsigned*)(ws + OFF_BAR + 2048) + l * 8 + bh); }
            }
            if (G == 256) { if (bx >= 128) { hgrn_scan(HS, HDEC, (bx - 128) * 512 + tid, 128 * 512);
                if (l == 0) tr_run(P, ws, (LAS float*)(lds + wave * 8448), lane, TR_A_END, TR_TOTAL, (bx - 128) * 8 + wave, 128 * 8); } }
            else hgrn_scan(HS, HDEC, bx * 512 + tid, G * 512);
        } else if (k == 3 && (PHM & 16u)) {
#pragma unroll 1
            for (int it = bx; it < 512; it += G) hgrn_out_item(lds, Z, P.lb_logits, l, HS, P.hgrn_out_norm + l * BW, Y + (size_t)2 * M * BW, it);
        } else if (k == 8 && (PHM & 512u)) {
#pragma unroll 1
            for (int p = bx; p < 256; p += G) { const int b = p >> 7, hh = (p >> 5) & 3, qi = p & 31;
                const bf16_t* kv = MEMKV + ((size_t)l * 512 + b * NMEM) * 1024 + hh * HD;
                attn_unit<2>(lds, MIX + (size_t)b * SEQ * BW + hh * HD, BW, kv, kv + 512, 1024, XO + (size_t)b * SEQ * BW + hh * HD, BW, qi * 128, 4, nullptr, nullptr, (size_t)M * BW); }
        } else if (fused_ok && k == 13) {
            load_wff((LAS float*)lds, P.w_in + (size_t)(l + 1) * DM * DIN_SRC);
#pragma unroll 1
            for (int r = gw; r < M; r += NGW) ff_row(lane, HN + (size_t)r * DM, (const LAS float*)lds, FF + (size_t)r * 4);
        } else if ((k == 6 || k == 10 || k == 13) && (PHM & 64u)) {
            const float* gpost = (k == 6 ? P.mix_norm_post : k == 10 ? P.xa_norm_post : P.mlp_norm_post) + l * DM;
            const float* gpre = (k == 6 ? P.xa_norm_pre + l * DM : k == 10 ? P.mlp_norm_pre + l * DM : P.mix_norm_pre + (l + 1 < DEPTH ? l + 1 : 0) * DM);
            const float* hin = (l == 0 && k == 6) ? P.x : P.out;
            const bool has_next = !(k == 13 && l + 1 == DEPTH), has_ff = (k == 13) && has_next;
            if (has_ff) load_wff((LAS float*)lds, P.w_in + (size_t)(l + 1 < DEPTH ? l + 1 : 0) * DM * DIN_SRC);
#pragma unroll 1
            for (int r = gw; r < M; r += NGW)
                row_pass(true, has_next, has_ff, lane, SRC + (size_t)r * DM, gpost, hin + (size_t)r * DM, P.out + (size_t)r * DM, gpre, HN + (size_t)r * DM, (const LAS float*)lds, FF + (size_t)r * 4);
        }
        if (ph + 1 < (fused_ok ? 14 * DEPTH - 1 : 14 * DEPTH)) GRID_SYNC();
    }
#ifdef DBG_OFF
    { const bf16_t* dbg = (const bf16_t*)(P.ws + DBG_OFF); const int t0 = bx * 512 + otid();
      for (size_t i = t0; i < (size_t)M * DM; i += (size_t)G * 512) P.out[i] = i < (size_t)(DBG_LEN) ? bf2f(dbg[i]) : 0.f; }
#endif
}

extern "C" void kernel_launch(void* const* d_in, const int* in_sizes, int n_in, void* d_out, int out_size, void* d_ws, size_t ws_size, hipStream_t stream) {
    static int grid_blocks = 0;
    if (grid_blocks == 0) {
        if (n_in != 22 || ws_size < WS_END) { fprintf(stderr, "kernel_launch: unexpected inputs (n_in %d, ws %zu, need %zu)\n", n_in, ws_size, (size_t)WS_END); grid_blocks = -1; return; }
        int dev = 0, cus = 0, per_cu = 0;
        (void)hipGetDevice(&dev); (void)hipDeviceGetAttribute(&cus, hipDeviceAttributeMultiprocessorCount, dev);
        (void)hipFuncSetAttribute((const void*)fwd_megakernel, hipFuncAttributeMaxDynamicSharedMemorySize, LDS_BYTES);
        (void)hipOccupancyMaxActiveBlocksPerMultiprocessor(&per_cu, (const void*)fwd_megakernel, 512, LDS_BYTES);
        if (per_cu < 1) fprintf(stderr, "kernel_launch: occupancy query says %d blocks per CU\n", per_cu);
        (void)hipGetLastError();
        grid_blocks = cus > 0 ? cus : 256;
    }
    if (grid_blocks < 0) return;
    Params p{};
    const float** pp = (const float**)&p;
    for (int i = 0; i < 22; ++i) pp[i] = (const float*)d_in[i];
    p.out = (float*)d_out; p.ws = (unsigned char*)d_ws;
    void* args[] = {&p};
    hipError_t e = hipLaunchCooperativeKernel((const void*)fwd_megakernel, dim3(grid_blocks), dim3(512), args, LDS_BYTES, stream);
    if (e != hipSuccess) fprintf(stderr, "cooperative launch failed: %s (grid %d)\n", hipGetErrorString(e), grid_blocks);
}
```

```cpp
#include <hip/hip_runtime.h>
#include <hip/hip_cooperative_groups.h>
#include <cstdio>
#include <cstdint>
namespace cg = cooperative_groups;

#define LAS __attribute__((address_space(3)))
typedef unsigned short bf16_t;
typedef short bf16x8 __attribute__((ext_vector_type(8)));
typedef short s16x4 __attribute__((ext_vector_type(4)));
typedef float f32x4 __attribute__((ext_vector_type(4)));
typedef float f32x16 __attribute__((ext_vector_type(16)));
typedef unsigned u32x4 __attribute__((ext_vector_type(4)));
typedef unsigned u32x2 __attribute__((ext_vector_type(2)));

constexpr int BATCH = 2, SEQ = 4096, DM = 2048, M = BATCH * SEQ, DEPTH = 2;
constexpr int DIN_SRC = 13828, NZ = 13824;
constexpr int Z_MQ = 0, Z_MK = 512, Z_MV = 1024, Z_FQ = 1536, Z_FK = 2048, Z_FV = 2560, Z_HQ = 3072, Z_HF = 3584, Z_HI = 4096, Z_HG = 4608, Z_PIN = 5120, Z_GL = 5632;
constexpr int FF_SRC_COL = 3072;
constexpr int NH = 4, HD = 128, BW = 512, HID = 8192, NMEM = 256;
constexpr float EPS = 1e-6f, MASKV = -1e30f, LOG2E = 1.4426950408889634f;

constexpr size_t MiB = 1u << 20;
constexpr size_t SZ_WIN = (size_t)NZ * DM * 2, SZ_WBR = (size_t)4 * DM * BW * 2, SZ_WOUT = (size_t)DM * DM * 2, SZ_WXQ = (size_t)BW * DM * 2, SZ_WXKV = (size_t)1024 * DM * 2,
                 SZ_WXO = (size_t)DM * BW * 2, SZ_WUP = (size_t)HID * DM * 2, SZ_WDN = (size_t)DM * HID * 2;
constexpr size_t SZ_WL = SZ_WIN + SZ_WBR + SZ_WOUT + SZ_WXQ + SZ_WXKV + SZ_WXO + SZ_WUP + SZ_WDN;
constexpr size_t OFF_W = 0;
constexpr size_t OFF_Z = ((OFF_W + 2 * SZ_WL + MiB - 1) / MiB) * MiB;
constexpr size_t OFF_HN = OFF_Z + (((size_t)M * NZ * 2 + MiB - 1) / MiB) * MiB;
constexpr size_t OFF_Y = OFF_HN + (size_t)M * DM * 2;
constexpr size_t OFF_MIX = OFF_Y + (size_t)4 * M * BW * 2;
constexpr size_t OFF_SRC = OFF_MIX + (size_t)M * DM * 2;
constexpr size_t OFF_XQ = OFF_SRC + (size_t)M * DM * 2;
constexpr size_t OFF_XO = OFF_XQ + (size_t)M * BW * 2;
constexpr size_t OFF_HS = OFF_XO + (size_t)M * BW * 2;
constexpr size_t OFF_HDEC = OFF_HS + (size_t)512 * 128 * 128 * 4;
constexpr size_t OFF_KBAR = OFF_HDEC + (size_t)512 * 128 * 4;
constexpr size_t OFF_CF = OFF_KBAR + (size_t)2 * 4 * 16 * 128 * 4;
constexpr size_t OFF_FF = OFF_CF + (size_t)8 * 4096 * 4;
constexpr size_t OFF_MEMN = OFF_FF + (size_t)M * 4 * 4;
constexpr size_t OFF_MEMKV = OFF_MEMN + (size_t)2 * 512 * DM * 2;
constexpr size_t OFF_LB = OFF_MEMKV + (size_t)2 * 512 * 1024 * 2;
constexpr size_t OFF_BAR = OFF_LB + 2 * 512 * 4;
constexpr size_t CTL_BYTES = 131072;
constexpr size_t OFF_XB = OFF_BAR + CTL_BYTES;
constexpr size_t WS_END = OFF_XB + 2 * (size_t)M * 8 * 4;

__device__ __forceinline__ int otid0() { int t = threadIdx.x; asm volatile("" : "+v"(t)); return t; }
namespace pg8 {
constexpr int BM = 256, BK = 64, HALF = 128, HTB = HALF * BK * 2, STAGE_BYTES = 8 * HTB, NXCD = 8, WGM = 4;
__host__ __device__ __forceinline__ int lds_byte(int r, int c) { const int st = (r >> 4) * 2 + (c >> 5), rr = r & 15, cc = c & 31, ob = rr * 64 + cc * 2; return st * 1024 + (ob ^ (((ob >> 9) & 1) << 5)); }
__host__ __device__ __forceinline__ void stage_rc(int b, int& R, int& C) { const int st = b / 1024, sb = b % 1024, swz = sb ^ (((sb >> 9) & 1) << 5); R = (st >> 1) * 16 + swz / 64; C = (st & 1) * 32 + (swz % 64) / 2; }
__host__ __device__ __forceinline__ int perm32(int rho) { const int n = rho >> 4, i = rho & 15; return 8 * (i >> 2) + 4 * n + (i & 3); }

struct Unit { int pm, pn, n; long aoff, boff, ooff; };
struct Gemm { const bf16_t* A; const bf16_t* Bt; int M, N, K, lda, ldb; };

struct StaticOrder {
    int nM, nN, nwg, G, c, nsub, c0, ksp; long astr, bstr, ostr;
    __device__ void init(int M_, int N_, int G_, int c_, int nsub_ = 1, long astr_ = 0, long bstr_ = 0, int c0_ = 0, int ksp_ = 1, long ostr_ = 0) { nM = M_ / BM; nN = N_ / BM; nwg = nM * nN; G = G_; c = c_; nsub = nsub_; astr = astr_; bstr = bstr_; c0 = c0_; ksp = ksp_; ostr = ostr_; }
    __device__ bool next(int i, Unit& u) const {
        if (c < c0) return false;
        const int ti = i / nsub; u.n = i - ti * nsub;
        const long L = (long)ti * G + (c - c0); if (L >= (long)nwg * ksp) return false;
        const int split = (int)(L / nwg);
        int wgid = (int)(L - (long)split * nwg); { const int q = nwg / NXCD, r = nwg % NXCD, xcd = wgid % NXCD, off = wgid / NXCD; wgid = (xcd < r ? xcd * (q + 1) : r * (q + 1) + (xcd - r) * q) + off; }
        const int nig = WGM * nN, gid = wgid / nig, fm = gid * WGM, gsz = (nM - fm) < WGM ? (nM - fm) : WGM;
        u.pm = fm + ((wgid % nig) % gsz); u.pn = (wgid % nig) / gsz; u.aoff = (u.n + split) * astr; u.boff = (u.n + split) * bstr; u.ooff = split * ostr; return true;
    }
};

typedef float f32x2_t __attribute__((ext_vector_type(2))); typedef __bf16 bf16x2_t __attribute__((ext_vector_type(2)));
__device__ __forceinline__ unsigned cvt_pk_bf16(float lo, float hi) { f32x2_t v = {lo, hi}; bf16x2_t b = __builtin_convertvector(v, bf16x2_t); return __builtin_bit_cast(unsigned, b); }
__device__ __forceinline__ float bf_lo(unsigned w) { return __uint_as_float(w << 16); }
__device__ __forceinline__ float bf_hi(unsigned w) { return __uint_as_float(w & 0xffff0000u); }
__device__ __forceinline__ float sigmoidf_(float x) { return __builtin_amdgcn_rcpf(1.0f + __builtin_amdgcn_exp2f(-x * LOG2E)); }

#define RLX_AGENT __ATOMIC_RELAXED, __HIP_MEMORY_SCOPE_AGENT
struct Epi {
    static constexpr bool PERM = true;
    bf16_t* O; int ldc; const bf16_t* G; int ldg; int MODE;
    const float* hold; float* hout; bf16_t* hn; const float* gpost; const float* gpre; float* xb1; float* xb2; unsigned* cnt1; unsigned* cnt2; int has_next;
    __device__ __forceinline__ void operator()(const f32x4 (&acc)[2][2][4][2], const Unit& u, int wr, int wc, int fr, int fq) const {
        const int row0 = u.pm * BM + wr * 64 + fr, col0 = u.pn * BM + wc * 32 + 8 * fq;
        if (MODE == 4 && u.pn * BM >= Z_GL) {
#pragma unroll
            for (int ai = 0; ai < 2; ++ai)
#pragma unroll
                for (int m = 0; m < 4; ++m) { unsigned char* gp = (unsigned char*)(O + (size_t)(row0 + ai * HALF + m * 16) * ldc + Z_GL) + (col0 - Z_GL);
#pragma unroll
                    for (int bj = 0; bj < 2; ++bj) { const f32x4 v0 = acc[ai][bj][m][0], v1 = acc[ai][bj][m][1]; unsigned q[8];
#pragma unroll
                        for (int e = 0; e < 4; ++e) { q[e] = (unsigned)(sigmoidf_(v0[e]) * 255.0f + 0.5f); q[4 + e] = (unsigned)(sigmoidf_(v1[e]) * 255.0f + 0.5f); }
                        u32x2 w; w.x = q[0] | (q[1] << 8) | (q[2] << 16) | (q[3] << 24); w.y = q[4] | (q[5] << 8) | (q[6] << 16) | (q[7] << 24);
                        *(u32x2*)(gp + bj * HALF) = w; } }
            return;
        }
#pragma unroll
        for (int ai = 0; ai < 2; ++ai)
#pragma unroll
            for (int m = 0; m < 4; ++m) { const size_t row = (size_t)(row0 + ai * HALF + m * 16); bf16_t* rowp = O + u.ooff + row * ldc + col0;
#pragma unroll
                for (int bj = 0; bj < 2; ++bj) { f32x4 v0 = acc[ai][bj][m][0], v1 = acc[ai][bj][m][1];
                    if (MODE == 1) {
#pragma unroll
                        for (int e = 0; e < 4; ++e) { const float a = fmaxf(v0[e], 0.f), b = fmaxf(v1[e], 0.f); v0[e] = a * a; v1[e] = b * b; } }
                    if (MODE == 2) {
                        const u32x2 g = *(const u32x2*)((const unsigned char*)(G + row * ldg) + (size_t)u.n * DM + col0 + bj * HALF);
                        const float k255 = 1.0f / 255.0f;
                        v0[0] *= (float)(g.x & 0xffu) * k255; v0[1] *= (float)((g.x >> 8) & 0xffu) * k255; v0[2] *= (float)((g.x >> 16) & 0xffu) * k255; v0[3] *= (float)(g.x >> 24) * k255;
                        v1[0] *= (float)(g.y & 0xffu) * k255; v1[1] *= (float)((g.y >> 8) & 0xffu) * k255; v1[2] *= (float)((g.y >> 16) & 0xffu) * k255; v1[3] *= (float)(g.y >> 24) * k255;
                        if (u.n > 0) { const u32x4 o = *(const u32x4*)(rowp + bj * HALF);
                            v0[0] += bf_lo(o.x); v0[1] += bf_hi(o.x); v0[2] += bf_lo(o.y); v0[3] += bf_hi(o.y); v1[0] += bf_lo(o.z); v1[1] += bf_hi(o.z); v1[2] += bf_lo(o.w); v1[3] += bf_hi(o.w); } }
                    u32x4 w; w.x = cvt_pk_bf16(v0[0], v0[1]); w.y = cvt_pk_bf16(v0[2], v0[3]); w.z = cvt_pk_bf16(v1[0], v1[1]); w.w = cvt_pk_bf16(v1[2], v1[3]);
                    *(u32x4*)(rowp + bj * HALF) = w; } }
    }
    __device__ __forceinline__ void panel_rstd(const f32x4 (&v)[2][2][4][2], const Unit& u, int wr, int wc, int fr, int fq, LAS unsigned char* lds, int tid, float* xb, unsigned* cnt) const {
        LAS float* Pt = (LAS float*)lds; LAS float* St = (LAS float*)(lds + 4096);
        const int wid = __builtin_amdgcn_readfirstlane(tid >> 6), lane = tid & 63;
#pragma unroll
        for (int ai = 0; ai < 2; ++ai)
#pragma unroll
            for (int m = 0; m < 4; ++m) { float s = 0.f;
#pragma unroll
                for (int bj = 0; bj < 2; ++bj)
#pragma unroll
                    for (int n = 0; n < 2; ++n) { const f32x4 x = v[ai][bj][m][n]; s += (x[0] * x[0] + x[1] * x[1]) + (x[2] * x[2] + x[3] * x[3]); }
                s += __shfl_xor(s, 16); s += __shfl_xor(s, 32);
                if (fq == 0) Pt[(ai * HALF + wr * 64 + m * 16 + fr) * 4 + wc] = s; }
        asm volatile("s_waitcnt lgkmcnt(0)" ::: "memory"); __builtin_amdgcn_s_barrier(); asm volatile("" ::: "memory");
        if (tid < 256) { const float tot = (Pt[tid * 4 + 0] + Pt[tid * 4 + 1]) + (Pt[tid * 4 + 2] + Pt[tid * 4 + 3]);
            __hip_atomic_store(xb + (size_t)(u.pm * BM + tid) * 8 + u.pn, tot, RLX_AGENT); }
        asm volatile("s_waitcnt vmcnt(0)" ::: "memory");
        if (tid < 256 && lane == 0) __hip_atomic_fetch_add(cnt + 64 * u.pm, 1u, RLX_AGENT);
        if (wid == 0) { unsigned sp = 0;
            while ((unsigned)__builtin_amdgcn_readfirstlane(__hip_atomic_load(cnt + 64 * u.pm, RLX_AGENT)) < 32u) { __builtin_amdgcn_s_sleep(1); if (++sp > (1u << 22)) break; }
            __builtin_amdgcn_fence(__ATOMIC_ACQUIRE, "agent"); }
        asm volatile("s_waitcnt vmcnt(0) lgkmcnt(0)" ::: "memory"); __builtin_amdgcn_s_barrier(); asm volatile("" ::: "memory");
        if (tid < 256) { const float* sl = xb + (size_t)(u.pm * BM + tid) * 8; float q = 0.f;
#pragma unroll
            for (int t = 0; t < 8; ++t) q += __hip_atomic_load(sl + t, RLX_AGENT);
            St[tid] = 1.0f / sqrtf(q * (1.0f / DM) + EPS); }
        asm volatile("s_waitcnt lgkmcnt(0)" ::: "memory"); __builtin_amdgcn_s_barrier(); asm volatile("" ::: "memory");
    }
    __device__ __forceinline__ void fused(f32x4 (&acc)[2][2][4][2], const Unit& u, int wr, int wc, int fr, int fq, LAS unsigned char* lds, int tid) const {
        const LAS float* St = (const LAS float*)(lds + 4096);
        const int col0 = u.pn * BM + wc * 32 + 8 * fq;
        panel_rstd(acc, u, wr, wc, fr, fq, lds, tid, xb1, cnt1);
        {   f32x4 gp[2][2];
#pragma unroll
            for (int bj = 0; bj < 2; ++bj)
#pragma unroll
                for (int n = 0; n < 2; ++n) gp[bj][n] = *(const f32x4*)(gpost + col0 + bj * HALF + 4 * n);
#pragma unroll
            for (int ai = 0; ai < 2; ++ai)
#pragma unroll
                for (int m = 0; m < 4; ++m) { const int r = ai * HALF + wr * 64 + m * 16 + fr; const float rs = St[r]; const size_t off = (size_t)(u.pm * BM + r) * DM + col0;
#pragma unroll
                    for (int bj = 0; bj < 2; ++bj)
#pragma unroll
                        for (int n = 0; n < 2; ++n) { const f32x4 ho = *(const f32x4*)(hold + off + bj * HALF + 4 * n); acc[ai][bj][m][n] = ho + acc[ai][bj][m][n] * rs * gp[bj][n]; }
                    if (!has_next) {
#pragma unroll
                        for (int bj = 0; bj < 2; ++bj)
#pragma unroll
                            for (int n = 0; n < 2; ++n) *(f32x4*)(hout + off + bj * HALF + 4 * n) = acc[ai][bj][m][n]; }
                    if (m & 1) asm volatile("" ::: "memory"); } }
        if (!has_next) return;
        panel_rstd(acc, u, wr, wc, fr, fq, lds, tid, xb2, cnt2);
        {   f32x4 gp[2][2];
#pragma unroll
            for (int bj = 0; bj < 2; ++bj)
#pragma unroll
                for (int n = 0; n < 2; ++n) gp[bj][n] = *(const f32x4*)(gpre + col0 + bj * HALF + 4 * n);
#pragma unroll
            for (int ai = 0; ai < 2; ++ai)
#pragma unroll
                for (int m = 0; m < 4; ++m) { const int r = ai * HALF + wr * 64 + m * 16 + fr; const float rs = St[r]; const size_t off = (size_t)(u.pm * BM + r) * DM + col0;
#pragma unroll
                    for (int bj = 0; bj < 2; ++bj) { const f32x4 x0 = acc[ai][bj][m][0], x1 = acc[ai][bj][m][1];
                        *(f32x4*)(hout + off + bj * HALF) = x0; *(f32x4*)(hout + off + bj * HALF + 4) = x1;
                        const f32x4 y0 = x0 * rs * gp[bj][0], y1 = x1 * rs * gp[bj][1];
                        u32x4 w; w.x = cvt_pk_bf16(y0[0], y0[1]); w.y = cvt_pk_bf16(y0[2], y0[3]); w.z = cvt_pk_bf16(y1[0], y1[1]); w.w = cvt_pk_bf16(y1[2], y1[3]);
                        *(u32x4*)(hn + off + bj * HALF) = w; }
                    if (m & 1) asm volatile("" ::: "memory"); } }
    }
};

template <class EpiT, class Sched>
__device__ __forceinline__ void gemm_phase(LAS unsigned char* lds, const Gemm g, const Sched& S, const EpiT& E) {
    const int tid = otid0(), wid = __builtin_amdgcn_readfirstlane(tid >> 6), lane = tid & 63, wr = wid >> 2, wc = wid & 3, fr = lane & 15, fq = lane >> 4;
    const int K = g.K, nt = K / BK;
    unsigned voffA[2], voffB[2];
#pragma unroll
    for (int i = 0; i < 2; ++i) { int R, C; stage_rc(tid * 16 + i * 8192, R, C); const int Rb = EpiT::PERM ? ((R & ~31) + perm32(R & 31)) : R;
        voffA[i] = (unsigned)(R * g.lda + C) * 2u; voffB[i] = (unsigned)(Rb * g.ldb + C) * 2u; }
    const size_t kstep = (size_t)(BK * 2);
    const size_t hstepA = (size_t)HALF * g.lda * 2, hstepB = (size_t)HALF * g.ldb * 2;
    const size_t tstepA = 2 * hstepA, tstepB = 2 * hstepB;
    const unsigned ldsw = (unsigned)wid * 1024u;
    const int aoff = lds_byte(wr * 64 + fr, fq * 8), boff = lds_byte(wc * 32 + fr, fq * 8);
#define PG8_SA(b, h) (((b) * 2 + (h)) * HTB)
#define PG8_SB(b, h) ((4 + (b) * 2 + (h)) * HTB)
#define PG8_STAGE(bufoff, gbase, voff) do { _Pragma("unroll") for (int _i = 0; _i < 2; ++_i) \
        __builtin_amdgcn_global_load_lds((const unsigned*)((const char*)(gbase) + (voff)[_i]), (LAS unsigned*)(lds + (bufoff) + ldsw + _i * 8192), 16, 0, 0); } while (0)
#define PG8_LDA(dst, b, h) do { _Pragma("unroll") for (int m = 0; m < 4; ++m) _Pragma("unroll") for (int k = 0; k < 2; ++k) dst[m][k] = *(const LAS bf16x8*)(lds + PG8_SA(b, h) + aoff + m * 2048 + k * 1024); } while (0)
#define PG8_LDB(dst, b, h) do { _Pragma("unroll") for (int n = 0; n < 2; ++n) _Pragma("unroll") for (int k = 0; k < 2; ++k) dst[n][k] = *(const LAS bf16x8*)(lds + PG8_SB(b, h) + boff + n * 2048 + k * 1024); } while (0)
#define PG8_MMA(ai, bj, At, Bt) do { __builtin_amdgcn_s_setprio(1); _Pragma("unroll") for (int m = 0; m < 4; ++m) _Pragma("unroll") for (int n = 0; n < 2; ++n) _Pragma("unroll") for (int k = 0; k < 2; ++k) \
        acc[ai][bj][m][n] = __builtin_amdgcn_mfma_f32_16x16x32_bf16(Bt[n][k], At[m][k], acc[ai][bj][m][n], 0, 0, 0); __builtin_amdgcn_s_setprio(0); } while (0)
#define PG8_WAIT_V(n) asm volatile("s_waitcnt vmcnt(" #n ")" ::: "memory")
#define PG8_WAIT_L(n) asm volatile("s_waitcnt lgkmcnt(" #n ")" ::: "memory")
#define PG8_BAR __builtin_amdgcn_s_barrier()
#define PG8_SCHED __builtin_amdgcn_sched_barrier(0)
    Unit cur, nxt; int ui = 0;
    if (!S.next(0, cur)) return;
    f32x4 acc[2][2][4][2];
#pragma unroll
    for (int a = 0; a < 2; ++a)
#pragma unroll
        for (int b = 0; b < 2; ++b)
#pragma unroll
            for (int m = 0; m < 4; ++m)
#pragma unroll
                for (int n = 0; n < 2; ++n) acc[a][b][m][n] = (f32x4){0.f, 0.f, 0.f, 0.f};
    bf16x8 At[4][2], B0[2][2], B1[2][2];
    const char* cA = (const char*)g.A + (size_t)cur.pm * tstepA + cur.aoff; const char* cB = (const char*)g.Bt + (size_t)cur.pn * tstepB + cur.boff;
    PG8_STAGE(PG8_SB(0, 0), cB, voffB); PG8_STAGE(PG8_SB(0, 1), cB + hstepB, voffB); PG8_STAGE(PG8_SA(0, 0), cA, voffA); PG8_STAGE(PG8_SA(0, 1), cA + hstepA, voffA);
    if (wr == 1) PG8_BAR;
    PG8_WAIT_V(2); PG8_BAR;
    PG8_STAGE(PG8_SB(1, 0), cB + kstep, voffB); PG8_STAGE(PG8_SA(1, 0), cA + kstep, voffA); PG8_STAGE(PG8_SB(1, 1), cB + hstepB + kstep, voffB);
    PG8_WAIT_V(6); PG8_BAR;
    for (;;) {
        const bool has_next = S.next(ui + 1, nxt);
        const char* nA = has_next ? (const char*)g.A + (size_t)nxt.pm * tstepA + nxt.aoff : cA; const char* nB = has_next ? (const char*)g.Bt + (size_t)nxt.pn * tstepB + nxt.boff : cB;
        for (int t = 0; t < nt; t += 2) {
            const bool last = (t == nt - 2);
            const char* a1 = cA + (size_t)(t + 1) * kstep;
            const char* a2 = last ? nA : cA + (size_t)(t + 2) * kstep; const char* b2 = last ? nB : cB + (size_t)(t + 2) * kstep;
            const char* a3 = a2 + kstep; const char* b3 = b2 + kstep;
            PG8_LDB(B0, 0, 0); PG8_LDB(B1, 0, 1); PG8_SCHED; PG8_LDA(At, 0, 0); PG8_STAGE(PG8_SA(1, 1), a1 + hstepA, voffA);
            PG8_WAIT_V(8); PG8_WAIT_L(0); PG8_BAR; PG8_MMA(0, 0, At, B0); PG8_MMA(0, 1, At, B1); PG8_BAR; PG8_SCHED;
            PG8_LDA(At, 0, 1); PG8_STAGE(PG8_SB(0, 0), b2, voffB); PG8_STAGE(PG8_SB(0, 1), b2 + hstepB, voffB); PG8_STAGE(PG8_SA(0, 0), a2, voffA);
            PG8_WAIT_V(8); PG8_WAIT_L(0); PG8_BAR; PG8_MMA(1, 0, At, B0); PG8_MMA(1, 1, At, B1); PG8_BAR; PG8_SCHED;
            PG8_LDB(B0, 1, 0); PG8_LDB(B1, 1, 1); PG8_SCHED; PG8_LDA(At, 1, 0); PG8_STAGE(PG8_SA(0, 1), a2 + hstepA, voffA);
            PG8_WAIT_V(8); PG8_WAIT_L(0); PG8_BAR; PG8_MMA(0, 0, At, B0); PG8_MMA(0, 1, At, B1); PG8_BAR; PG8_SCHED;
            PG8_LDA(At, 1, 1); PG8_STAGE(PG8_SB(1, 0), b3, voffB); PG8_STAGE(PG8_SB(1, 1), b3 + hstepB, voffB); PG8_STAGE(PG8_SA(1, 0), a3, voffA);
            PG8_WAIT_V(8); PG8_WAIT_L(0); PG8_BAR; PG8_MMA(1, 0, At, B0); PG8_MMA(1, 1, At, B1); PG8_BAR; PG8_SCHED;
        }
        if (wr == 0) PG8_BAR;
        if (E.MODE != 3) E(acc, cur, wr, wc, fr, fq);
        if (!has_next) break;
#pragma unroll
        for (int a = 0; a < 2; ++a)
#pragma unroll
            for (int b = 0; b < 2; ++b)
#pragma unroll
                for (int m = 0; m < 4; ++m)
#pragma unroll
                    for (int n = 0; n < 2; ++n) acc[a][b][m][n] = (f32x4){0.f, 0.f, 0.f, 0.f};
        cur = nxt; cA = nA; cB = nB; ++ui;
        if (wr == 1) PG8_BAR;
    }
    PG8_WAIT_V(0);
    PG8_BAR;
    if (E.MODE == 3) E.fused(acc, cur, wr, wc, fr, fq, lds, tid);
#undef PG8_SA
#undef PG8_SB
#undef PG8_STAGE
#undef PG8_LDA
#undef PG8_LDB
#undef PG8_MMA
#undef PG8_WAIT_V
#undef PG8_WAIT_L
#undef PG8_BAR
#undef PG8_SCHED
}
}
using pg8::cvt_pk_bf16; using pg8::bf_lo; using pg8::bf_hi; using pg8::sigmoidf_;

struct Params {
    const float *x, *mem, *lb_logits, *mix_norm_pre, *mix_norm_post, *w_in, *fox_f_bias, *hgrn_out_norm, *pool_w, *pool_scale, *w_branch, *w_mix_out,
                *xa_norm_pre, *xa_norm_mem, *xa_norm_post, *xa_wq, *xa_wkv, *xa_wo, *mlp_norm_pre, *mlp_norm_post, *mlp_w_up, *mlp_w_down;
    float* out; unsigned char* ws;
};
__device__ __forceinline__ float wave_sum(float v) {
#pragma unroll
    for (int o = 1; o < 64; o <<= 1) v += __shfl_xor(v, o);
    return v;
}
__device__ __forceinline__ unsigned f2bf(float f) { unsigned u = __builtin_bit_cast(unsigned, f); return (u + 0x7fffu + ((u >> 16) & 1u)) >> 16; }
__device__ __forceinline__ unsigned pk2(float lo, float hi) { return f2bf(lo) | (f2bf(hi) << 16); }
__device__ __forceinline__ float bf2f(bf16_t v) { return __uint_as_float((unsigned)v << 16); }
#define LDS_WAIT() asm volatile("s_waitcnt lgkmcnt(0)" ::: "memory")
__device__ __forceinline__ int otid() { int t = threadIdx.x; asm volatile("" : "+v"(t)); return t; }

struct TrItem { const float* src; bf16_t* dst; int K; };
__device__ __forceinline__ TrItem tr_decode(const float* W, int ldw, int K, int ncols, bf16_t* WT, int item) {
    const int nblk = ncols / 32, kb = item / nblk, nb = item - kb * nblk; TrItem t; t.src = W + (size_t)(64 * kb) * ldw + 32 * nb; t.dst = WT + (size_t)(32 * nb) * K + 64 * kb; t.K = K; return t;
}
__device__ __forceinline__ void tr_load(const TrItem& t, int ldw, int lane, f32x4 (&v)[8]) {
#pragma unroll
    for (int i = 0; i < 8; ++i) v[i] = *(const f32x4*)(t.src + (size_t)(8 * i + (lane >> 3)) * ldw + 4 * (lane & 7));
}
__device__ __forceinline__ void tr_process(const TrItem& t, LAS float* scr, int lane, const f32x4 (&v)[8]) {
#pragma unroll
    for (int i = 0; i < 8; ++i) { LAS float* d = scr + (8 * i + (lane >> 3)) * 33 + 4 * (lane & 7); d[0] = v[i][0]; d[1] = v[i][1]; d[2] = v[i][2]; d[3] = v[i][3]; }
    LDS_WAIT(); asm volatile("" ::: "memory");
    const int c = lane & 7;
#pragma unroll
    for (int j = 0; j < 4; ++j) { const int n = (lane >> 3) + 8 * j; const LAS float* s = scr + (8 * c) * 33 + n;
        u32x4 o; o.x = pk2(s[0 * 33], s[1 * 33]); o.y = pk2(s[2 * 33], s[3 * 33]); o.z = pk2(s[4 * 33], s[5 * 33]); o.w = pk2(s[6 * 33], s[7 * 33]);
        *(u32x4*)(t.dst + (size_t)n * t.K + 8 * c) = o; }
    LDS_WAIT(); asm volatile("" ::: "memory");
}

__device__ __forceinline__ void row_pass(const bool HAS_SRC, const bool HAS_NEXT, const bool HAS_FF, int lane, const bf16_t* src, const float* gpost, const float* hin, float* hout, const float* gpre, bf16_t* hn, const LAS float* wff, float* ff) {
    asm volatile("" : "+v"(lane));
    f32x4 h[8];
#pragma unroll
    for (int j = 0; j < 8; ++j) h[j] = *(const f32x4*)(hin + 4 * lane + 256 * j);
    if (HAS_SRC) {
        f32x4 s[8]; float ss = 0.f;
#pragma unroll
        for (int j = 0; j < 8; ++j) { const u32x2 w = *(const u32x2*)(src + 4 * lane + 256 * j); s[j] = (f32x4){bf_lo(w.x), bf_hi(w.x), bf_lo(w.y), bf_hi(w.y)};
            ss += (s[j][0] * s[j][0] + s[j][1] * s[j][1]) + (s[j][2] * s[j][2] + s[j][3] * s[j][3]); }
        const float r1 = 1.0f / sqrtf(wave_sum(ss) * (1.0f / DM) + EPS);
#pragma unroll
        for (int j = 0; j < 8; ++j) { const f32x4 g = *(const f32x4*)(gpost + 4 * lane + 256 * j); h[j] = h[j] + s[j] * r1 * g; *(f32x4*)(hout + 4 * lane + 256 * j) = h[j]; }
    }
    if (HAS_NEXT) {
        float ss = 0.f;
#pragma unroll
        for (int j = 0; j < 8; ++j) ss += (h[j][0] * h[j][0] + h[j][1] * h[j][1]) + (h[j][2] * h[j][2] + h[j][3] * h[j][3]);
        const float r2 = 1.0f / sqrtf(wave_sum(ss) * (1.0f / DM) + EPS);
        f32x4 fa = (f32x4){0.f, 0.f, 0.f, 0.f};
#pragma unroll
        for (int j = 0; j < 8; ++j) { const f32x4 g = *(const f32x4*)(gpre + 4 * lane + 256 * j); const f32x4 y = h[j] * r2 * g;
            u32x2 w; w.x = pk2(y[0], y[1]); w.y = pk2(y[2], y[3]); *(u32x2*)(hn + 4 * lane + 256 * j) = w;
            if (HAS_FF) {
#pragma unroll
                for (int e = 0; e < 4; ++e) { const f32x4 wv = *(const LAS f32x4*)(wff + (4 * lane + 256 * j + e) * 4); fa = fa + wv * y[e]; } } }
        if (HAS_FF) { fa[0] = wave_sum(fa[0]); fa[1] = wave_sum(fa[1]); fa[2] = wave_sum(fa[2]); fa[3] = wave_sum(fa[3]); if (lane == 0) *(f32x4*)ff = fa; }
    }
}

constexpr int AT_KSTR = 272, AT_VSTR = 320, AT_KBUF = 64 * AT_KSTR, AT_VBUF = 64 * AT_VSTR;
constexpr int AT_K0 = 0, AT_V0 = 2 * AT_KBUF, AT_CK = AT_V0 + 2 * AT_VBUF, AT_KBAR = AT_CK + 512, AT_VOTE = AT_KBAR + 8192, AT_END = AT_VOTE + 64;
typedef short v4i16_t __attribute__((ext_vector_type(4)));
__device__ __forceinline__ s16x4 vtr(LAS const unsigned char* p) { return __builtin_bit_cast(s16x4, __builtin_amdgcn_ds_read_tr16_b64_v4i16((LAS v4i16_t*)p)); }

template <int MODE>
__device__ __forceinline__ void attn_unit(LAS unsigned char* lds, const bf16_t* Qb, int ldq, const bf16_t* Kb, const bf16_t* Vb, int ldkv, bf16_t* Ob, int ldo, int q0, int ntiles, const float* cf, const float* kbar, size_t qsplit = 0, const unsigned* kmaxp = nullptr) {
    const int tid = otid(), lane = tid & 63, wid = __builtin_amdgcn_readfirstlane(tid >> 6), qg = wid & 3, kh = wid >> 2, r32 = lane & 31, h = lane >> 5;
    const int qrow = q0 + 32 * qg + r32;
    const float C2 = 0.08838834764831845f * LOG2E;
    bf16x8 qf[8];
    { const bf16_t* qp = Qb + (size_t)qrow * ldq + 8 * h;
      if (MODE == 2 && qsplit) {
#pragma unroll
          for (int s = 0; s < 8; ++s) { float a[8];
#pragma unroll
              for (int e = 0; e < 8; ++e) a[e] = 0.f;
#pragma unroll
              for (int ks = 0; ks < 4; ++ks) { const u32x4 w = *(const u32x4*)(qp + ks * qsplit + 16 * s);
                  a[0] += bf_lo(w.x); a[1] += bf_hi(w.x); a[2] += bf_lo(w.y); a[3] += bf_hi(w.y); a[4] += bf_lo(w.z); a[5] += bf_hi(w.z); a[6] += bf_lo(w.w); a[7] += bf_hi(w.w); }
              u32x4 o; o.x = cvt_pk_bf16(a[0], a[1]); o.y = cvt_pk_bf16(a[2], a[3]); o.z = cvt_pk_bf16(a[4], a[5]); o.w = cvt_pk_bf16(a[6], a[7]); qf[s] = __builtin_bit_cast(bf16x8, o); }
      } else {
#pragma unroll
          for (int s = 0; s < 8; ++s) qf[s] = *(const bf16x8*)(qp + 16 * s); } }
    unsigned sel = 0; const int blk = q0 >> 8;
    if (MODE == 0) {
        LAS float* kbl = (LAS float*)(lds + AT_KBAR);
        *(LAS f32x4*)(kbl + 4 * tid) = *(const f32x4*)(kbar + 4 * tid);
        __syncthreads();
        if (blk <= 3) sel = (1u << blk) - 1u;
        else {
            unsigned qw[32];
            { const bf16_t* qp = Qb + (size_t)qrow * ldq + 64 * h;
#pragma unroll
              for (int c8 = 0; c8 < 8; ++c8) { const u32x4 w = *(const u32x4*)(qp + 8 * c8); qw[4 * c8] = w.x; qw[4 * c8 + 1] = w.y; qw[4 * c8 + 2] = w.z; qw[4 * c8 + 3] = w.w; } }
            float v1 = -3.0e38f, v2 = -3.0e38f, v3 = -3.0e38f; int i1 = 0, i2 = 0, i3 = 0;
#pragma unroll 1
            for (int j = 0; j < blk; ++j) { float g = 0.f; const LAS float* kb = kbl + j * 128 + 64 * h;
#pragma unroll
                for (int c4 = 0; c4 < 16; ++c4) { const f32x4 a = *(const LAS f32x4*)(kb + 4 * c4);
                    g += (bf_lo(qw[2 * c4]) * a[0] + bf_hi(qw[2 * c4]) * a[1]) + (bf_lo(qw[2 * c4 + 1]) * a[2] + bf_hi(qw[2 * c4 + 1]) * a[3]); }
                g += __shfl_xor(g, 32);
                if (g > v1) { v3 = v2; i3 = i2; v2 = v1; i2 = i1; v1 = g; i1 = j; }
                else if (g > v2) { v3 = v2; i3 = i2; v2 = g; i2 = j; }
                else if (g > v3) { v3 = g; i3 = j; } }
            sel = (1u << i1) | (1u << i2) | (1u << i3);
        }
    }
    float cq2 = 0.f, qkb = 0.f;
    if (MODE == 1) { cq2 = cf[qrow] * LOG2E;
        float qs = 0.f;
#pragma unroll
        for (int s8 = 0; s8 < 8; ++s8) { const u32x4 w = __builtin_bit_cast(u32x4, qf[s8]);
            const float a0 = bf_lo(w.x), a1 = bf_hi(w.x), a2 = bf_lo(w.y), a3 = bf_hi(w.y), a4 = bf_lo(w.z), a5 = bf_hi(w.z), a6 = bf_lo(w.w), a7 = bf_hi(w.w);
            qs += (a0 * a0 + a1 * a1) + (a2 * a2 + a3 * a3) + (a4 * a4 + a5 * a5) + (a6 * a6 + a7 * a7); }
        qs += __shfl_xor(qs, 32);
        qkb = C2 * sqrtf(qs) * sqrtf(__uint_as_float(*kmaxp)) * 1.01f + 1.0f; }
    LAS unsigned* vote = (LAS unsigned*)(lds + AT_VOTE);
    float m_run = MASKV, l_run = 0.f;
    f32x16 o[4];
#pragma unroll
    for (int d = 0; d < 4; ++d)
#pragma unroll
        for (int r = 0; r < 16; ++r) o[d][r] = 0.f;
    u32x4 kreg[2][2], vreg[2][2]; float ckreg[2] = {0.f, 0.f};
    const int srow = tid >> 4, sch = tid & 15;
#define AT_LOAD(j, S_) do { _Pragma("unroll") for (int i_ = 0; i_ < 2; ++i_) { const size_t go = (size_t)(64 * (j) + srow + 32 * i_) * ldkv + sch * 8; kreg[S_][i_] = *(const u32x4*)(Kb + go); vreg[S_][i_] = *(const u32x4*)(Vb + go); } \
        if (MODE == 1 && tid < 64) ckreg[S_] = cf[64 * (j) + tid] * LOG2E; } while (0)
#define AT_STORE(b, S_) do { _Pragma("unroll") for (int i_ = 0; i_ < 2; ++i_) { *(LAS u32x4*)(lds + AT_K0 + (b) * AT_KBUF + (srow + 32 * i_) * AT_KSTR + sch * 16) = kreg[S_][i_]; \
        *(LAS u32x4*)(lds + AT_V0 + (b) * AT_VBUF + (srow + 32 * i_) * AT_VSTR + sch * 16) = vreg[S_][i_]; } if (MODE == 1 && tid < 64) *(LAS float*)(lds + AT_CK + (b) * 256 + tid * 4) = ckreg[S_]; } while (0)
    AT_LOAD(ntiles - 1, 0); AT_LOAD(ntiles - 2, 1); AT_STORE(0, 0);
    __syncthreads();
    bool done = false;
#pragma unroll 1
    for (int it0 = 0; it0 < ntiles; it0 += 2) {
#pragma unroll
      for (int half = 0; half < 2; ++half) {
        const int it = it0 + half, j = ntiles - 1 - it, cur = half;
        if (it + 2 < ntiles) AT_LOAD(j - 2, half);
        const int kv0 = 64 * j + 32 * kh;
        bool act = true;
        if (MODE != 2) act = !(kv0 > q0 + 32 * qg + 31);
        if (MODE == 1) {
            const float ckmin = *(LAS const float*)(lds + AT_CK + cur * 256 + (32 * kh + 31) * 4);
            const bool dead = __all((qkb + cq2 - ckmin) < (m_run - 40.0f));
            act = act && !dead;
            if (lane == 0) vote[(it & 1) * 8 + wid] = dead ? 0u : 1u;
        }
        if (act) {
            f32x16 p;
#pragma unroll
            for (int r = 0; r < 16; ++r) p[r] = 0.f;
            { LAS const unsigned char* kp = lds + AT_K0 + cur * AT_KBUF + (32 * kh + r32) * AT_KSTR + 16 * h;
#pragma unroll
              for (int s = 0; s < 8; ++s) { const bf16x8 kf = *(LAS const bf16x8*)(kp + 32 * s); p = __builtin_amdgcn_mfma_f32_32x32x16_bf16(kf, qf[s], p, 0, 0, 0); } }
            bool lane_on = true;
            if (MODE == 0) { const int jb = j >> 2; lane_on = (jb == blk) || ((sel >> jb) & 1u); }
            const bool need_mask = (MODE != 2) && ((kv0 + 31 > q0 + 32 * qg) || (MODE == 0 && __any(!lane_on)));
            float mx = MASKV;
            if (MODE == 1) {
#pragma unroll
                for (int g4 = 0; g4 < 4; ++g4) { const f32x4 ck4 = *(LAS const f32x4*)(lds + AT_CK + cur * 256 + (32 * kh + 8 * g4 + 4 * h) * 4);
#pragma unroll
                    for (int e = 0; e < 4; ++e) p[4 * g4 + e] = p[4 * g4 + e] * C2 + (cq2 - ck4[e]); }
            } else {
#pragma unroll
                for (int r = 0; r < 16; ++r) p[r] *= C2;
            }
            if (need_mask) {
#pragma unroll
                for (int r = 0; r < 16; ++r) { const int kvl = (r & 3) + 8 * (r >> 2) + 4 * h; if ((kv0 + kvl > qrow) || !lane_on) p[r] = MASKV; }
            }
#pragma unroll
            for (int r = 0; r < 16; ++r) mx = fmaxf(mx, p[r]);
            mx = fmaxf(mx, __shfl_xor(mx, 32));
            if (__any(mx > m_run)) {
                const float m_new = fmaxf(m_run, mx), alpha = __builtin_amdgcn_exp2f(m_run - m_new); m_run = m_new; l_run *= alpha;
#pragma unroll
                for (int d = 0; d < 4; ++d)
#pragma unroll
                    for (int r = 0; r < 16; ++r) o[d][r] *= alpha;
            }
            float ps = 0.f;
#pragma unroll
            for (int r = 0; r < 16; ++r) { p[r] = __builtin_amdgcn_exp2f(p[r] - m_run); ps += p[r]; }
            l_run += ps;
            bf16x8 pb[2];
#pragma unroll
            for (int s2 = 0; s2 < 2; ++s2) { u32x4 w; w.x = cvt_pk_bf16(p[8 * s2 + 0], p[8 * s2 + 1]); w.y = cvt_pk_bf16(p[8 * s2 + 2], p[8 * s2 + 3]); w.z = cvt_pk_bf16(p[8 * s2 + 4], p[8 * s2 + 5]); w.w = cvt_pk_bf16(p[8 * s2 + 6], p[8 * s2 + 7]);
                pb[s2] = __builtin_bit_cast(bf16x8, w); }
            LAS const unsigned char* vp = lds + AT_V0 + cur * AT_VBUF + (32 * kh + 4 * h + ((lane & 15) >> 2)) * AT_VSTR + (16 * ((lane >> 4) & 1) + 4 * (lane & 3)) * 2;
#pragma unroll
            for (int d = 0; d < 4; ++d)
#pragma unroll
                for (int s2 = 0; s2 < 2; ++s2) { const s16x4 lo = vtr(vp + (16 * s2) * AT_VSTR + 64 * d), hi = vtr(vp + (16 * s2 + 8) * AT_VSTR + 64 * d);
                    const bf16x8 vf = (bf16x8){lo[0], lo[1], lo[2], lo[3], hi[0], hi[1], hi[2], hi[3]};
                    o[d] = __builtin_amdgcn_mfma_f32_32x32x16_bf16(vf, pb[s2], o[d], 0, 0, 0); }
        }
        if (it + 1 < ntiles) AT_STORE(half ^ 1, half ^ 1);
        __syncthreads();
        if (MODE == 1) { const u32x4 v0 = *(LAS const u32x4*)(vote + (it & 1) * 8), v1 = *(LAS const u32x4*)(vote + (it & 1) * 8 + 4);
            if (((v0.x | v0.y) | (v0.z | v0.w) | (v1.x | v1.y) | (v1.z | v1.w)) == 0u) { done = true; break; } }
      }
      if (done) break;
    }
#undef AT_LOAD
#undef AT_STORE
    l_run += __shfl_xor(l_run, 32);
    LAS float* mrg = (LAS float*)lds;
    const int mi = qg * 64 + lane;
    if (kh == 1) {
#pragma unroll
        for (int d = 0; d < 4; ++d)
#pragma unroll
            for (int r = 0; r < 16; ++r) mrg[(d * 16 + r) * 256 + mi] = o[d][r];
        mrg[64 * 256 + mi] = m_run; mrg[65 * 256 + mi] = l_run;
    }
    __syncthreads();
    if (kh == 0) {
        const float m1 = mrg[64 * 256 + mi], l1 = mrg[65 * 256 + mi];
        const float mt = fmaxf(m_run, m1), a0 = __builtin_amdgcn_exp2f(m_run - mt), a1 = __builtin_amdgcn_exp2f(m1 - mt);
        const float inv = 1.0f / (l_run * a0 + l1 * a1);
        bf16_t* op = Ob + (size_t)qrow * ldo + 4 * h;
#pragma unroll
        for (int d = 0; d < 4; ++d)
#pragma unroll
            for (int g4 = 0; g4 < 4; ++g4) { float v[4];
#pragma unroll
                for (int e = 0; e < 4; ++e) { const int r = 4 * g4 + e; v[e] = (o[d][r] * a0 + mrg[(d * 16 + r) * 256 + mi] * a1) * inv; }
                u32x2 w; w.x = cvt_pk_bf16(v[0], v[1]); w.y = cvt_pk_bf16(v[2], v[3]); *(u32x2*)(op + 32 * d + 8 * g4) = w; }
    }
    __syncthreads();
}

__device__ __forceinline__ void rope_item(LAS unsigned char* lds, bf16_t* z, float* kbar_all, int it) {
    const int isk = it >> 7, b = (it >> 6) & 1, blk = (it >> 2) & 15, hh = it & 3, tid = otid(), tg = tid >> 6, dp = tid & 63;
    const int col = (isk ? Z_MK : Z_MQ) + hh * HD + dp;
    const float inv_freq = exp2f(-(float)dp * (13.287712379549449f / 64.0f));
    float s1 = 0.f, s2 = 0.f;
#pragma unroll 1
    for (int i0 = 0; i0 < 32; i0 += 8) {
        float x1[8], x2[8];
#pragma unroll
        for (int i = 0; i < 8; ++i) { const bf16_t* p = z + (size_t)(b * SEQ + blk * 256 + tg * 32 + i0 + i) * NZ + col; x1[i] = bf2f(p[0]); x2[i] = bf2f(p[64]); }
#pragma unroll
        for (int i = 0; i < 8; ++i) { const int t = blk * 256 + tg * 32 + i0 + i; bf16_t* p = z + (size_t)(b * SEQ + t) * NZ + col;
            const float ang = (float)t * inv_freq;
            double rev = (double)ang * 0.15915494309189535; rev -= floor(rev);
            const float rf = (float)rev, sn = __builtin_amdgcn_sinf(rf), cs = __builtin_amdgcn_cosf(rf);
            const float o1 = x1[i] * cs - x2[i] * sn, o2 = x2[i] * cs + x1[i] * sn;
            p[0] = (bf16_t)f2bf(o1); p[64] = (bf16_t)f2bf(o2); s1 += o1; s2 += o2; }
    }
    if (isk) {
        LAS float* red = (LAS float*)lds;
        red[tg * 128 + dp] = s1; red[tg * 128 + 64 + dp] = s2;
        __syncthreads();
        if (tid < 128) { float a = 0.f;
#pragma unroll
            for (int g = 0; g < 8; ++g) a += red[g * 128 + tid];
            kbar_all[((size_t)(b * NH + hh) * 16 + blk) * 128 + tid] = a * (1.0f / 256.0f); }
        __syncthreads();
    }
}
__device__ __forceinline__ void kmax_item(const bf16_t* z, unsigned* kmax2, int it) {
    const int b = it >> 6, blk = (it >> 2) & 15, hh = it & 3, tid = otid(), row = tid >> 1, hf = tid & 1;
    const bf16_t* p = z + (size_t)(b * SEQ + blk * 256 + row) * NZ + Z_FK + hh * HD + 64 * hf; float ss = 0.f;
#pragma unroll
    for (int c8 = 0; c8 < 8; ++c8) { const u32x4 w = *(const u32x4*)(p + 8 * c8);
        const float a0 = bf_lo(w.x), a1 = bf_hi(w.x), a2 = bf_lo(w.y), a3 = bf_hi(w.y), a4 = bf_lo(w.z), a5 = bf_hi(w.z), a6 = bf_lo(w.w), a7 = bf_hi(w.w);
        ss += (a0 * a0 + a1 * a1) + (a2 * a2 + a3 * a3) + (a4 * a4 + a5 * a5) + (a6 * a6 + a7 * a7); }
    ss += __shfl_xor(ss, 1);
#pragma unroll
    for (int o = 2; o < 64; o <<= 1) ss = fmaxf(ss, __shfl_xor(ss, o));
    if ((tid & 63) == 0) atomicMax(kmax2 + b * NH + hh, __float_as_uint(ss));
}
__device__ __forceinline__ float log_sigmoid_(float x) { return fminf(x, 0.f) - log1pf(expf(-fabsf(x))); }
__device__ __forceinline__ void cumsum_item(LAS unsigned char* lds, const float* ff, const float* bias, float* cf, int it) {
    const int b = it >> 2, hh = it & 3, tid = otid(), lane = tid & 63, wid = tid >> 6;
    const float bi = bias[hh]; float v[8]; float run = 0.f;
#pragma unroll
    for (int i = 0; i < 8; ++i) { run += log_sigmoid_(ff[(size_t)(b * SEQ + tid * 8 + i) * 4 + hh] + bi); v[i] = run; }
    float sc = run;
#pragma unroll
    for (int o = 1; o < 64; o <<= 1) { const float t = __shfl_up(sc, o); if (lane >= o) sc += t; }
    LAS float* wt = (LAS float*)lds;
    if (lane == 63) wt[wid] = sc;
    __syncthreads();
    float off = sc - run;
    for (int w = 0; w < wid; ++w) off += wt[w];
#pragma unroll
    for (int i = 0; i < 8; ++i) cf[(size_t)(b * NH + hh) * SEQ + tid * 8 + i] = v[i] + off;
    __syncthreads();
}
template <int W>
__device__ __forceinline__ void pool_rows(const bf16_t* z, bf16_t* y3, int r0, int c) {
    float v[32 + W - 1];
    const int bstart = r0 & ~(SEQ - 1);
#pragma unroll
    for (int i = 0; i < 32 + W - 1; ++i) { const int row = r0 - (W - 1) + i; v[i] = (row >= bstart) ? bf2f(z[(size_t)row * NZ + Z_PIN + c]) : 0.f; }
    float s = 0.f;
#pragma unroll
    for (int i = 0; i < W - 1; ++i) s += v[i];
#pragma unroll
    for (int t = 0; t < 32; ++t) { s += v[t + W - 1]; const int tl = (r0 + t) & (SEQ - 1); const float cnt = (float)((tl + 1 < W) ? (tl + 1) : W);
        y3[(size_t)(r0 + t) * BW + c] = (bf16_t)f2bf(s / cnt - v[t + W - 1]); s -= v[t]; }
}
__device__ __forceinline__ void pool_item(const bf16_t* z, bf16_t* y3, int it) {
    const int c = otid(), g = __builtin_amdgcn_readfirstlane(c >> 7);
    if (g == 0) pool_rows<2>(z, y3, it * 32, c); else if (g == 1) pool_rows<4>(z, y3, it * 32, c); else if (g == 2) pool_rows<8>(z, y3, it * 32, c); else pool_rows<16>(z, y3, it * 32, c);
}

constexpr int HG_STR = 132;
constexpr int HG_Q = 0, HG_K = 64 * HG_STR * 4, HG_B = 2 * 64 * HG_STR * 4, HG_ATT = 3 * 64 * HG_STR * 4, HG_TOT = HG_ATT + 64 * 65 * 4;
__device__ __forceinline__ float hgrn_lb(const float* lbl, int layer, int c) { if (layer == 0) return 0.f; const float g0 = lbl[c], g1 = lbl[512 + c]; return 1.0f / (1.0f + expf(g0 - g1)); }
template <bool WITH_Q>
__device__ __forceinline__ void hgrn_load(LAS unsigned char* lds, const bf16_t* z, const float* lbl, int layer, int row0, int hh) {
    const int tid = otid();
    LAS float* Qm = (LAS float*)(lds + HG_Q); LAS float* Km = (LAS float*)(lds + HG_K); LAS float* Bm = (LAS float*)(lds + HG_B); LAS float* tot = (LAS float*)(lds + HG_TOT);
    { const int d8 = (tid & 15) * 8, r0 = tid >> 4;
#pragma unroll
      for (int rr = 0; rr < 2; ++rr) { const int r = r0 + 32 * rr; const bf16_t* zp = z + (size_t)(row0 + r) * NZ + hh * HD + d8;
          const u32x4 wf = *(const u32x4*)(zp + Z_HF); const unsigned wfa[4] = {wf.x, wf.y, wf.z, wf.w};
          u32x4 wq = (u32x4){0, 0, 0, 0}; if (WITH_Q) wq = *(const u32x4*)(zp + Z_HQ); const unsigned wqa[4] = {wq.x, wq.y, wq.z, wq.w};
#pragma unroll
          for (int e = 0; e < 8; ++e) { const unsigned w = wfa[e >> 1]; const float zf = (e & 1) ? bf_hi(w) : bf_lo(w);
              const float lb = hgrn_lb(lbl, layer, hh * HD + d8 + e), sg = 1.0f / (1.0f + expf(-zf));
              Bm[r * HG_STR + d8 + e] = __builtin_amdgcn_logf(lb + (1.0f - lb) * sg);     Km[r * HG_STR + d8 + e] = (1.0f - lb) * (1.0f - sg);
              if (WITH_Q) { const unsigned q = wqa[e >> 1]; Qm[r * HG_STR + d8 + e] = (e & 1) ? bf_hi(q) : bf_lo(q); } } } }
    __syncthreads();
    const int d = tid & 127, qr = tid >> 7; float run = 0.f;
#pragma unroll
    for (int i = 0; i < 16; ++i) { run += Bm[(16 * qr + i) * HG_STR + d]; Bm[(16 * qr + i) * HG_STR + d] = run; }
    tot[qr * 128 + d] = run;
    __syncthreads();
    float off = 0.f;
    for (int q2 = 0; q2 < qr; ++q2) off += tot[q2 * 128 + d];
#pragma unroll
    for (int i = 0; i < 16; ++i) Bm[(16 * qr + i) * HG_STR + d] += off;
    __syncthreads();
}
__device__ __forceinline__ void hgrn_local_item(LAS unsigned char* lds, const bf16_t* z, const float* lbl, int layer, float* HS, float* HDEC, int it) {
    const int b = it >> 8, hh = (it >> 6) & 3, c = it & 63, row0 = b * SEQ + c * 64, tid = otid();
    hgrn_load<false>(lds, z, lbl, layer, row0, hh);
    LAS float* Vm = (LAS float*)(lds + HG_Q); LAS float* Km = (LAS float*)(lds + HG_K); LAS float* Bm = (LAS float*)(lds + HG_B);
    { const int d8 = (tid & 15) * 8, r0 = tid >> 4;
#pragma unroll
      for (int rr = 0; rr < 2; ++rr) { const int r = r0 + 32 * rr; const u32x4 wv = *(const u32x4*)(z + (size_t)(row0 + r) * NZ + Z_HI + hh * HD + d8); const unsigned wa[4] = {wv.x, wv.y, wv.z, wv.w};
#pragma unroll
          for (int e = 0; e < 8; ++e) Vm[r * HG_STR + d8 + e] = (e & 1) ? bf_hi(wa[e >> 1]) : bf_lo(wa[e >> 1]); } }
    { const int d = tid & 127, qr = tid >> 7; const float bl = Bm[63 * HG_STR + d];
#pragma unroll
      for (int i = 0; i < 16; ++i) { const int s = 16 * qr + i; Km[s * HG_STR + d] *= __builtin_amdgcn_exp2f(bl - Bm[s * HG_STR + d]); }
      if (qr == 0) HDEC[(size_t)it * 128 + d] = __builtin_amdgcn_exp2f(bl); }
    __syncthreads();
    { const int wv = __builtin_amdgcn_readfirstlane(tid >> 6), ln = tid & 63, r32 = ln & 31, h2 = ln >> 5, eb = wv & 3;
      float* dst = HS + (size_t)it * 16384;
#pragma unroll
      for (int q = 0; q < 2; ++q) { const int db = (wv >> 2) * 2 + q; f32x16 c;
#pragma unroll
          for (int r = 0; r < 16; ++r) c[r] = 0.f;
#pragma unroll 8
          for (int kk = 0; kk < 32; ++kk) { const float av = Km[(2 * kk + h2) * HG_STR + 32 * db + r32], bv = Vm[(2 * kk + h2) * HG_STR + 32 * eb + r32];
              c = __builtin_amdgcn_mfma_f32_32x32x2f32(av, bv, c, 0, 0, 0); }
#pragma unroll
          for (int r = 0; r < 16; ++r) dst[(32 * db + (r & 3) + 8 * (r >> 2) + 4 * h2) * 128 + 32 * eb + r32] = c[r]; } }
    __syncthreads();
}
__device__ __forceinline__ void hgrn_scan(float* HS, const float* HDEC, int gtid, int gthreads) {
    for (int el = gtid; el < 8 * 16384; el += gthreads) { const int bh = el >> 14, de = el & 16383, d = de >> 7; float st = 0.f;
        float* p = HS + (size_t)bh * 64 * 16384 + de; const float* dc = HDEC + (size_t)bh * 64 * 128 + d;
#pragma unroll 8
        for (int c = 0; c < 64; ++c) { const float t = p[(size_t)c * 16384]; p[(size_t)c * 16384] = st; st = dc[c * 128] * st + t; } }
}
__device__ __forceinline__ void hgrn_out_item(LAS unsigned char* lds, const bf16_t* z, const float* lbl, int layer, const float* HS, const float* norm_g, bf16_t* y2, int it) {
    const int b = it >> 8, hh = (it >> 6) & 3, c = it & 63, row0 = b * SEQ + c * 64, tid = otid();
    hgrn_load<true>(lds, z, lbl, layer, row0, hh);
    LAS float* Qm = (LAS float*)(lds + HG_Q); LAS float* Km = (LAS float*)(lds + HG_K); LAS float* Bm = (LAS float*)(lds + HG_B); LAS float* At = (LAS float*)(lds + HG_ATT);
    { const int d8 = (tid & 15) * 8, r0 = tid >> 4;
#pragma unroll
      for (int rr = 0; rr < 2; ++rr) { const int r = r0 + 32 * rr;
#pragma unroll
          for (int e = 0; e < 8; ++e) { const float dl = Bm[r * HG_STR + d8 + e] - Bm[31 * HG_STR + d8 + e];
              Qm[r * HG_STR + d8 + e] *= __builtin_amdgcn_exp2f(dl); Km[r * HG_STR + d8 + e] *= __builtin_amdgcn_exp2f(-dl); } } }
    __syncthreads();
    { const int t = tid >> 3, sg = tid & 7; float a[8];
#pragma unroll
      for (int j = 0; j < 8; ++j) a[j] = 0.f;
      for (int d = 0; d < 128; d += 4) { const f32x4 q = *(const LAS f32x4*)(Qm + t * HG_STR + d);
#pragma unroll
          for (int j = 0; j < 8; ++j) { const int s = sg + 8 * j; if (s <= t) { const f32x4 k = *(const LAS f32x4*)(Km + s * HG_STR + d);
              a[j] += (q[0] * k[0] + q[1] * k[1]) + (q[2] * k[2] + q[3] * k[3]); } } }
#pragma unroll
      for (int j = 0; j < 8; ++j) At[t * 65 + sg + 8 * j] = a[j]; }
    __syncthreads();
    const float* Sg = HS + (size_t)it * 16384;
    f32x4 sreg[4];
#pragma unroll
    for (int i = 0; i < 4; ++i) sreg[i] = *(const f32x4*)(Sg + (size_t)(tid + 512 * i) * 4);
    { const int d8 = (tid & 15) * 8, r0 = tid >> 4;
#pragma unroll
      for (int rr = 0; rr < 2; ++rr) { const int r = r0 + 32 * rr; const u32x4 wv = *(const u32x4*)(z + (size_t)(row0 + r) * NZ + Z_HI + hh * HD + d8); const unsigned wa[4] = {wv.x, wv.y, wv.z, wv.w};
#pragma unroll
          for (int e = 0; e < 8; ++e) { Km[r * HG_STR + d8 + e] = (e & 1) ? bf_hi(wa[e >> 1]) : bf_lo(wa[e >> 1]); Qm[r * HG_STR + d8 + e] *= __builtin_amdgcn_exp2f(Bm[31 * HG_STR + d8 + e]); } } }
    __syncthreads();
    const int wv = __builtin_amdgcn_readfirstlane(tid >> 6), ln = tid & 63, r32 = ln & 31, h2 = ln >> 5, tb = wv >> 2, eb = wv & 3;
    f32x16 oc;
#pragma unroll
    for (int r = 0; r < 16; ++r) oc[r] = 0.f;
#pragma unroll 1
    for (int hf = 0; hf < 2; ++hf) {
#pragma unroll
        for (int i = 0; i < 4; ++i) { const int f4 = tid + 512 * i, dr = f4 >> 5, ec = (f4 & 31) * 4; *(LAS f32x4*)(Bm + dr * HG_STR + ec) = sreg[i]; }
        __syncthreads();
        if (hf == 0) {
#pragma unroll
            for (int i = 0; i < 4; ++i) sreg[i] = *(const f32x4*)(Sg + 8192 + (size_t)(tid + 512 * i) * 4); }
#pragma unroll 8
        for (int kk = 0; kk < 32; ++kk) { const float av = Qm[(32 * tb + r32) * HG_STR + 64 * hf + 2 * kk + h2], bv = Bm[(2 * kk + h2) * HG_STR + 32 * eb + r32];
            oc = __builtin_amdgcn_mfma_f32_32x32x2f32(av, bv, oc, 0, 0, 0); }
        __syncthreads();
    }
#pragma unroll 8
    for (int kk = 0; kk < 32; ++kk) { const float av = At[(32 * tb + r32) * 65 + 2 * kk + h2], bv = Km[(2 * kk + h2) * HG_STR + 32 * eb + r32];
        oc = __builtin_amdgcn_mfma_f32_32x32x2f32(av, bv, oc, 0, 0, 0); }
    { LAS float* red = Bm;
#pragma unroll
      for (int r = 0; r < 16; ++r) { float ss = oc[r] * oc[r];
#pragma unroll
          for (int o = 1; o < 32; o <<= 1) ss += __shfl_xor(ss, o);
          if (r32 == 0) red[(32 * tb + (r & 3) + 8 * (r >> 2) + 4 * h2) * 4 + eb] = ss; }
      __syncthreads();
      const int e = 32 * eb + r32; const float ng = norm_g[hh * HD + e];
#pragma unroll
      for (int r = 0; r < 16; ++r) { const int t = 32 * tb + (r & 3) + 8 * (r >> 2) + 4 * h2; const f32x4 pr = *(const LAS f32x4*)(red + t * 4);
          const float rs = 1.0f / sqrtf(((pr[0] + pr[1]) + (pr[2] + pr[3])) * (1.0f / 128.0f) + EPS);
          const size_t row = (size_t)(row0 + t); const float g = bf2f(z[row * NZ + Z_HG + hh * HD + e]);
          y2[row * BW + hh * HD + e] = (bf16_t)f2bf(oc[r] * rs * ng * g * sigmoidf_(g)); } }
    __syncthreads();
}

__device__ __forceinline__ void wpool_item(const float* pool_w, const float* pool_scale, const float* wb3, bf16_t* dst, int it) {
    const int g = (it >> 5) & 3, c0 = ((it >> 2) & 7) * 16, nn = (it & 3) * 512 + otid();
    float acc[16];
#pragma unroll
    for (int i = 0; i < 16; ++i) acc[i] = 0.f;
    for (int e = 0; e < 128; ++e) { const float wb = wb3[(size_t)(g * 128 + e) * DM + nn] * pool_scale[g * 128 + e];
#pragma unroll
        for (int i = 0; i < 16; ++i) acc[i] += pool_w[((size_t)g * 128 + c0 + i) * 128 + e] * wb; }
    u32x4 w0, w1; w0.x = pk2(acc[0], acc[1]); w0.y = pk2(acc[2], acc[3]); w0.z = pk2(acc[4], acc[5]); w0.w = pk2(acc[6], acc[7]);
    w1.x = pk2(acc[8], acc[9]); w1.y = pk2(acc[10], acc[11]); w1.z = pk2(acc[12], acc[13]); w1.w = pk2(acc[14], acc[15]);
    bf16_t* p = dst + (size_t)nn * BW + g * 128 + c0; *(u32x4*)p = w0; *(u32x4*)(p + 8) = w1;
}

__device__ __forceinline__ void load_wff(LAS float* dst, const float* win) {
    const int tid = otid();
#pragma unroll
    for (int i = 0; i < 4; ++i) { const int k = tid + 512 * i; *(LAS f32x4*)(dst + 4 * k) = *(const f32x4*)(win + (size_t)k * DIN_SRC + FF_SRC_COL); }
    __syncthreads();
}
__device__ __forceinline__ void ff_row(int lane, const bf16_t* hn, const LAS float* wff, float* ff) {
    asm volatile("" : "+v"(lane));
    f32x4 fa = (f32x4){0.f, 0.f, 0.f, 0.f};
#pragma unroll
    for (int j = 0; j < 8; ++j) { const u32x2 w = *(const u32x2*)(hn + 4 * lane + 256 * j); const float y[4] = {bf_lo(w.x), bf_hi(w.x), bf_lo(w.y), bf_hi(w.y)};
#pragma unroll
        for (int e = 0; e < 4; ++e) { const f32x4 wv = *(const LAS f32x4*)(wff + (4 * lane + 256 * j + e) * 4); fa = fa + wv * y[e]; } }
    fa[0] = wave_sum(fa[0]); fa[1] = wave_sum(fa[1]); fa[2] = wave_sum(fa[2]); fa[3] = wave_sum(fa[3]); if (lane == 0) *(f32x4*)ff = fa;
}
constexpr int LDS_BYTES = 147456;
struct LayerW { bf16_t *win, *wbr, *wout, *wxq, *wxkv, *wxo, *wup, *wdn; };
__device__ __forceinline__ LayerW layer_w(unsigned char* ws, int l) {
    LayerW w; unsigned char* p = ws + OFF_W + (size_t)l * SZ_WL;
    w.win = (bf16_t*)p; p += SZ_WIN; w.wbr = (bf16_t*)p; p += SZ_WBR; w.wout = (bf16_t*)p; p += SZ_WOUT; w.wxq = (bf16_t*)p; p += SZ_WXQ;
    w.wxkv = (bf16_t*)p; p += SZ_WXKV; w.wxo = (bf16_t*)p; p += SZ_WXO; w.wup = (bf16_t*)p; p += SZ_WUP; w.wdn = (bf16_t*)p; return w;
}
constexpr int I_INA = 32 * 96, I_INB = 32 * 336, I_BR = 8 * 64, I_OUT = 32 * 64, I_XQ = 32 * 16, I_XKV = 32 * 32, I_XO = 8 * 64, I_UP = 32 * 256, I_DN = 128 * 64;
constexpr int I_LAYER = I_INA + I_INB + 3 * I_BR + I_OUT + I_XQ + I_XKV + I_XO + I_UP + I_DN;
constexpr int TR_TOTAL = 2 * I_LAYER;
constexpr int TR_DEFER_C = 12288, TR_DEFER_A = 3200;
constexpr int TR_P0_END = TR_TOTAL - TR_DEFER_C - TR_DEFER_A, TR_A_END = TR_TOTAL - TR_DEFER_C;
static_assert(TR_P0_END >= I_LAYER + (I_LAYER - I_UP - I_DN), "only layer-1 MLP weights may be deferred");
__device__ __forceinline__ TrItem tr_item(const Params& P, unsigned char* ws, int it, int& ldw_) {
    const int l = it / I_LAYER; int r = it - l * I_LAYER; const LayerW w = layer_w(ws, l);
    const float* src; int K, nc; bf16_t* dst;
    if (r < I_INA) { src = P.w_in + (size_t)l * DM * DIN_SRC; ldw_ = DIN_SRC; K = DM; nc = 3072; dst = w.win; }
    else if ((r -= I_INA) < I_INB) { src = P.w_in + (size_t)l * DM * DIN_SRC + 3076; ldw_ = DIN_SRC; K = DM; nc = 10752; dst = w.win + (size_t)3072 * DM; }
    else if ((r -= I_INB) < 3 * I_BR) { const int n = r / I_BR; r -= n * I_BR; src = P.w_branch + ((size_t)l * 4 + n) * BW * DM; ldw_ = DM; K = BW; nc = DM; dst = w.wbr + (size_t)n * DM * BW; }
    else if ((r -= 3 * I_BR) < I_OUT) { src = P.w_mix_out + (size_t)l * DM * DM; ldw_ = DM; K = DM; nc = DM; dst = w.wout; }
    else if ((r -= I_OUT) < I_XQ) { src = P.xa_wq + (size_t)l * DM * BW; ldw_ = BW; K = DM; nc = BW; dst = w.wxq; }
    else if ((r -= I_XQ) < I_XKV) { src = P.xa_wkv + (size_t)l * DM * 1024; ldw_ = 1024; K = DM; nc = 1024; dst = w.wxkv; }
    else if ((r -= I_XKV) < I_XO) { src = P.xa_wo + (size_t)l * BW * DM; ldw_ = DM; K = BW; nc = DM; dst = w.wxo; }
    else if ((r -= I_XO) < I_UP) { src = P.mlp_w_up + (size_t)l * DM * HID; ldw_ = HID; K = DM; nc = HID; dst = w.wup; }
    else { r -= I_UP; src = P.mlp_w_down + (size_t)l * HID * DM; ldw_ = DM; K = HID; nc = DM; dst = w.wdn; }
    return tr_decode(src, ldw_, K, nc, dst, r);
}
__device__ __forceinline__ void tr_run(const Params& P, unsigned char* ws, LAS float* scr, int lane, int it0, int it_end, int worker, int nworkers) {
    int it = it0 + worker; TrItem cur; cur.src = nullptr; cur.dst = nullptr; cur.K = 0; f32x4 v[8]; int ldw = 0;
    if (it < it_end) { cur = tr_item(P, ws, it, ldw); tr_load(cur, ldw, lane, v); }
#pragma unroll 1
    while (it < it_end) {
        const int nit = it + nworkers; TrItem nx = cur; f32x4 vn[8]; int ldn = 0;
#pragma unroll
        for (int i = 0; i < 8; ++i) vn[i] = v[i];
        if (nit < it_end) { nx = tr_item(P, ws, nit, ldn); tr_load(nx, ldn, lane, vn); }
        tr_process(cur, scr, lane, v);
        it = nit; cur = nx;
#pragma unroll
        for (int i = 0; i < 8; ++i) v[i] = vn[i];
    }
}
#ifndef PHM
#define PHM 0xFFFFFFFFu
#endif
#define GRID_SYNC() do { asm volatile("s_waitcnt vmcnt(0) lgkmcnt(0)" ::: "memory"); __syncthreads(); \
    if (otid() == 0) { __builtin_amdgcn_fence(__ATOMIC_RELEASE, "agent"); asm volatile("s_waitcnt vmcnt(0)" ::: "memory"); \
        bar_gen += 1u; const unsigned target_ = bar_gen * (unsigned)G; \
        __hip_atomic_fetch_add(bar_ctr, 1u, __ATOMIC_RELAXED, __HIP_MEMORY_SCOPE_AGENT); \
        while (__hip_atomic_load(bar_ctr, __ATOMIC_RELAXED, __HIP_MEMORY_SCOPE_AGENT) < target_) __builtin_amdgcn_s_sleep(1); \
        __builtin_amdgcn_fence(__ATOMIC_ACQUIRE, "agent"); asm volatile("s_waitcnt vmcnt(0)" ::: "memory"); } \
    __syncthreads(); } while (0)

__global__ void __launch_bounds__(512, 2) fwd_megakernel(Params P) {
    extern __shared__ __attribute__((aligned(16))) unsigned char lds_raw[];
    LAS unsigned char* lds = (LAS unsigned char*)lds_raw;
    cg::grid_group grid = cg::this_grid();
    unsigned* bar_ctr = (unsigned*)(P.ws + OFF_BAR); unsigned bar_gen = 0u;
    if (blockIdx.x == 0) { unsigned* ctl = (unsigned*)(P.ws + OFF_BAR); const int t_ = otid();
        for (int i = t_; i < (int)(CTL_BYTES / 16); i += 512) *(u32x4*)(ctl + 4 * i) = (u32x4){0u, 0u, 0u, 0u};
        asm volatile("s_waitcnt vmcnt(0)" ::: "memory"); __syncthreads();
        if (t_ < 64) { __builtin_amdgcn_fence(__ATOMIC_RELEASE, "agent"); asm volatile("s_waitcnt vmcnt(0)" ::: "memory"); } __syncthreads(); }
    grid.sync();
    __builtin_amdgcn_fence(__ATOMIC_ACQUIRE, "agent"); asm volatile("s_waitcnt vmcnt(0)" ::: "memory"); __syncthreads();
    const int G = gridDim.x, bx = blockIdx.x, NGW = G * 8;
#define TID_VARS const int tid = otid(), lane = tid & 63, wave = __builtin_amdgcn_readfirstlane(tid >> 6), gw = bx * 8 + wave; (void)lane; (void)gw;
#define WS_PTRS unsigned char* ws = P.ws; asm volatile("" : "+s"(ws)); \
    bf16_t* Z = (bf16_t*)(ws + OFF_Z); bf16_t* HN = (bf16_t*)(ws + OFF_HN); bf16_t* Y = (bf16_t*)(ws + OFF_Y); bf16_t* MIX = (bf16_t*)(ws + OFF_MIX); \
    bf16_t* SRC = (bf16_t*)(ws + OFF_SRC); bf16_t* XQ = (bf16_t*)(ws + OFF_XQ); bf16_t* XO = (bf16_t*)(ws + OFF_XO); \
    float* HS = (float*)(ws + OFF_HS); float* HDEC = (float*)(ws + OFF_HDEC); float* KBAR = (float*)(ws + OFF_KBAR); float* CF = (float*)(ws + OFF_CF); float* FF = (float*)(ws + OFF_FF); \
    bf16_t* MEMN = (bf16_t*)(ws + OFF_MEMN); bf16_t* MEMKV = (bf16_t*)(ws + OFF_MEMKV); (void)Z; (void)HN; (void)Y; (void)MIX; (void)SRC; (void)XQ; (void)XO; (void)HS; (void)HDEC; (void)KBAR; (void)CF; (void)FF; (void)MEMN; (void)MEMKV;
    if (PHM & 1u) {
        WS_PTRS TID_VARS
        LAS float* scr = (LAS float*)(lds + wave * 8448);
        LAS float* wffl = (LAS float*)(lds + 69632);
        load_wff(wffl, P.w_in);
        tr_run(P, ws, scr, lane, 0, (G == 256 ? TR_P0_END : TR_TOTAL), gw, NGW);
#pragma unroll 1
        for (int it = bx; it < 256; it += G) { const int l = it >> 7; const LayerW w = layer_w(ws, l);
            wpool_item(P.pool_w + (size_t)l * 4 * 128 * 128, P.pool_scale + l * BW, P.w_branch + ((size_t)l * 4 + 3) * BW * DM, w.wbr + (size_t)3 * DM * BW, it); }
#pragma unroll 1
        for (int r = gw; r < 1024 + M; r += NGW) {
            if (r < 1024) { const int l = r >> 9, rr = r & 511;
                row_pass(false, true, false, lane, nullptr, nullptr, P.mem + (size_t)rr * DM, nullptr, P.xa_norm_mem + l * DM, MEMN + (size_t)r * DM, nullptr, nullptr); }
            else { const int r2 = r - 1024; row_pass(false, true, true, lane, nullptr, nullptr, P.x + (size_t)r2 * DM, nullptr, P.mix_norm_pre, HN + (size_t)r2 * DM, wffl, FF + (size_t)r2 * 4); }
        }
    }
    GRID_SYNC();

#pragma unroll 1
#ifndef PH_END
#define PH_END (14 * DEPTH)
#endif
    for (int ph = 0; ph < PH_END; ++ph) {
        const int l = ph / 14, k = ph - 14 * l;
        const bool fused_ok = (G >= 256);
        if (fused_ok && (k == 6 || k == 10 || (k == 13 && l + 1 == DEPTH))) continue;
        WS_PTRS TID_VARS
        const LayerW w = layer_w(ws, l);
        const bool is_gemm = (k == 0) | (k == 4) | (k == 5) | (k == 7) | (k == 9) | (k == 11) | (k == 12);
        if (is_gemm && ((PHM >> (k + 1)) & 1u)) {
            const int njobs = (k == 0 && l == 0) ? 1 + DEPTH : 1;
#pragma unroll 1
            for (int job = 0; job < njobs; ++job) {
                pg8::Gemm g; pg8::StaticOrder S; pg8::Epi E; E.G = nullptr; E.ldg = 0; E.MODE = 0;
                E.hold = nullptr; E.hout = nullptr; E.hn = nullptr; E.gpost = nullptr; E.gpre = nullptr; E.xb1 = nullptr; E.xb2 = nullptr; E.cnt1 = nullptr; E.cnt2 = nullptr; E.has_next = 0;
                int nsub = 1, c0 = 0, ksp = 1, ld = 0; long astr = 0, bstr = 0, ostr = 0; g.M = M;
                if (k == 0 && job == 0) { g.A = HN; g.Bt = w.win; g.N = NZ; g.K = DM; E.O = Z; E.MODE = 4; }
                else if (k == 0) { const int l2 = job - 1; const LayerW w2 = layer_w(ws, l2);
                    g.A = MEMN + (size_t)l2 * 512 * DM; g.Bt = w2.wxkv; g.M = 512; g.N = 1024; g.K = DM; E.O = MEMKV + (size_t)l2 * 512 * 1024; c0 = (G >= 208 ? 192 : 0) + 8 * l2; }
                else if (k == 4) { g.A = Y; g.Bt = w.wbr; g.N = DM; g.K = BW; E.O = MIX; E.G = Z + Z_GL; E.ldg = NZ; E.MODE = 2; nsub = 4; astr = (long)M * BW * 2; bstr = (long)DM * BW * 2; }
                else if (k == 5) { g.A = MIX; g.Bt = w.wout; g.N = DM; g.K = DM; E.O = SRC; }
                else if (k == 7) { g.A = HN; g.Bt = w.wxq; g.N = BW; g.K = BW; ld = DM; E.O = MIX; ksp = 4; astr = BW * 2; bstr = BW * 2; ostr = (long)M * BW; }
                else if (k == 9) { g.A = XO; g.Bt = w.wxo; g.N = DM; g.K = BW; E.O = SRC; }
                else if (k == 11) { g.A = HN; g.Bt = w.wup; g.N = HID; g.K = DM; E.O = Z; E.MODE = 1; }
                else { g.A = Z; g.Bt = w.wdn; g.N = DM; g.K = HID; E.O = SRC; }
                if (fused_ok && (k == 5 || k == 9 || k == 12)) { const int gi = (k == 5) ? 0 : (k == 9) ? 1 : 2;
                    E.MODE = 3; E.hold = (l == 0 && k == 5) ? P.x : P.out; E.hout = P.out; E.hn = HN; E.has_next = !(k == 12 && l + 1 == DEPTH);
                    E.gpost = (k == 5 ? P.mix_norm_post : k == 9 ? P.xa_norm_post : P.mlp_norm_post) + l * DM;
                    E.gpre = (k == 5 ? P.xa_norm_pre + l * DM : k == 9 ? P.mlp_norm_pre + l * DM : P.mix_norm_pre + (l + 1 < DEPTH ? l + 1 : 0) * DM);
                    E.xb1 = (float*)(ws + OFF_XB); E.xb2 = E.xb1 + (size_t)M * 8;
                    E.cnt1 = (unsigned*)(ws + OFF_BAR + 4096) + (size_t)(((l * 3 + gi) * 2 + 0) * 32) * 64; E.cnt2 = E.cnt1 + 32 * 64; }
                E.ldc = g.N; g.lda = ld ? ld : g.K; g.ldb = ld ? ld : g.K;
                S.init(g.M, g.N, G, bx, nsub, astr, bstr, c0, ksp, ostr);
                pg8::gemm_phase(lds, g, S, E);
            }
            if (k == 0 && l == 0 && G == 256 && bx >= 216) tr_run(P, ws, (LAS float*)(lds + wave * 8448), lane, TR_P0_END, TR_A_END, (bx - 216) * 8 + wave, 40 * 8);
            if (k == 0) { const int cb = (G >= 216) ? 208 : 0; if (bx >= cb && bx < cb + 8) cumsum_item(lds, FF, P.fox_f_bias + l * NH, CF, bx - cb); }
        } else if (k == 1 && (PHM & 4u)) {
#pragma unroll 1
            for (int it = bx; it < 1160; it += G) {
                if (it < 256) rope_item(lds, Z, KBAR, it);
                else if (it < 264) { }
                else if (it < 776) hgrn_local_item(lds, Z, P.lb_logits, l, HS, HDEC, it - 264);
                else if (it < 1032) pool_item(Z, Y + (size_t)3 * M * BW, it - 776);
                else kmax_item(Z, (unsigned*)(ws + OFF_BAR + 2048) + l * 8, it - 1032);
            }
        } else if (k == 2 && (PHM & 8u)) {
#pragma unroll 1
            for (int p = bx; p < 256; p += G) {
                const int type = p >> 7, bh = (p >> 4) & 7, s = p & 15, b = bh >> 2, hh = bh & 3;
                const bf16_t* zb = Z + (size_t)b * SEQ * NZ + hh * HD;
#pragma unroll 1
                for (int kk = 0; kk < 2; ++kk) { const int qi = kk ? s : 31 - s;
                    if (type == 0) attn_unit<0>(lds, zb + Z_MQ, NZ, zb + Z_MK, zb + Z_MV, NZ, Y + (size_t)b * SEQ * BW + hh * HD, BW, qi * 128, 2 * qi + 2, nullptr, KBAR + (size_t)bh * 2048);
                    else attn_unit<1>(lds, zb + Z_FQ, NZ, zb + Z_FK, zb + Z_FV, NZ, Y + (size_t)M * BW + (size_t)b * SEQ * BW + hh * HD, BW, qi * 128, 2 * qi + 2, CF + (size_t)bh * SEQ, nullptr, 0, (const unsigned*)(ws + OFF_BAR + 2048) + l * 8 + bh); }
            }
            if (G == 256) { if (bx >= 128) { hgrn_scan(HS, HDEC, (bx - 128) * 512 + tid, 128 * 512);
                if (l == 0) tr_run(P, ws, (LAS float*)(lds + wave * 8448), lane, TR_A_END, TR_TOTAL, (bx - 128) * 8 + wave, 128 * 8); } }
            else hgrn_scan(HS, HDEC, bx * 512 + tid, G * 512);
        } else if (k == 3 && (PHM & 16u)) {
#pragma unroll 1
            for (int it = bx; it < 512; it += G) hgrn_out_item(lds, Z, P.lb_logits, l, HS, P.hgrn_out_norm + l * BW, Y + (size_t)2 * M * BW, it);
        } else if (k == 8 && (PHM & 512u)) {
#pragma unroll 1
            for (int p = bx; p < 256; p += G) { const int b = p >> 7, hh = (p >> 5) & 3, qi = p & 31;
                const bf16_t* kv = MEMKV + ((size_t)l * 512 + b * NMEM) * 1024 + hh * HD;
                attn_unit<2>(lds, MIX + (size_t)b * SEQ * BW + hh * HD, BW, kv, kv + 512, 1024, XO + (size_t)b * SEQ * BW + hh * HD, BW, qi * 128, 4, nullptr, nullptr, (size_t)M * BW); }
        } else if (fused_ok && k == 13) {
            load_wff((LAS float*)lds, P.w_in + (size_t)(l + 1) * DM * DIN_SRC);
#pragma unroll 1
            for (int r = gw; r < M; r += NGW) ff_row(lane, HN + (size_t)r * DM, (const LAS float*)lds, FF + (size_t)r * 4);
        } else if ((k == 6 || k == 10 || k == 13) && (PHM & 64u)) {
            const float* gpost = (k == 6 ? P.mix_norm_post : k == 10 ? P.xa_norm_post : P.mlp_norm_post) + l * DM;
            const float* gpre = (k == 6 ? P.xa_norm_pre + l * DM : k == 10 ? P.mlp_norm_pre + l * DM : P.mix_norm_pre + (l + 1 < DEPTH ? l + 1 : 0) * DM);
            const float* hin = (l == 0 && k == 6) ? P.x : P.out;
            const bool has_next = !(k == 13 && l + 1 == DEPTH), has_ff = (k == 13) && has_next;
            if (has_ff) load_wff((LAS float*)lds, P.w_in + (size_t)(l + 1 < DEPTH ? l + 1 : 0) * DM * DIN_SRC);
#pragma unroll 1
            for (int r = gw; r < M; r += NGW)
                row_pass(true, has_next, has_ff, lane, SRC + (size_t)r * DM, gpost, hin + (size_t)r * DM, P.out + (size_t)r * DM, gpre, HN + (size_t)r * DM, (const LAS float*)lds, FF + (size_t)r * 4);
        }
        if (ph + 1 < (fused_ok ? 14 * DEPTH - 1 : 14 * DEPTH)) GRID_SYNC();
    }
#ifdef DBG_OFF
    { const bf16_t* dbg = (const bf16_t*)(P.ws + DBG_OFF); const int t0 = bx * 512 + otid();
      for (size_t i = t0; i < (size_t)M * DM; i += (size_t)G * 512) P.out[i] = i < (size_t)(DBG_LEN) ? bf2f(dbg[i]) : 0.f; }
#endif
}

extern "C" void kernel_launch(void* const* d_in, const int* in_sizes, int n_in, void* d_out, int out_size, void* d_ws, size_t ws_size, hipStream_t stream) {
    static int grid_blocks = 0;
    if (grid_blocks == 0) {
        if (n_in != 22 || ws_size < WS_END) { fprintf(stderr, "kernel_launch: unexpected inputs (n_in %d, ws %zu, need %zu)\n", n_in, ws_size, (size_t)WS_END); grid_blocks = -1; return; }
        int dev = 0, cus = 0, per_cu = 0;
        (void)hipGetDevice(&dev); (void)hipDeviceGetAttribute(&cus, hipDeviceAttributeMultiprocessorCount, dev);
        (void)hipFuncSetAttribute((const void*)fwd_megakernel, hipFuncAttributeMaxDynamicSharedMemorySize, LDS_BYTES);
        (void)hipOccupancyMaxActiveBlocksPerMultiprocessor(&per_cu, (const void*)fwd_megakernel, 512, LDS_BYTES);
        if (per_cu < 1) fprintf(stderr, "kernel_launch: occupancy query says %d blocks per CU\n", per_cu);
        (void)hipGetLastError();
        grid_blocks = cus > 0 ? cus : 256;
    }
    if (grid_blocks < 0) return;
    Params p{};
    const float** pp = (const float**)&p;
    for (int i = 0; i < 22; ++i) pp[i] = (const float*)d_in[i];
    p.out = (float*)d_out; p.ws = (unsigned char*)d_ws;
    void* args[] = {&p};
    hipError_t e = hipLaunchCooperativeKernel((const void*)fwd_megakernel, dim3(grid_blocks), dim3(512), args, LDS_BYTES, stream);
    if (e != hipSuccess) fprintf(stderr, "cooperative launch failed: %s (grid %d)\n", hipGetErrorString(e), grid_blocks);
}
```

```cpp
#include <hip/hip_runtime.h>
#include <hip/hip_cooperative_groups.h>
#include <cstdio>
#include <cstdint>
namespace cg = cooperative_groups;

#define LAS __attribute__((address_space(3)))
typedef unsigned short bf16_t;
typedef short bf16x8 __attribute__((ext_vector_type(8)));
typedef short s16x4 __attribute__((ext_vector_type(4)));
typedef float f32x4 __attribute__((ext_vector_type(4)));
typedef float f32x16 __attribute__((ext_vector_type(16)));
typedef unsigned u32x4 __attribute__((ext_vector_type(4)));
typedef unsigned u32x2 __attribute__((ext_vector_type(2)));

constexpr int BATCH = 2, SEQ = 4096, DM = 2048, M = BATCH * SEQ, DEPTH = 2;
constexpr int DIN_SRC = 13828, NZ = 13824;
constexpr int Z_MQ = 0, Z_MK = 512, Z_MV = 1024, Z_FQ = 1536, Z_FK = 2048, Z_FV = 2560, Z_HQ = 3072, Z_HF = 3584, Z_HI = 4096, Z_HG = 4608, Z_PIN = 5120, Z_GL = 5632;
constexpr int FF_SRC_COL = 3072;
constexpr int NH = 4, HD = 128, BW = 512, HID = 8192, NMEM = 256;
constexpr float EPS = 1e-6f, MASKV = -1e30f, LOG2E = 1.4426950408889634f;

constexpr size_t MiB = 1u << 20;
constexpr size_t SZ_WIN = (size_t)NZ * DM * 2, SZ_WBR = (size_t)4 * DM * BW * 2, SZ_WOUT = (size_t)DM * DM * 2, SZ_WXQ = (size_t)BW * DM * 2, SZ_WXKV = (size_t)1024 * DM * 2,
                 SZ_WXO = (size_t)DM * BW * 2, SZ_WUP = (size_t)HID * DM * 2, SZ_WDN = (size_t)DM * HID * 2;
constexpr size_t SZ_WL = SZ_WIN + SZ_WBR + SZ_WOUT + SZ_WXQ + SZ_WXKV + SZ_WXO + SZ_WUP + SZ_WDN;
constexpr size_t OFF_W = 0;
constexpr size_t OFF_Z = ((OFF_W + 2 * SZ_WL + MiB - 1) / MiB) * MiB;
constexpr size_t OFF_HN = OFF_Z + (((size_t)M * NZ * 2 + MiB - 1) / MiB) * MiB;
constexpr size_t OFF_Y = OFF_HN + (size_t)M * DM * 2;
constexpr size_t OFF_MIX = OFF_Y + (size_t)4 * M * BW * 2;
constexpr size_t OFF_SRC = OFF_MIX + (size_t)M * DM * 2;
constexpr size_t OFF_XQ = OFF_SRC + (size_t)M * DM * 2;
constexpr size_t OFF_XO = OFF_XQ + (size_t)M * BW * 2;
constexpr size_t OFF_HS = OFF_XO + (size_t)M * BW * 2;
constexpr size_t OFF_HDEC = OFF_HS + (size_t)512 * 128 * 128 * 4;
constexpr size_t OFF_KBAR = OFF_HDEC + (size_t)512 * 128 * 4;
constexpr size_t OFF_CF = OFF_KBAR + (size_t)2 * 4 * 16 * 128 * 4;
constexpr size_t OFF_FF = OFF_CF + (size_t)8 * 4096 * 4;
constexpr size_t OFF_MEMN = OFF_FF + (size_t)M * 4 * 4;
constexpr size_t OFF_MEMKV = OFF_MEMN + (size_t)2 * 512 * DM * 2;
constexpr size_t OFF_LB = OFF_MEMKV + (size_t)2 * 512 * 1024 * 2;
constexpr size_t OFF_BAR = OFF_LB + 2 * 512 * 4;
constexpr size_t CTL_BYTES = 131072;
constexpr size_t OFF_XB = OFF_BAR + CTL_BYTES;
constexpr size_t WS_END = OFF_XB + 2 * (size_t)M * 8 * 4;

__device__ __forceinline__ int otid0() { int t = threadIdx.x; asm volatile("" : "+v"(t)); return t; }
namespace pg8 {
constexpr int BM = 256, BK = 64, HALF = 128, HTB = HALF * BK * 2, STAGE_BYTES = 8 * HTB, NXCD = 8, WGM = 4;
__host__ __device__ __forceinline__ int lds_byte(int r, int c) { const int st = (r >> 4) * 2 + (c >> 5), rr = r & 15, cc = c & 31, ob = rr * 64 + cc * 2; return st * 1024 + (ob ^ (((ob >> 9) & 1) << 5)); }
__host__ __device__ __forceinline__ void stage_rc(int b, int& R, int& C) { const int st = b / 1024, sb = b % 1024, swz = sb ^ (((sb >> 9) & 1) << 5); R = (st >> 1) * 16 + swz / 64; C = (st & 1) * 32 + (swz % 64) / 2; }
__host__ __device__ __forceinline__ int perm32(int rho) { const int n = rho >> 4, i = rho & 15; return 8 * (i >> 2) + 4 * n + (i & 3); }

struct Unit { int pm, pn, n; long aoff, boff, ooff; };
struct Gemm { const bf16_t* A; const bf16_t* Bt; int M, N, K, lda, ldb; };

struct StaticOrder {
    int nM, nN, nwg, G, c, nsub, c0, ksp; long astr, bstr, ostr;
    __device__ void init(int M_, int N_, int G_, int c_, int nsub_ = 1, long astr_ = 0, long bstr_ = 0, int c0_ = 0, int ksp_ = 1, long ostr_ = 0) { nM = M_ / BM; nN = N_ / BM; nwg = nM * nN; G = G_; c = c_; nsub = nsub_; astr = astr_; bstr = bstr_; c0 = c0_; ksp = ksp_; ostr = ostr_; }
    __device__ bool next(int i, Unit& u) const {
        if (c < c0) return false;
        const int ti = i / nsub; u.n = i - ti * nsub;
        const long L = (long)ti * G + (c - c0); if (L >= (long)nwg * ksp) return false;
        const int split = (int)(L / nwg);
        int wgid = (int)(L - (long)split * nwg); { const int q = nwg / NXCD, r = nwg % NXCD, xcd = wgid % NXCD, off = wgid / NXCD; wgid = (xcd < r ? xcd * (q + 1) : r * (q + 1) + (xcd - r) * q) + off; }
        const int nig = WGM * nN, gid = wgid / nig, fm = gid * WGM, gsz = (nM - fm) < WGM ? (nM - fm) : WGM;
        u.pm = fm + ((wgid % nig) % gsz); u.pn = (wgid % nig) / gsz; u.aoff = (u.n + split) * astr; u.boff = (u.n + split) * bstr; u.ooff = split * ostr; return true;
    }
};

typedef float f32x2_t __attribute__((ext_vector_type(2))); typedef __bf16 bf16x2_t __attribute__((ext_vector_type(2)));
__device__ __forceinline__ unsigned cvt_pk_bf16(float lo, float hi) { f32x2_t v = {lo, hi}; bf16x2_t b = __builtin_convertvector(v, bf16x2_t); return __builtin_bit_cast(unsigned, b); }
__device__ __forceinline__ float bf_lo(unsigned w) { return __uint_as_float(w << 16); }
__device__ __forceinline__ float bf_hi(unsigned w) { return __uint_as_float(w & 0xffff0000u); }
__device__ __forceinline__ float sigmoidf_(float x) { return __builtin_amdgcn_rcpf(1.0f + __builtin_amdgcn_exp2f(-x * LOG2E)); }

#define RLX_AGENT __ATOMIC_RELAXED, __HIP_MEMORY_SCOPE_AGENT
struct Epi {
    static constexpr bool PERM = true;
    bf16_t* O; int ldc; const bf16_t* G; int ldg; int MODE;
    const float* hold; float* hout; bf16_t* hn; const float* gpost; const float* gpre; float* xb1; float* xb2; unsigned* cnt1; unsigned* cnt2; int has_next;
    __device__ __forceinline__ void operator()(f32x4 (&acc)[2][2][4][2], const Unit& u, int wr, int wc, int fr, int fq) const {
        const int row0 = u.pm * BM + wr * 64 + fr, col0 = u.pn * BM + wc * 32 + 8 * fq;
        if (MODE == 2) {
            const bool lastb = (u.n == 3);
#pragma unroll
            for (int ai = 0; ai < 2; ++ai)
#pragma unroll
                for (int m = 0; m < 4; ++m) { const size_t row = (size_t)(row0 + ai * HALF + m * 16); const unsigned char* gp = (const unsigned char*)(G + row * ldg) + (size_t)u.n * DM + col0;
#pragma unroll
                    for (int bj = 0; bj < 2; ++bj) { const u32x2 ga = *(const u32x2*)(gp + bj * HALF); u32x2 gb = (u32x2){0x01010101u, 0x01010101u}; if (!lastb) gb = *(const u32x2*)(gp + DM + bj * HALF);
                        float f[8];
#pragma unroll
                        for (int e = 0; e < 4; ++e) { const float a0 = (float)((ga.x >> (8 * e)) & 0xffu), a1 = (float)((ga.y >> (8 * e)) & 0xffu), b0 = (float)((gb.x >> (8 * e)) & 0xffu), b1 = (float)((gb.y >> (8 * e)) & 0xffu);
                            f[e] = lastb ? a0 * (1.0f / 255.0f) : a0 * __builtin_amdgcn_rcpf(b0); f[4 + e] = lastb ? a1 * (1.0f / 255.0f) : a1 * __builtin_amdgcn_rcpf(b1); }
                        f32x4 v0 = acc[ai][bj][m][0], v1 = acc[ai][bj][m][1];
                        v0[0] *= f[0]; v0[1] *= f[1]; v0[2] *= f[2]; v0[3] *= f[3]; v1[0] *= f[4]; v1[1] *= f[5]; v1[2] *= f[6]; v1[3] *= f[7];
                        acc[ai][bj][m][0] = v0; acc[ai][bj][m][1] = v1;
                        if (lastb) { u32x4 w; w.x = cvt_pk_bf16(v0[0], v0[1]); w.y = cvt_pk_bf16(v0[2], v0[3]); w.z = cvt_pk_bf16(v1[0], v1[1]); w.w = cvt_pk_bf16(v1[2], v1[3]);
                            *(u32x4*)(O + row * ldc + col0 + bj * HALF) = w; } } }
            return;
        }
        if (MODE == 4 && u.pn * BM >= Z_GL) {
#pragma unroll
            for (int ai = 0; ai < 2; ++ai)
#pragma unroll
                for (int m = 0; m < 4; ++m) { unsigned char* gp = (unsigned char*)(O + (size_t)(row0 + ai * HALF + m * 16) * ldc + Z_GL) + (col0 - Z_GL);
#pragma unroll
                    for (int bj = 0; bj < 2; ++bj) { const f32x4 v0 = acc[ai][bj][m][0], v1 = acc[ai][bj][m][1]; unsigned q[8];
#pragma unroll
                        for (int e = 0; e < 4; ++e) { q[e] = (unsigned)fmaxf(sigmoidf_(v0[e]) * 255.0f + 0.5f, 1.0f); q[4 + e] = (unsigned)fmaxf(sigmoidf_(v1[e]) * 255.0f + 0.5f, 1.0f); }
                        u32x2 w; w.x = q[0] | (q[1] << 8) | (q[2] << 16) | (q[3] << 24); w.y = q[4] | (q[5] << 8) | (q[6] << 16) | (q[7] << 24);
                        *(u32x2*)(gp + bj * HALF) = w; } }
            return;
        }
#pragma unroll
        for (int ai = 0; ai < 2; ++ai)
#pragma unroll
            for (int m = 0; m < 4; ++m) { const size_t row = (size_t)(row0 + ai * HALF + m * 16); bf16_t* rowp = O + u.ooff + row * ldc + col0;
#pragma unroll
                for (int bj = 0; bj < 2; ++bj) { f32x4 v0 = acc[ai][bj][m][0], v1 = acc[ai][bj][m][1];
                    if (MODE == 1) {
#pragma unroll
                        for (int e = 0; e < 4; ++e) { const float a = fmaxf(v0[e], 0.f), b = fmaxf(v1[e], 0.f); v0[e] = a * a; v1[e] = b * b; } }
                    if (MODE == 2) {
                        const u32x2 g = *(const u32x2*)((const unsigned char*)(G + row * ldg) + (size_t)u.n * DM + col0 + bj * HALF);
                        const float k255 = 1.0f / 255.0f;
                        v0[0] *= (float)(g.x & 0xffu) * k255; v0[1] *= (float)((g.x >> 8) & 0xffu) * k255; v0[2] *= (float)((g.x >> 16) & 0xffu) * k255; v0[3] *= (float)(g.x >> 24) * k255;
                        v1[0] *= (float)(g.y & 0xffu) * k255; v1[1] *= (float)((g.y >> 8) & 0xffu) * k255; v1[2] *= (float)((g.y >> 16) & 0xffu) * k255; v1[3] *= (float)(g.y >> 24) * k255;
                        if (u.n > 0) { const u32x4 o = *(const u32x4*)(rowp + bj * HALF);
                            v0[0] += bf_lo(o.x); v0[1] += bf_hi(o.x); v0[2] += bf_lo(o.y); v0[3] += bf_hi(o.y); v1[0] += bf_lo(o.z); v1[1] += bf_hi(o.z); v1[2] += bf_lo(o.w); v1[3] += bf_hi(o.w); } }
                    u32x4 w; w.x = cvt_pk_bf16(v0[0], v0[1]); w.y = cvt_pk_bf16(v0[2], v0[3]); w.z = cvt_pk_bf16(v1[0], v1[1]); w.w = cvt_pk_bf16(v1[2], v1[3]);
                    *(u32x4*)(rowp + bj * HALF) = w; } }
    }
    __device__ __forceinline__ void panel_rstd(const f32x4 (&v)[2][2][4][2], const Unit& u, int wr, int wc, int fr, int fq, LAS unsigned char* lds, int tid, float* xb, unsigned* cnt) const {
        LAS float* Pt = (LAS float*)lds; LAS float* St = (LAS float*)(lds + 4096);
        const int wid = __builtin_amdgcn_readfirstlane(tid >> 6), lane = tid & 63;
#pragma unroll
        for (int ai = 0; ai < 2; ++ai)
#pragma unroll
            for (int m = 0; m < 4; ++m) { float s = 0.f;
#pragma unroll
                for (int bj = 0; bj < 2; ++bj)
#pragma unroll
                    for (int n = 0; n < 2; ++n) { const f32x4 x = v[ai][bj][m][n]; s += (x[0] * x[0] + x[1] * x[1]) + (x[2] * x[2] + x[3] * x[3]); }
                s += __shfl_xor(s, 16); s += __shfl_xor(s, 32);
                if (fq == 0) Pt[(ai * HALF + wr * 64 + m * 16 + fr) * 4 + wc] = s; }
        asm volatile("s_waitcnt lgkmcnt(0)" ::: "memory"); __builtin_amdgcn_s_barrier(); asm volatile("" ::: "memory");
        if (tid < 256) { const float tot = (Pt[tid * 4 + 0] + Pt[tid * 4 + 1]) + (Pt[tid * 4 + 2] + Pt[tid * 4 + 3]);
            __hip_atomic_store(xb + (size_t)(u.pm * BM + tid) * 8 + u.pn, tot, RLX_AGENT); }
        asm volatile("s_waitcnt vmcnt(0)" ::: "memory");
        if (tid < 256 && lane == 0) __hip_atomic_fetch_add(cnt + 64 * u.pm, 1u, RLX_AGENT);
        if (wid == 0) { unsigned sp = 0;
            while ((unsigned)__builtin_amdgcn_readfirstlane(__hip_atomic_load(cnt + 64 * u.pm, RLX_AGENT)) < 32u) { __builtin_amdgcn_s_sleep(1); if (++sp > (1u << 22)) break; }
            __builtin_amdgcn_fence(__ATOMIC_ACQUIRE, "agent"); }
        asm volatile("s_waitcnt vmcnt(0) lgkmcnt(0)" ::: "memory"); __builtin_amdgcn_s_barrier(); asm volatile("" ::: "memory");
        if (tid < 256) { const float* sl = xb + (size_t)(u.pm * BM + tid) * 8; float q = 0.f;
#pragma unroll
            for (int t = 0; t < 8; ++t) q += __hip_atomic_load(sl + t, RLX_AGENT);
            St[tid] = 1.0f / sqrtf(q * (1.0f / DM) + EPS); }
        asm volatile("s_waitcnt lgkmcnt(0)" ::: "memory"); __builtin_amdgcn_s_barrier(); asm volatile("" ::: "memory");
    }
    __device__ __forceinline__ void fused(f32x4 (&acc)[2][2][4][2], const Unit& u, int wr, int wc, int fr, int fq, LAS unsigned char* lds, int tid) const {
        const LAS float* St = (const LAS float*)(lds + 4096);
        const int col0 = u.pn * BM + wc * 32 + 8 * fq;
        panel_rstd(acc, u, wr, wc, fr, fq, lds, tid, xb1, cnt1);
        {   f32x4 gp[2][2];
#pragma unroll
            for (int bj = 0; bj < 2; ++bj)
#pragma unroll
                for (int n = 0; n < 2; ++n) gp[bj][n] = *(const f32x4*)(gpost + col0 + bj * HALF + 4 * n);
#pragma unroll
            for (int ai = 0; ai < 2; ++ai)
#pragma unroll
                for (int m = 0; m < 4; ++m) { const int r = ai * HALF + wr * 64 + m * 16 + fr; const float rs = St[r]; const size_t off = (size_t)(u.pm * BM + r) * DM + col0;
#pragma unroll
                    for (int bj = 0; bj < 2; ++bj)
#pragma unroll
                        for (int n = 0; n < 2; ++n) { const f32x4 ho = *(const f32x4*)(hold + off + bj * HALF + 4 * n); acc[ai][bj][m][n] = ho + acc[ai][bj][m][n] * rs * gp[bj][n]; }
                    if (!has_next) {
#pragma unroll
                        for (int bj = 0; bj < 2; ++bj)
#pragma unroll
                            for (int n = 0; n < 2; ++n) *(f32x4*)(hout + off + bj * HALF + 4 * n) = acc[ai][bj][m][n]; }
                    if (m & 1) asm volatile("" ::: "memory"); } }
        if (!has_next) return;
        panel_rstd(acc, u, wr, wc, fr, fq, lds, tid, xb2, cnt2);
        {   f32x4 gp[2][2];
#pragma unroll
            for (int bj = 0; bj < 2; ++bj)
#pragma unroll
                for (int n = 0; n < 2; ++n) gp[bj][n] = *(const f32x4*)(gpre + col0 + bj * HALF + 4 * n);
#pragma unroll
            for (int ai = 0; ai < 2; ++ai)
#pragma unroll
                for (int m = 0; m < 4; ++m) { const int r = ai * HALF + wr * 64 + m * 16 + fr; const float rs = St[r]; const size_t off = (size_t)(u.pm * BM + r) * DM + col0;
#pragma unroll
                    for (int bj = 0; bj < 2; ++bj) { const f32x4 x0 = acc[ai][bj][m][0], x1 = acc[ai][bj][m][1];
                        *(f32x4*)(hout + off + bj * HALF) = x0; *(f32x4*)(hout + off + bj * HALF + 4) = x1;
                        const f32x4 y0 = x0 * rs * gp[bj][0], y1 = x1 * rs * gp[bj][1];
                        u32x4 w; w.x = cvt_pk_bf16(y0[0], y0[1]); w.y = cvt_pk_bf16(y0[2], y0[3]); w.z = cvt_pk_bf16(y1[0], y1[1]); w.w = cvt_pk_bf16(y1[2], y1[3]);
                        *(u32x4*)(hn + off + bj * HALF) = w; }
                    if (m & 1) asm volatile("" ::: "memory"); } }
    }
};

template <class EpiT, class Sched>
__device__ __forceinline__ void gemm_phase(LAS unsigned char* lds, const Gemm g, const Sched& S, const EpiT& E) {
    const int tid = otid0(), wid = __builtin_amdgcn_readfirstlane(tid >> 6), lane = tid & 63, wr = wid >> 2, wc = wid & 3, fr = lane & 15, fq = lane >> 4;
    const int K = g.K, nt = K / BK;
    unsigned voffA[2], voffB[2];
#pragma unroll
    for (int i = 0; i < 2; ++i) { int R, C; stage_rc(tid * 16 + i * 8192, R, C); const int Rb = EpiT::PERM ? ((R & ~31) + perm32(R & 31)) : R;
        voffA[i] = (unsigned)(R * g.lda + C) * 2u; voffB[i] = (unsigned)(Rb * g.ldb + C) * 2u; }
    const size_t kstep = (size_t)(BK * 2);
    const size_t hstepA = (size_t)HALF * g.lda * 2, hstepB = (size_t)HALF * g.ldb * 2;
    const size_t tstepA = 2 * hstepA, tstepB = 2 * hstepB;
    const unsigned ldsw = (unsigned)wid * 1024u;
    const int aoff = lds_byte(wr * 64 + fr, fq * 8), boff = lds_byte(wc * 32 + fr, fq * 8);
#define PG8_SA(b, h) (((b) * 2 + (h)) * HTB)
#define PG8_SB(b, h) ((4 + (b) * 2 + (h)) * HTB)
#define PG8_STAGE(bufoff, gbase, voff) do { _Pragma("unroll") for (int _i = 0; _i < 2; ++_i) \
        __builtin_amdgcn_global_load_lds((const unsigned*)((const char*)(gbase) + (voff)[_i]), (LAS unsigned*)(lds + (bufoff) + ldsw + _i * 8192), 16, 0, 0); } while (0)
#define PG8_LDA(dst, b, h) do { _Pragma("unroll") for (int m = 0; m < 4; ++m) _Pragma("unroll") for (int k = 0; k < 2; ++k) dst[m][k] = *(const LAS bf16x8*)(lds + PG8_SA(b, h) + aoff + m * 2048 + k * 1024); } while (0)
#define PG8_LDB(dst, b, h) do { _Pragma("unroll") for (int n = 0; n < 2; ++n) _Pragma("unroll") for (int k = 0; k < 2; ++k) dst[n][k] = *(const LAS bf16x8*)(lds + PG8_SB(b, h) + boff + n * 2048 + k * 1024); } while (0)
#define PG8_MMA(ai, bj, At, Bt) do { __builtin_amdgcn_s_setprio(1); _Pragma("unroll") for (int m = 0; m < 4; ++m) _Pragma("unroll") for (int n = 0; n < 2; ++n) _Pragma("unroll") for (int k = 0; k < 2; ++k) \
        acc[ai][bj][m][n] = __builtin_amdgcn_mfma_f32_16x16x32_bf16(Bt[n][k], At[m][k], acc[ai][bj][m][n], 0, 0, 0); __builtin_amdgcn_s_setprio(0); } while (0)
#define PG8_WAIT_V(n) asm volatile("s_waitcnt vmcnt(" #n ")" ::: "memory")
#define PG8_WAIT_L(n) asm volatile("s_waitcnt lgkmcnt(" #n ")" ::: "memory")
#define PG8_BAR __builtin_amdgcn_s_barrier()
#define PG8_SCHED __builtin_amdgcn_sched_barrier(0)
    Unit cur, nxt; int ui = 0;
    if (!S.next(0, cur)) return;
    f32x4 acc[2][2][4][2];
#pragma unroll
    for (int a = 0; a < 2; ++a)
#pragma unroll
        for (int b = 0; b < 2; ++b)
#pragma unroll
            for (int m = 0; m < 4; ++m)
#pragma unroll
                for (int n = 0; n < 2; ++n) acc[a][b][m][n] = (f32x4){0.f, 0.f, 0.f, 0.f};
    bf16x8 At[4][2], B0[2][2], B1[2][2];
    const char* cA = (const char*)g.A + (size_t)cur.pm * tstepA + cur.aoff; const char* cB = (const char*)g.Bt + (size_t)cur.pn * tstepB + cur.boff;
    PG8_STAGE(PG8_SB(0, 0), cB, voffB); PG8_STAGE(PG8_SB(0, 1), cB + hstepB, voffB); PG8_STAGE(PG8_SA(0, 0), cA, voffA); PG8_STAGE(PG8_SA(0, 1), cA + hstepA, voffA);
    if (wr == 1) PG8_BAR;
    PG8_WAIT_V(2); PG8_BAR;
    PG8_STAGE(PG8_SB(1, 0), cB + kstep, voffB); PG8_STAGE(PG8_SA(1, 0), cA + kstep, voffA); PG8_STAGE(PG8_SB(1, 1), cB + hstepB + kstep, voffB);
    PG8_WAIT_V(6); PG8_BAR;
    for (;;) {
        const bool has_next = S.next(ui + 1, nxt);
        const char* nA = has_next ? (const char*)g.A + (size_t)nxt.pm * tstepA + nxt.aoff : cA; const char* nB = has_next ? (const char*)g.Bt + (size_t)nxt.pn * tstepB + nxt.boff : cB;
        for (int t = 0; t < nt; t += 2) {
            const bool last = (t == nt - 2);
            const char* a1 = cA + (size_t)(t + 1) * kstep;
            const char* a2 = last ? nA : cA + (size_t)(t + 2) * kstep; const char* b2 = last ? nB : cB + (size_t)(t + 2) * kstep;
            const char* a3 = a2 + kstep; const char* b3 = b2 + kstep;
            PG8_LDB(B0, 0, 0); PG8_LDB(B1, 0, 1); PG8_SCHED; PG8_LDA(At, 0, 0); PG8_STAGE(PG8_SA(1, 1), a1 + hstepA, voffA);
            PG8_WAIT_V(8); PG8_WAIT_L(0); PG8_BAR; PG8_MMA(0, 0, At, B0); PG8_MMA(0, 1, At, B1); PG8_BAR; PG8_SCHED;
            PG8_LDA(At, 0, 1); PG8_STAGE(PG8_SB(0, 0), b2, voffB); PG8_STAGE(PG8_SB(0, 1), b2 + hstepB, voffB); PG8_STAGE(PG8_SA(0, 0), a2, voffA);
            PG8_WAIT_V(8); PG8_WAIT_L(0); PG8_BAR; PG8_MMA(1, 0, At, B0); PG8_MMA(1, 1, At, B1); PG8_BAR; PG8_SCHED;
            PG8_LDB(B0, 1, 0); PG8_LDB(B1, 1, 1); PG8_SCHED; PG8_LDA(At, 1, 0); PG8_STAGE(PG8_SA(0, 1), a2 + hstepA, voffA);
            PG8_WAIT_V(8); PG8_WAIT_L(0); PG8_BAR; PG8_MMA(0, 0, At, B0); PG8_MMA(0, 1, At, B1); PG8_BAR; PG8_SCHED;
            PG8_LDA(At, 1, 1); PG8_STAGE(PG8_SB(1, 0), b3, voffB); PG8_STAGE(PG8_SB(1, 1), b3 + hstepB, voffB); PG8_STAGE(PG8_SA(1, 0), a3, voffA);
            PG8_WAIT_V(8); PG8_WAIT_L(0); PG8_BAR; PG8_MMA(1, 0, At, B0); PG8_MMA(1, 1, At, B1); PG8_BAR; PG8_SCHED;
        }
        if (wr == 0) PG8_BAR;
        if (E.MODE != 3) E(acc, cur, wr, wc, fr, fq);
        if (!has_next) break;
        if (!(E.MODE == 2 && nxt.n != 0))
#pragma unroll
        for (int a = 0; a < 2; ++a)
#pragma unroll
            for (int b = 0; b < 2; ++b)
#pragma unroll
                for (int m = 0; m < 4; ++m)
#pragma unroll
                    for (int n = 0; n < 2; ++n) acc[a][b][m][n] = (f32x4){0.f, 0.f, 0.f, 0.f};
        cur = nxt; cA = nA; cB = nB; ++ui;
        if (wr == 1) PG8_BAR;
    }
    PG8_WAIT_V(0);
    PG8_BAR;
    if (E.MODE == 3) E.fused(acc, cur, wr, wc, fr, fq, lds, tid);
#undef PG8_SA
#undef PG8_SB
#undef PG8_STAGE
#undef PG8_LDA
#undef PG8_LDB
#undef PG8_MMA
#undef PG8_WAIT_V
#undef PG8_WAIT_L
#undef PG8_BAR
#undef PG8_SCHED
}
}
using pg8::cvt_pk_bf16; using pg8::bf_lo; using pg8::bf_hi; using pg8::sigmoidf_;

struct Params {
    const float *x, *mem, *lb_logits, *mix_norm_pre, *mix_norm_post, *w_in, *fox_f_bias, *hgrn_out_norm, *pool_w, *pool_scale, *w_branch, *w_mix_out,
                *xa_norm_pre, *xa_norm_mem, *xa_norm_post, *xa_wq, *xa_wkv, *xa_wo, *mlp_norm_pre, *mlp_norm_post, *mlp_w_up, *mlp_w_down;
    float* out; unsigned char* ws;
};
__device__ __forceinline__ float wave_sum(float v) {
#pragma unroll
    for (int o = 1; o < 64; o <<= 1) v += __shfl_xor(v, o);
    return v;
}
__device__ __forceinline__ unsigned f2bf(float f) { unsigned u = __builtin_bit_cast(unsigned, f); return (u + 0x7fffu + ((u >> 16) & 1u)) >> 16; }
__device__ __forceinline__ unsigned pk2(float lo, float hi) { return f2bf(lo) | (f2bf(hi) << 16); }
__device__ __forceinline__ float bf2f(bf16_t v) { return __uint_as_float((unsigned)v << 16); }
#define LDS_WAIT() asm volatile("s_waitcnt lgkmcnt(0)" ::: "memory")
__device__ __forceinline__ int otid() { int t = threadIdx.x; asm volatile("" : "+v"(t)); return t; }

struct TrItem { const float* src; bf16_t* dst; int K; };
__device__ __forceinline__ TrItem tr_decode(const float* W, int ldw, int K, int ncols, bf16_t* WT, int item) {
    const int nblk = ncols / 32, kb = item / nblk, nb = item - kb * nblk; TrItem t; t.src = W + (size_t)(64 * kb) * ldw + 32 * nb; t.dst = WT + (size_t)(32 * nb) * K + 64 * kb; t.K = K; return t;
}
__device__ __forceinline__ void tr_load(const TrItem& t, int ldw, int lane, f32x4 (&v)[8]) {
#pragma unroll
    for (int i = 0; i < 8; ++i) v[i] = *(const f32x4*)(t.src + (size_t)(8 * i + (lane >> 3)) * ldw + 4 * (lane & 7));
}
__device__ __forceinline__ void tr_process(const TrItem& t, LAS float* scr, int lane, const f32x4 (&v)[8]) {
#pragma unroll
    for (int i = 0; i < 8; ++i) { LAS float* d = scr + (8 * i + (lane >> 3)) * 33 + 4 * (lane & 7); d[0] = v[i][0]; d[1] = v[i][1]; d[2] = v[i][2]; d[3] = v[i][3]; }
    LDS_WAIT(); asm volatile("" ::: "memory");
    const int c = lane & 7;
#pragma unroll
    for (int j = 0; j < 4; ++j) { const int n = (lane >> 3) + 8 * j; const LAS float* s = scr + (8 * c) * 33 + n;
        u32x4 o; o.x = pk2(s[0 * 33], s[1 * 33]); o.y = pk2(s[2 * 33], s[3 * 33]); o.z = pk2(s[4 * 33], s[5 * 33]); o.w = pk2(s[6 * 33], s[7 * 33]);
        *(u32x4*)(t.dst + (size_t)n * t.K + 8 * c) = o; }
    LDS_WAIT(); asm volatile("" ::: "memory");
}

__device__ __forceinline__ void row_pass(const bool HAS_SRC, const bool HAS_NEXT, const bool HAS_FF, int lane, const bf16_t* src, const float* gpost, const float* hin, float* hout, const float* gpre, bf16_t* hn, const LAS float* wff, float* ff) {
    asm volatile("" : "+v"(lane));
    f32x4 h[8];
#pragma unroll
    for (int j = 0; j < 8; ++j) h[j] = *(const f32x4*)(hin + 4 * lane + 256 * j);
    if (HAS_SRC) {
        f32x4 s[8]; float ss = 0.f;
#pragma unroll
        for (int j = 0; j < 8; ++j) { const u32x2 w = *(const u32x2*)(src + 4 * lane + 256 * j); s[j] = (f32x4){bf_lo(w.x), bf_hi(w.x), bf_lo(w.y), bf_hi(w.y)};
            ss += (s[j][0] * s[j][0] + s[j][1] * s[j][1]) + (s[j][2] * s[j][2] + s[j][3] * s[j][3]); }
        const float r1 = 1.0f / sqrtf(wave_sum(ss) * (1.0f / DM) + EPS);
#pragma unroll
        for (int j = 0; j < 8; ++j) { const f32x4 g = *(const f32x4*)(gpost + 4 * lane + 256 * j); h[j] = h[j] + s[j] * r1 * g; *(f32x4*)(hout + 4 * lane + 256 * j) = h[j]; }
    }
    if (HAS_NEXT) {
        float ss = 0.f;
#pragma unroll
        for (int j = 0; j < 8; ++j) ss += (h[j][0] * h[j][0] + h[j][1] * h[j][1]) + (h[j][2] * h[j][2] + h[j][3] * h[j][3]);
        const float r2 = 1.0f / sqrtf(wave_sum(ss) * (1.0f / DM) + EPS);
        f32x4 fa = (f32x4){0.f, 0.f, 0.f, 0.f};
#pragma unroll
        for (int j = 0; j < 8; ++j) { const f32x4 g = *(const f32x4*)(gpre + 4 * lane + 256 * j); const f32x4 y = h[j] * r2 * g;
            u32x2 w; w.x = pk2(y[0], y[1]); w.y = pk2(y[2], y[3]); *(u32x2*)(hn + 4 * lane + 256 * j) = w;
            if (HAS_FF) {
#pragma unroll
                for (int e = 0; e < 4; ++e) { const f32x4 wv = *(const LAS f32x4*)(wff + (4 * lane + 256 * j + e) * 4); fa = fa + wv * y[e]; } } }
        if (HAS_FF) { fa[0] = wave_sum(fa[0]); fa[1] = wave_sum(fa[1]); fa[2] = wave_sum(fa[2]); fa[3] = wave_sum(fa[3]); if (lane == 0) *(f32x4*)ff = fa; }
    }
}

constexpr int AT_KSTR = 272, AT_VSTR = 320, AT_KBUF = 64 * AT_KSTR, AT_VBUF = 64 * AT_VSTR;
constexpr int AT_K0 = 0, AT_V0 = 2 * AT_KBUF, AT_CK = AT_V0 + 2 * AT_VBUF, AT_KBAR = AT_CK + 512, AT_VOTE = AT_KBAR + 8192, AT_END = AT_VOTE + 64;
typedef short v4i16_t __attribute__((ext_vector_type(4)));
__device__ __forceinline__ s16x4 vtr(LAS const unsigned char* p) { return __builtin_bit_cast(s16x4, __builtin_amdgcn_ds_read_tr16_b64_v4i16((LAS v4i16_t*)p)); }

template <int MODE>
__device__ __forceinline__ void attn_unit(LAS unsigned char* lds, const bf16_t* Qb, int ldq, const bf16_t* Kb, const bf16_t* Vb, int ldkv, bf16_t* Ob, int ldo, int q0, int ntiles, const float* cf, const float* kbar, size_t qsplit = 0, const unsigned* kmaxp = nullptr) {
    const int tid = otid(), lane = tid & 63, wid = __builtin_amdgcn_readfirstlane(tid >> 6), qg = wid & 3, kh = wid >> 2, r32 = lane & 31, h = lane >> 5;
    const int qrow = q0 + 32 * qg + r32;
    const float C2 = 0.08838834764831845f * LOG2E;
    bf16x8 qf[8];
    { const bf16_t* qp = Qb + (size_t)qrow * ldq + 8 * h;
      if (MODE == 2 && qsplit) {
#pragma unroll
          for (int s = 0; s < 8; ++s) { float a[8];
#pragma unroll
              for (int e = 0; e < 8; ++e) a[e] = 0.f;
#pragma unroll
              for (int ks = 0; ks < 4; ++ks) { const u32x4 w = *(const u32x4*)(qp + ks * qsplit + 16 * s);
                  a[0] += bf_lo(w.x); a[1] += bf_hi(w.x); a[2] += bf_lo(w.y); a[3] += bf_hi(w.y); a[4] += bf_lo(w.z); a[5] += bf_hi(w.z); a[6] += bf_lo(w.w); a[7] += bf_hi(w.w); }
              u32x4 o; o.x = cvt_pk_bf16(a[0], a[1]); o.y = cvt_pk_bf16(a[2], a[3]); o.z = cvt_pk_bf16(a[4], a[5]); o.w = cvt_pk_bf16(a[6], a[7]); qf[s] = __builtin_bit_cast(bf16x8, o); }
      } else {
#pragma unroll
          for (int s = 0; s < 8; ++s) qf[s] = *(const bf16x8*)(qp + 16 * s); } }
    unsigned sel = 0; const int blk = q0 >> 8;
    if (MODE == 0) {
        LAS float* kbl = (LAS float*)(lds + AT_KBAR);
        *(LAS f32x4*)(kbl + 4 * tid) = *(const f32x4*)(kbar + 4 * tid);
        __syncthreads();
        if (blk <= 3) sel = (1u << blk) - 1u;
        else {
            unsigned qw[32];
            { const bf16_t* qp = Qb + (size_t)qrow * ldq + 64 * h;
#pragma unroll
              for (int c8 = 0; c8 < 8; ++c8) { const u32x4 w = *(const u32x4*)(qp + 8 * c8); qw[4 * c8] = w.x; qw[4 * c8 + 1] = w.y; qw[4 * c8 + 2] = w.z; qw[4 * c8 + 3] = w.w; } }
            float v1 = -3.0e38f, v2 = -3.0e38f, v3 = -3.0e38f; int i1 = 0, i2 = 0, i3 = 0;
#pragma unroll 1
            for (int j = 0; j < blk; ++j) { float g = 0.f; const LAS float* kb = kbl + j * 128 + 64 * h;
#pragma unroll
                for (int c4 = 0; c4 < 16; ++c4) { const f32x4 a = *(const LAS f32x4*)(kb + 4 * c4);
                    g += (bf_lo(qw[2 * c4]) * a[0] + bf_hi(qw[2 * c4]) * a[1]) + (bf_lo(qw[2 * c4 + 1]) * a[2] + bf_hi(qw[2 * c4 + 1]) * a[3]); }
                g += __shfl_xor(g, 32);
                if (g > v1) { v3 = v2; i3 = i2; v2 = v1; i2 = i1; v1 = g; i1 = j; }
                else if (g > v2) { v3 = v2; i3 = i2; v2 = g; i2 = j; }
                else if (g > v3) { v3 = g; i3 = j; } }
            sel = (1u << i1) | (1u << i2) | (1u << i3);
        }
    }
    float cq2 = 0.f, qkb = 0.f;
    if (MODE == 1) { cq2 = cf[qrow] * LOG2E;
        float qs = 0.f;
#pragma unroll
        for (int s8 = 0; s8 < 8; ++s8) { const u32x4 w = __builtin_bit_cast(u32x4, qf[s8]);
            const float a0 = bf_lo(w.x), a1 = bf_hi(w.x), a2 = bf_lo(w.y), a3 = bf_hi(w.y), a4 = bf_lo(w.z), a5 = bf_hi(w.z), a6 = bf_lo(w.w), a7 = bf_hi(w.w);
            qs += (a0 * a0 + a1 * a1) + (a2 * a2 + a3 * a3) + (a4 * a4 + a5 * a5) + (a6 * a6 + a7 * a7); }
        qs += __shfl_xor(qs, 32);
        qkb = C2 * sqrtf(qs) * sqrtf(__uint_as_float(*kmaxp)) * 1.01f + 1.0f; }
    LAS unsigned* vote = (LAS unsigned*)(lds + AT_VOTE);
    float m_run = MASKV, l_run = 0.f;
    f32x16 o[4];
#pragma unroll
    for (int d = 0; d < 4; ++d)
#pragma unroll
        for (int r = 0; r < 16; ++r) o[d][r] = 0.f;
    u32x4 kreg[2][2], vreg[2][2]; float ckreg[2] = {0.f, 0.f};
    const int srow = tid >> 4, sch = tid & 15;
#define AT_LOAD(j, S_) do { _Pragma("unroll") for (int i_ = 0; i_ < 2; ++i_) { const size_t go = (size_t)(64 * (j) + srow + 32 * i_) * ldkv + sch * 8; kreg[S_][i_] = *(const u32x4*)(Kb + go); vreg[S_][i_] = *(const u32x4*)(Vb + go); } \
        if (MODE == 1 && tid < 64) ckreg[S_] = cf[64 * (j) + tid] * LOG2E; } while (0)
#define AT_STORE(b, S_) do { _Pragma("unroll") for (int i_ = 0; i_ < 2; ++i_) { *(LAS u32x4*)(lds + AT_K0 + (b) * AT_KBUF + (srow + 32 * i_) * AT_KSTR + sch * 16) = kreg[S_][i_]; \
        *(LAS u32x4*)(lds + AT_V0 + (b) * AT_VBUF + (srow + 32 * i_) * AT_VSTR + sch * 16) = vreg[S_][i_]; } if (MODE == 1 && tid < 64) *(LAS float*)(lds + AT_CK + (b) * 256 + tid * 4) = ckreg[S_]; } while (0)
    AT_LOAD(ntiles - 1, 0); AT_LOAD(ntiles - 2, 1); AT_STORE(0, 0);
    __syncthreads();
    bool done = false;
#pragma unroll 1
    for (int it0 = 0; it0 < ntiles; it0 += 2) {
#pragma unroll
      for (int half = 0; half < 2; ++half) {
        const int it = it0 + half, j = ntiles - 1 - it, cur = half;
        if (it + 2 < ntiles) AT_LOAD(j - 2, half);
        const int kv0 = 64 * j + 32 * kh;
        bool act = true;
        if (MODE != 2) act = !(kv0 > q0 + 32 * qg + 31);
        if (MODE == 1) {
            const float ckmin = *(LAS const float*)(lds + AT_CK + cur * 256 + (32 * kh + 31) * 4);
            const bool dead = __all((qkb + cq2 - ckmin) < (m_run - 40.0f));
            act = act && !dead;
            if (lane == 0) vote[(it & 1) * 8 + wid] = dead ? 0u : 1u;
        }
        if (act) {
            f32x16 p;
#pragma unroll
            for (int r = 0; r < 16; ++r) p[r] = 0.f;
            { LAS const unsigned char* kp = lds + AT_K0 + cur * AT_KBUF + (32 * kh + r32) * AT_KSTR + 16 * h;
#pragma unroll
              for (int s = 0; s < 8; ++s) { const bf16x8 kf = *(LAS const bf16x8*)(kp + 32 * s); p = __builtin_amdgcn_mfma_f32_32x32x16_bf16(kf, qf[s], p, 0, 0, 0); } }
            bool lane_on = true;
            if (MODE == 0) { const int jb = j >> 2; lane_on = (jb == blk) || ((sel >> jb) & 1u); }
            const bool need_mask = (MODE != 2) && ((kv0 + 31 > q0 + 32 * qg) || (MODE == 0 && __any(!lane_on)));
            float mx = MASKV;
            if (MODE == 1) {
#pragma unroll
                for (int g4 = 0; g4 < 4; ++g4) { const f32x4 ck4 = *(LAS const f32x4*)(lds + AT_CK + cur * 256 + (32 * kh + 8 * g4 + 4 * h) * 4);
#pragma unroll
                    for (int e = 0; e < 4; ++e) p[4 * g4 + e] = p[4 * g4 + e] * C2 + (cq2 - ck4[e]); }
            } else {
#pragma unroll
                for (int r = 0; r < 16; ++r) p[r] *= C2;
            }
            if (need_mask) {
#pragma unroll
                for (int r = 0; r < 16; ++r) { const int kvl = (r & 3) + 8 * (r >> 2) + 4 * h; if ((kv0 + kvl > qrow) || !lane_on) p[r] = MASKV; }
            }
#pragma unroll
            for (int r = 0; r < 16; ++r) mx = fmaxf(mx, p[r]);
            mx = fmaxf(mx, __shfl_xor(mx, 32));
            if (__any(mx > m_run)) {
                const float m_new = fmaxf(m_run, mx), alpha = __builtin_amdgcn_exp2f(m_run - m_new); m_run = m_new; l_run *= alpha;
#pragma unroll
                for (int d = 0; d < 4; ++d)
#pragma unroll
                    for (int r = 0; r < 16; ++r) o[d][r] *= alpha;
            }
            float ps = 0.f;
#pragma unroll
            for (int r = 0; r < 16; ++r) { p[r] = __builtin_amdgcn_exp2f(p[r] - m_run); ps += p[r]; }
            l_run += ps;
            bf16x8 pb[2];
#pragma unroll
            for (int s2 = 0; s2 < 2; ++s2) { u32x4 w; w.x = cvt_pk_bf16(p[8 * s2 + 0], p[8 * s2 + 1]); w.y = cvt_pk_bf16(p[8 * s2 + 2], p[8 * s2 + 3]); w.z = cvt_pk_bf16(p[8 * s2 + 4], p[8 * s2 + 5]); w.w = cvt_pk_bf16(p[8 * s2 + 6], p[8 * s2 + 7]);
                pb[s2] = __builtin_bit_cast(bf16x8, w); }
            LAS const unsigned char* vp = lds + AT_V0 + cur * AT_VBUF + (32 * kh + 4 * h + ((lane & 15) >> 2)) * AT_VSTR + (16 * ((lane >> 4) & 1) + 4 * (lane & 3)) * 2;
#pragma unroll
            for (int d = 0; d < 4; ++d)
#pragma unroll
                for (int s2 = 0; s2 < 2; ++s2) { const s16x4 lo = vtr(vp + (16 * s2) * AT_VSTR + 64 * d), hi = vtr(vp + (16 * s2 + 8) * AT_VSTR + 64 * d);
                    const bf16x8 vf = (bf16x8){lo[0], lo[1], lo[2], lo[3], hi[0], hi[1], hi[2], hi[3]};
                    o[d] = __builtin_amdgcn_mfma_f32_32x32x16_bf16(vf, pb[s2], o[d], 0, 0, 0); }
        }
        if (it + 1 < ntiles) AT_STORE(half ^ 1, half ^ 1);
        __syncthreads();
        if (MODE == 1) { const u32x4 v0 = *(LAS const u32x4*)(vote + (it & 1) * 8), v1 = *(LAS const u32x4*)(vote + (it & 1) * 8 + 4);
            if (((v0.x | v0.y) | (v0.z | v0.w) | (v1.x | v1.y) | (v1.z | v1.w)) == 0u) { done = true; break; } }
      }
      if (done) break;
    }
#undef AT_LOAD
#undef AT_STORE
    l_run += __shfl_xor(l_run, 32);
    LAS float* mrg = (LAS float*)lds;
    const int mi = qg * 64 + lane;
    if (kh == 1) {
#pragma unroll
        for (int d = 0; d < 4; ++d)
#pragma unroll
            for (int r = 0; r < 16; ++r) mrg[(d * 16 + r) * 256 + mi] = o[d][r];
        mrg[64 * 256 + mi] = m_run; mrg[65 * 256 + mi] = l_run;
    }
    __syncthreads();
    if (kh == 0) {
        const float m1 = mrg[64 * 256 + mi], l1 = mrg[65 * 256 + mi];
        const float mt = fmaxf(m_run, m1), a0 = __builtin_amdgcn_exp2f(m_run - mt), a1 = __builtin_amdgcn_exp2f(m1 - mt);
        const float inv = 1.0f / (l_run * a0 + l1 * a1);
        bf16_t* op = Ob + (size_t)qrow * ldo + 4 * h;
#pragma unroll
        for (int d = 0; d < 4; ++d)
#pragma unroll
            for (int g4 = 0; g4 < 4; ++g4) { float v[4];
#pragma unroll
                for (int e = 0; e < 4; ++e) { const int r = 4 * g4 + e; v[e] = (o[d][r] * a0 + mrg[(d * 16 + r) * 256 + mi] * a1) * inv; }
                u32x2 w; w.x = cvt_pk_bf16(v[0], v[1]); w.y = cvt_pk_bf16(v[2], v[3]); *(u32x2*)(op + 32 * d + 8 * g4) = w; }
    }
    __syncthreads();
}

__device__ __forceinline__ void rope_item(LAS unsigned char* lds, bf16_t* z, float* kbar_all, int it) {
    const int isk = it >> 7, b = (it >> 6) & 1, blk = (it >> 2) & 15, hh = it & 3, tid = otid(), tg = tid >> 6, dp = tid & 63;
    const int col = (isk ? Z_MK : Z_MQ) + hh * HD + dp;
    const float inv_freq = exp2f(-(float)dp * (13.287712379549449f / 64.0f));
    float s1 = 0.f, s2 = 0.f;
#pragma unroll 1
    for (int i0 = 0; i0 < 32; i0 += 8) {
        float x1[8], x2[8];
#pragma unroll
        for (int i = 0; i < 8; ++i) { const bf16_t* p = z + (size_t)(b * SEQ + blk * 256 + tg * 32 + i0 + i) * NZ + col; x1[i] = bf2f(p[0]); x2[i] = bf2f(p[64]); }
#pragma unroll
        for (int i = 0; i < 8; ++i) { const int t = blk * 256 + tg * 32 + i0 + i; bf16_t* p = z + (size_t)(b * SEQ + t) * NZ + col;
            const float ang = (float)t * inv_freq;
            double rev = (double)ang * 0.15915494309189535; rev -= floor(rev);
            const float rf = (float)rev, sn = __builtin_amdgcn_sinf(rf), cs = __builtin_amdgcn_cosf(rf);
            const float o1 = x1[i] * cs - x2[i] * sn, o2 = x2[i] * cs + x1[i] * sn;
            p[0] = (bf16_t)f2bf(o1); p[64] = (bf16_t)f2bf(o2); s1 += o1; s2 += o2; }
    }
    if (isk) {
        LAS float* red = (LAS float*)lds;
        red[tg * 128 + dp] = s1; red[tg * 128 + 64 + dp] = s2;
        __syncthreads();
        if (tid < 128) { float a = 0.f;
#pragma unroll
            for (int g = 0; g < 8; ++g) a += red[g * 128 + tid];
            kbar_all[((size_t)(b * NH + hh) * 16 + blk) * 128 + tid] = a * (1.0f / 256.0f); }
        __syncthreads();
    }
}
__device__ __forceinline__ void kmax_item(const bf16_t* z, unsigned* kmax2, int it) {
    const int b = it >> 6, blk = (it >> 2) & 15, hh = it & 3, tid = otid(), row = tid >> 1, hf = tid & 1;
    const bf16_t* p = z + (size_t)(b * SEQ + blk * 256 + row) * NZ + Z_FK + hh * HD + 64 * hf; float ss = 0.f;
#pragma unroll
    for (int c8 = 0; c8 < 8; ++c8) { const u32x4 w = *(const u32x4*)(p + 8 * c8);
        const float a0 = bf_lo(w.x), a1 = bf_hi(w.x), a2 = bf_lo(w.y), a3 = bf_hi(w.y), a4 = bf_lo(w.z), a5 = bf_hi(w.z), a6 = bf_lo(w.w), a7 = bf_hi(w.w);
        ss += (a0 * a0 + a1 * a1) + (a2 * a2 + a3 * a3) + (a4 * a4 + a5 * a5) + (a6 * a6 + a7 * a7); }
    ss += __shfl_xor(ss, 1);
#pragma unroll
    for (int o = 2; o < 64; o <<= 1) ss = fmaxf(ss, __shfl_xor(ss, o));
    if ((tid & 63) == 0) atomicMax(kmax2 + b * NH + hh, __float_as_uint(ss));
}
__device__ __forceinline__ float log_sigmoid_(float x) { return fminf(x, 0.f) - log1pf(expf(-fabsf(x))); }
__device__ __forceinline__ void cumsum_item(LAS unsigned char* lds, const float* ff, const float* bias, float* cf, int it) {
    const int b = it >> 2, hh = it & 3, tid = otid(), lane = tid & 63, wid = tid >> 6;
    const float bi = bias[hh]; float v[8]; float run = 0.f;
#pragma unroll
    for (int i = 0; i < 8; ++i) { run += log_sigmoid_(ff[(size_t)(b * SEQ + tid * 8 + i) * 4 + hh] + bi); v[i] = run; }
    float sc = run;
#pragma unroll
    for (int o = 1; o < 64; o <<= 1) { const float t = __shfl_up(sc, o); if (lane >= o) sc += t; }
    LAS float* wt = (LAS float*)lds;
    if (lane == 63) wt[wid] = sc;
    __syncthreads();
    float off = sc - run;
    for (int w = 0; w < wid; ++w) off += wt[w];
#pragma unroll
    for (int i = 0; i < 8; ++i) cf[(size_t)(b * NH + hh) * SEQ + tid * 8 + i] = v[i] + off;
    __syncthreads();
}
template <int W>
__device__ __forceinline__ void pool_rows(const bf16_t* z, bf16_t* y3, int r0, int c) {
    float v[32 + W - 1];
    const int bstart = r0 & ~(SEQ - 1);
#pragma unroll
    for (int i = 0; i < 32 + W - 1; ++i) { const int row = r0 - (W - 1) + i; v[i] = (row >= bstart) ? bf2f(z[(size_t)row * NZ + Z_PIN + c]) : 0.f; }
    float s = 0.f;
#pragma unroll
    for (int i = 0; i < W - 1; ++i) s += v[i];
#pragma unroll
    for (int t = 0; t < 32; ++t) { s += v[t + W - 1]; const int tl = (r0 + t) & (SEQ - 1); const float cnt = (float)((tl + 1 < W) ? (tl + 1) : W);
        y3[(size_t)(r0 + t) * BW + c] = (bf16_t)f2bf(s / cnt - v[t + W - 1]); s -= v[t]; }
}
__device__ __forceinline__ void pool_item(const bf16_t* z, bf16_t* y3, int it) {
    const int c = otid(), g = __builtin_amdgcn_readfirstlane(c >> 7);
    if (g == 0) pool_rows<2>(z, y3, it * 32, c); else if (g == 1) pool_rows<4>(z, y3, it * 32, c); else if (g == 2) pool_rows<8>(z, y3, it * 32, c); else pool_rows<16>(z, y3, it * 32, c);
}

constexpr int HG_STR = 132;
constexpr int HG_Q = 0, HG_K = 64 * HG_STR * 4, HG_B = 2 * 64 * HG_STR * 4, HG_ATT = 3 * 64 * HG_STR * 4, HG_TOT = HG_ATT + 64 * 65 * 4;
__device__ __forceinline__ float hgrn_lb(const float* lbl, int layer, int c) { if (layer == 0) return 0.f; const float g0 = lbl[c], g1 = lbl[512 + c]; return 1.0f / (1.0f + expf(g0 - g1)); }
template <bool WITH_Q>
__device__ __forceinline__ void hgrn_load(LAS unsigned char* lds, const bf16_t* z, const float* lbl, int layer, int row0, int hh) {
    const int tid = otid();
    LAS float* Qm = (LAS float*)(lds + HG_Q); LAS float* Km = (LAS float*)(lds + HG_K); LAS float* Bm = (LAS float*)(lds + HG_B); LAS float* tot = (LAS float*)(lds + HG_TOT);
    { const int d8 = (tid & 15) * 8, r0 = tid >> 4;
#pragma unroll
      for (int rr = 0; rr < 2; ++rr) { const int r = r0 + 32 * rr; const bf16_t* zp = z + (size_t)(row0 + r) * NZ + hh * HD + d8;
          const u32x4 wf = *(const u32x4*)(zp + Z_HF); const unsigned wfa[4] = {wf.x, wf.y, wf.z, wf.w};
          u32x4 wq = (u32x4){0, 0, 0, 0}; if (WITH_Q) wq = *(const u32x4*)(zp + Z_HQ); const unsigned wqa[4] = {wq.x, wq.y, wq.z, wq.w};
#pragma unroll
          for (int e = 0; e < 8; ++e) { const unsigned w = wfa[e >> 1]; const float zf = (e & 1) ? bf_hi(w) : bf_lo(w);
              const float lb = hgrn_lb(lbl, layer, hh * HD + d8 + e), sg = 1.0f / (1.0f + expf(-zf));
              Bm[r * HG_STR + d8 + e] = __builtin_amdgcn_logf(lb + (1.0f - lb) * sg);     Km[r * HG_STR + d8 + e] = (1.0f - lb) * (1.0f - sg);
              if (WITH_Q) { const unsigned q = wqa[e >> 1]; Qm[r * HG_STR + d8 + e] = (e & 1) ? bf_hi(q) : bf_lo(q); } } } }
    __syncthreads();
    const int d = tid & 127, qr = tid >> 7; float run = 0.f;
#pragma unroll
    for (int i = 0; i < 16; ++i) { run += Bm[(16 * qr + i) * HG_STR + d]; Bm[(16 * qr + i) * HG_STR + d] = run; }
    tot[qr * 128 + d] = run;
    __syncthreads();
    float off = 0.f;
    for (int q2 = 0; q2 < qr; ++q2) off += tot[q2 * 128 + d];
#pragma unroll
    for (int i = 0; i < 16; ++i) Bm[(16 * qr + i) * HG_STR + d] += off;
    __syncthreads();
}
__device__ __forceinline__ void hgrn_local_item(LAS unsigned char* lds, const bf16_t* z, const float* lbl, int layer, float* HS, float* HDEC, int it) {
    const int b = it >> 8, hh = (it >> 6) & 3, c = it & 63, row0 = b * SEQ + c * 64, tid = otid();
    hgrn_load<false>(lds, z, lbl, layer, row0, hh);
    LAS float* Vm = (LAS float*)(lds + HG_Q); LAS float* Km = (LAS float*)(lds + HG_K); LAS float* Bm = (LAS float*)(lds + HG_B);
    { const int d8 = (tid & 15) * 8, r0 = tid >> 4;
#pragma unroll
      for (int rr = 0; rr < 2; ++rr) { const int r = r0 + 32 * rr; const u32x4 wv = *(const u32x4*)(z + (size_t)(row0 + r) * NZ + Z_HI + hh * HD + d8); const unsigned wa[4] = {wv.x, wv.y, wv.z, wv.w};
#pragma unroll
          for (int e = 0; e < 8; ++e) Vm[r * HG_STR + d8 + e] = (e & 1) ? bf_hi(wa[e >> 1]) : bf_lo(wa[e >> 1]); } }
    { const int d = tid & 127, qr = tid >> 7; const float bl = Bm[63 * HG_STR + d];
#pragma unroll
      for (int i = 0; i < 16; ++i) { const int s = 16 * qr + i; Km[s * HG_STR + d] *= __builtin_amdgcn_exp2f(bl - Bm[s * HG_STR + d]); }
      if (qr == 0) HDEC[(size_t)it * 128 + d] = __builtin_amdgcn_exp2f(bl); }
    __syncthreads();
    { const int wv = __builtin_amdgcn_readfirstlane(tid >> 6), ln = tid & 63, r32 = ln & 31, h2 = ln >> 5, eb = wv & 3;
      float* dst = HS + (size_t)it * 16384;
#pragma unroll
      for (int q = 0; q < 2; ++q) { const int db = (wv >> 2) * 2 + q; f32x16 c;
#pragma unroll
          for (int r = 0; r < 16; ++r) c[r] = 0.f;
#pragma unroll 8
          for (int kk = 0; kk < 32; ++kk) { const float av = Km[(2 * kk + h2) * HG_STR + 32 * db + r32], bv = Vm[(2 * kk + h2) * HG_STR + 32 * eb + r32];
              c = __builtin_amdgcn_mfma_f32_32x32x2f32(av, bv, c, 0, 0, 0); }
#pragma unroll
          for (int r = 0; r < 16; ++r) dst[(32 * db + (r & 3) + 8 * (r >> 2) + 4 * h2) * 128 + 32 * eb + r32] = c[r]; } }
    __syncthreads();
}
__device__ __forceinline__ void hgrn_scan(float* HS, const float* HDEC, int gtid, int gthreads) {
    for (int el = gtid; el < 8 * 16384; el += gthreads) { const int bh = el >> 14, de = el & 16383, d = de >> 7; float st = 0.f;
        float* p = HS + (size_t)bh * 64 * 16384 + de; const float* dc = HDEC + (size_t)bh * 64 * 128 + d;
#pragma unroll 8
        for (int c = 0; c < 64; ++c) { const float t = p[(size_t)c * 16384]; p[(size_t)c * 16384] = st; st = dc[c * 128] * st + t; } }
}
__device__ __forceinline__ void hgrn_out_item(LAS unsigned char* lds, const bf16_t* z, const float* lbl, int layer, const float* HS, const float* norm_g, bf16_t* y2, int it) {
    const int b = it >> 8, hh = (it >> 6) & 3, c = it & 63, row0 = b * SEQ + c * 64, tid = otid();
    hgrn_load<true>(lds, z, lbl, layer, row0, hh);
    LAS float* Qm = (LAS float*)(lds + HG_Q); LAS float* Km = (LAS float*)(lds + HG_K); LAS float* Bm = (LAS float*)(lds + HG_B); LAS float* At = (LAS float*)(lds + HG_ATT);
    { const int d8 = (tid & 15) * 8, r0 = tid >> 4;
#pragma unroll
      for (int rr = 0; rr < 2; ++rr) { const int r = r0 + 32 * rr;
#pragma unroll
          for (int e = 0; e < 8; ++e) { const float dl = Bm[r * HG_STR + d8 + e] - Bm[31 * HG_STR + d8 + e];
              Qm[r * HG_STR + d8 + e] *= __builtin_amdgcn_exp2f(dl); Km[r * HG_STR + d8 + e] *= __builtin_amdgcn_exp2f(-dl); } } }
    __syncthreads();
    { const int t = tid >> 3, sg = tid & 7; float a[8];
#pragma unroll
      for (int j = 0; j < 8; ++j) a[j] = 0.f;
      for (int d = 0; d < 128; d += 4) { const f32x4 q = *(const LAS f32x4*)(Qm + t * HG_STR + d);
#pragma unroll
          for (int j = 0; j < 8; ++j) { const int s = sg + 8 * j; if (s <= t) { const f32x4 k = *(const LAS f32x4*)(Km + s * HG_STR + d);
              a[j] += (q[0] * k[0] + q[1] * k[1]) + (q[2] * k[2] + q[3] * k[3]); } } }
#pragma unroll
      for (int j = 0; j < 8; ++j) At[t * 65 + sg + 8 * j] = a[j]; }
    __syncthreads();
    const float* Sg = HS + (size_t)it * 16384;
    f32x4 sreg[4];
#pragma unroll
    for (int i = 0; i < 4; ++i) sreg[i] = *(const f32x4*)(Sg + (size_t)(tid + 512 * i) * 4);
    { const int d8 = (tid & 15) * 8, r0 = tid >> 4;
#pragma unroll
      for (int rr = 0; rr < 2; ++rr) { const int r = r0 + 32 * rr; const u32x4 wv = *(const u32x4*)(z + (size_t)(row0 + r) * NZ + Z_HI + hh * HD + d8); const unsigned wa[4] = {wv.x, wv.y, wv.z, wv.w};
#pragma unroll
          for (int e = 0; e < 8; ++e) { Km[r * HG_STR + d8 + e] = (e & 1) ? bf_hi(wa[e >> 1]) : bf_lo(wa[e >> 1]); Qm[r * HG_STR + d8 + e] *= __builtin_amdgcn_exp2f(Bm[31 * HG_STR + d8 + e]); } } }
    __syncthreads();
    const int wv = __builtin_amdgcn_readfirstlane(tid >> 6), ln = tid & 63, r32 = ln & 31, h2 = ln >> 5, tb = wv >> 2, eb = wv & 3;
    f32x16 oc;
#pragma unroll
    for (int r = 0; r < 16; ++r) oc[r] = 0.f;
#pragma unroll 1
    for (int hf = 0; hf < 2; ++hf) {
#pragma unroll
        for (int i = 0; i < 4; ++i) { const int f4 = tid + 512 * i, dr = f4 >> 5, ec = (f4 & 31) * 4; *(LAS f32x4*)(Bm + dr * HG_STR + ec) = sreg[i]; }
        __syncthreads();
        if (hf == 0) {
#pragma unroll
            for (int i = 0; i < 4; ++i) sreg[i] = *(const f32x4*)(Sg + 8192 + (size_t)(tid + 512 * i) * 4); }
#pragma unroll 8
        for (int kk = 0; kk < 32; ++kk) { const float av = Qm[(32 * tb + r32) * HG_STR + 64 * hf + 2 * kk + h2], bv = Bm[(2 * kk + h2) * HG_STR + 32 * eb + r32];
            oc = __builtin_amdgcn_mfma_f32_32x32x2f32(av, bv, oc, 0, 0, 0); }
        __syncthreads();
    }
#pragma unroll 8
    for (int kk = 0; kk < 32; ++kk) { const float av = At[(32 * tb + r32) * 65 + 2 * kk + h2], bv = Km[(2 * kk + h2) * HG_STR + 32 * eb + r32];
        oc = __builtin_amdgcn_mfma_f32_32x32x2f32(av, bv, oc, 0, 0, 0); }
    { LAS float* red = Bm;
#pragma unroll
      for (int r = 0; r < 16; ++r) { float ss = oc[r] * oc[r];
#pragma unroll
          for (int o = 1; o < 32; o <<= 1) ss += __shfl_xor(ss, o);
          if (r32 == 0) red[(32 * tb + (r & 3) + 8 * (r >> 2) + 4 * h2) * 4 + eb] = ss; }
      __syncthreads();
      const int e = 32 * eb + r32; const float ng = norm_g[hh * HD + e];
#pragma unroll
      for (int r = 0; r < 16; ++r) { const int t = 32 * tb + (r & 3) + 8 * (r >> 2) + 4 * h2; const f32x4 pr = *(const LAS f32x4*)(red + t * 4);
          const float rs = 1.0f / sqrtf(((pr[0] + pr[1]) + (pr[2] + pr[3])) * (1.0f / 128.0f) + EPS);
          const size_t row = (size_t)(row0 + t); const float g = bf2f(z[row * NZ + Z_HG + hh * HD + e]);
          y2[row * BW + hh * HD + e] = (bf16_t)f2bf(oc[r] * rs * ng * g * sigmoidf_(g)); } }
    __syncthreads();
}

__device__ __forceinline__ void wpool_item(const float* pool_w, const float* pool_scale, const float* wb3, bf16_t* dst, int it) {
    const int g = (it >> 5) & 3, c0 = ((it >> 2) & 7) * 16, nn = (it & 3) * 512 + otid();
    float acc[16];
#pragma unroll
    for (int i = 0; i < 16; ++i) acc[i] = 0.f;
    for (int e = 0; e < 128; ++e) { const float wb = wb3[(size_t)(g * 128 + e) * DM + nn] * pool_scale[g * 128 + e];
#pragma unroll
        for (int i = 0; i < 16; ++i) acc[i] += pool_w[((size_t)g * 128 + c0 + i) * 128 + e] * wb; }
    u32x4 w0, w1; w0.x = pk2(acc[0], acc[1]); w0.y = pk2(acc[2], acc[3]); w0.z = pk2(acc[4], acc[5]); w0.w = pk2(acc[6], acc[7]);
    w1.x = pk2(acc[8], acc[9]); w1.y = pk2(acc[10], acc[11]); w1.z = pk2(acc[12], acc[13]); w1.w = pk2(acc[14], acc[15]);
    bf16_t* p = dst + (size_t)nn * BW + g * 128 + c0; *(u32x4*)p = w0; *(u32x4*)(p + 8) = w1;
}

__device__ __forceinline__ void load_wff(LAS float* dst, const float* win) {
    const int tid = otid();
#pragma unroll
    for (int i = 0; i < 4; ++i) { const int k = tid + 512 * i; *(LAS f32x4*)(dst + 4 * k) = *(const f32x4*)(win + (size_t)k * DIN_SRC + FF_SRC_COL); }
    __syncthreads();
}
__device__ __forceinline__ void ff_row(int lane, const bf16_t* hn, const LAS float* wff, float* ff) {
    asm volatile("" : "+v"(lane));
    f32x4 fa = (f32x4){0.f, 0.f, 0.f, 0.f};
#pragma unroll
    for (int j = 0; j < 8; ++j) { const u32x2 w = *(const u32x2*)(hn + 4 * lane + 256 * j); const float y[4] = {bf_lo(w.x), bf_hi(w.x), bf_lo(w.y), bf_hi(w.y)};
#pragma unroll
        for (int e = 0; e < 4; ++e) { const f32x4 wv = *(const LAS f32x4*)(wff + (4 * lane + 256 * j + e) * 4); fa = fa + wv * y[e]; } }
    fa[0] = wave_sum(fa[0]); fa[1] = wave_sum(fa[1]); fa[2] = wave_sum(fa[2]); fa[3] = wave_sum(fa[3]); if (lane == 0) *(f32x4*)ff = fa;
}
constexpr int LDS_BYTES = 147456;
struct LayerW { bf16_t *win, *wbr, *wout, *wxq, *wxkv, *wxo, *wup, *wdn; };
__device__ __forceinline__ LayerW layer_w(unsigned char* ws, int l) {
    LayerW w; unsigned char* p = ws + OFF_W + (size_t)l * SZ_WL;
    w.win = (bf16_t*)p; p += SZ_WIN; w.wbr = (bf16_t*)p; p += SZ_WBR; w.wout = (bf16_t*)p; p += SZ_WOUT; w.wxq = (bf16_t*)p; p += SZ_WXQ;
    w.wxkv = (bf16_t*)p; p += SZ_WXKV; w.wxo = (bf16_t*)p; p += SZ_WXO; w.wup = (bf16_t*)p; p += SZ_WUP; w.wdn = (bf16_t*)p; return w;
}
constexpr int I_INA = 32 * 96, I_INB = 32 * 336, I_BR = 8 * 64, I_OUT = 32 * 64, I_XQ = 32 * 16, I_XKV = 32 * 32, I_XO = 8 * 64, I_UP = 32 * 256, I_DN = 128 * 64;
constexpr int I_LAYER = I_INA + I_INB + 3 * I_BR + I_OUT + I_XQ + I_XKV + I_XO + I_UP + I_DN;
constexpr int TR_TOTAL = 2 * I_LAYER;
constexpr int TR_DEFER_C = 12288, TR_DEFER_A = 3200;
constexpr int TR_P0_END = TR_TOTAL - TR_DEFER_C - TR_DEFER_A, TR_A_END = TR_TOTAL - TR_DEFER_C;
static_assert(TR_P0_END >= I_LAYER + (I_LAYER - I_UP - I_DN), "only layer-1 MLP weights may be deferred");
__device__ __forceinline__ TrItem tr_item(const Params& P, unsigned char* ws, int it, int& ldw_) {
    const int l = it / I_LAYER; int r = it - l * I_LAYER; const LayerW w = layer_w(ws, l);
    const float* src; int K, nc; bf16_t* dst;
    if (r < I_INA) { src = P.w_in + (size_t)l * DM * DIN_SRC; ldw_ = DIN_SRC; K = DM; nc = 3072; dst = w.win; }
    else if ((r -= I_INA) < I_INB) { src = P.w_in + (size_t)l * DM * DIN_SRC + 3076; ldw_ = DIN_SRC; K = DM; nc = 10752; dst = w.win + (size_t)3072 * DM; }
    else if ((r -= I_INB) < 3 * I_BR) { const int n = r / I_BR; r -= n * I_BR; src = P.w_branch + ((size_t)l * 4 + n) * BW * DM; ldw_ = DM; K = BW; nc = DM; dst = w.wbr + (size_t)n * DM * BW; }
    else if ((r -= 3 * I_BR) < I_OUT) { src = P.w_mix_out + (size_t)l * DM * DM; ldw_ = DM; K = DM; nc = DM; dst = w.wout; }
    else if ((r -= I_OUT) < I_XQ) { src = P.xa_wq + (size_t)l * DM * BW; ldw_ = BW; K = DM; nc = BW; dst = w.wxq; }
    else if ((r -= I_XQ) < I_XKV) { src = P.xa_wkv + (size_t)l * DM * 1024; ldw_ = 1024; K = DM; nc = 1024; dst = w.wxkv; }
    else if ((r -= I_XKV) < I_XO) { src = P.xa_wo + (size_t)l * BW * DM; ldw_ = DM; K = BW; nc = DM; dst = w.wxo; }
    else if ((r -= I_XO) < I_UP) { src = P.mlp_w_up + (size_t)l * DM * HID; ldw_ = HID; K = DM; nc = HID; dst = w.wup; }
    else { r -= I_UP; src = P.mlp_w_down + (size_t)l * HID * DM; ldw_ = DM; K = HID; nc = DM; dst = w.wdn; }
    return tr_decode(src, ldw_, K, nc, dst, r);
}
__device__ __forceinline__ void tr_run(const Params& P, unsigned char* ws, LAS float* scr, int lane, int it0, int it_end, int worker, int nworkers) {
    int it = it0 + worker; TrItem cur; cur.src = nullptr; cur.dst = nullptr; cur.K = 0; f32x4 v[8]; int ldw = 0;
    if (it < it_end) { cur = tr_item(P, ws, it, ldw); tr_load(cur, ldw, lane, v); }
#pragma unroll 1
    while (it < it_end) {
        const int nit = it + nworkers; TrItem nx = cur; f32x4 vn[8]; int ldn = 0;
#pragma unroll
        for (int i = 0; i < 8; ++i) vn[i] = v[i];
        if (nit < it_end) { nx = tr_item(P, ws, nit, ldn); tr_load(nx, ldn, lane, vn); }
        tr_process(cur, scr, lane, v);
        it = nit; cur = nx;
#pragma unroll
        for (int i = 0; i < 8; ++i) v[i] = vn[i];
    }
}
#ifndef PHM
#define PHM 0xFFFFFFFFu
#endif
#define GRID_SYNC() do { asm volatile("s_waitcnt vmcnt(0) lgkmcnt(0)" ::: "memory"); __syncthreads(); \
    if (otid() == 0) { __builtin_amdgcn_fence(__ATOMIC_RELEASE, "agent"); asm volatile("s_waitcnt vmcnt(0)" ::: "memory"); \
        bar_gen += 1u; const unsigned target_ = bar_gen * (unsigned)G; \
        __hip_atomic_fetch_add(bar_ctr, 1u, __ATOMIC_RELAXED, __HIP_MEMORY_SCOPE_AGENT); \
        while (__hip_atomic_load(bar_ctr, __ATOMIC_RELAXED, __HIP_MEMORY_SCOPE_AGENT) < target_) __builtin_amdgcn_s_sleep(1); \
        __builtin_amdgcn_fence(__ATOMIC_ACQUIRE, "agent"); asm volatile("s_waitcnt vmcnt(0)" ::: "memory"); } \
    __syncthreads(); } while (0)

__global__ void __launch_bounds__(512, 2) fwd_megakernel(Params P) {
    extern __shared__ __attribute__((aligned(16))) unsigned char lds_raw[];
    LAS unsigned char* lds = (LAS unsigned char*)lds_raw;
    cg::grid_group grid = cg::this_grid();
    unsigned* bar_ctr = (unsigned*)(P.ws + OFF_BAR); unsigned bar_gen = 0u;
    if (blockIdx.x == 0) { unsigned* ctl = (unsigned*)(P.ws + OFF_BAR); const int t_ = otid();
        for (int i = t_; i < (int)(CTL_BYTES / 16); i += 512) *(u32x4*)(ctl + 4 * i) = (u32x4){0u, 0u, 0u, 0u};
        asm volatile("s_waitcnt vmcnt(0)" ::: "memory"); __syncthreads();
        if (t_ < 64) { __builtin_amdgcn_fence(__ATOMIC_RELEASE, "agent"); asm volatile("s_waitcnt vmcnt(0)" ::: "memory"); } __syncthreads(); }
    grid.sync();
    __builtin_amdgcn_fence(__ATOMIC_ACQUIRE, "agent"); asm volatile("s_waitcnt vmcnt(0)" ::: "memory"); __syncthreads();
    const int G = gridDim.x, bx = blockIdx.x, NGW = G * 8;
#define TID_VARS const int tid = otid(), lane = tid & 63, wave = __builtin_amdgcn_readfirstlane(tid >> 6), gw = bx * 8 + wave; (void)lane; (void)gw;
#define WS_PTRS unsigned char* ws = P.ws; asm volatile("" : "+s"(ws)); \
    bf16_t* Z = (bf16_t*)(ws + OFF_Z); bf16_t* HN = (bf16_t*)(ws + OFF_HN); bf16_t* Y = (bf16_t*)(ws + OFF_Y); bf16_t* MIX = (bf16_t*)(ws + OFF_MIX); \
    bf16_t* SRC = (bf16_t*)(ws + OFF_SRC); bf16_t* XQ = (bf16_t*)(ws + OFF_XQ); bf16_t* XO = (bf16_t*)(ws + OFF_XO); \
    float* HS = (float*)(ws + OFF_HS); float* HDEC = (float*)(ws + OFF_HDEC); float* KBAR = (float*)(ws + OFF_KBAR); float* CF = (float*)(ws + OFF_CF); float* FF = (float*)(ws + OFF_FF); \
    bf16_t* MEMN = (bf16_t*)(ws + OFF_MEMN); bf16_t* MEMKV = (bf16_t*)(ws + OFF_MEMKV); (void)Z; (void)HN; (void)Y; (void)MIX; (void)SRC; (void)XQ; (void)XO; (void)HS; (void)HDEC; (void)KBAR; (void)CF; (void)FF; (void)MEMN; (void)MEMKV;
    if (PHM & 1u) {
        WS_PTRS TID_VARS
        LAS float* scr = (LAS float*)(lds + wave * 8448);
        LAS float* wffl = (LAS float*)(lds + 69632);
        load_wff(wffl, P.w_in);
        tr_run(P, ws, scr, lane, 0, (G == 256 ? TR_P0_END : TR_TOTAL), gw, NGW);
#pragma unroll 1
        for (int it = bx; it < 256; it += G) { const int l = it >> 7; const LayerW w = layer_w(ws, l);
            wpool_item(P.pool_w + (size_t)l * 4 * 128 * 128, P.pool_scale + l * BW, P.w_branch + ((size_t)l * 4 + 3) * BW * DM, w.wbr + (size_t)3 * DM * BW, it); }
#pragma unroll 1
        for (int r = gw; r < 1024 + M; r += NGW) {
            if (r < 1024) { const int l = r >> 9, rr = r & 511;
                row_pass(false, true, false, lane, nullptr, nullptr, P.mem + (size_t)rr * DM, nullptr, P.xa_norm_mem + l * DM, MEMN + (size_t)r * DM, nullptr, nullptr); }
            else { const int r2 = r - 1024; row_pass(false, true, true, lane, nullptr, nullptr, P.x + (size_t)r2 * DM, nullptr, P.mix_norm_pre, HN + (size_t)r2 * DM, wffl, FF + (size_t)r2 * 4); }
        }
    }
    GRID_SYNC();

#pragma unroll 1
#ifndef PH_END
#define PH_END (14 * DEPTH)
#endif
    for (int ph = 0; ph < PH_END; ++ph) {
        const int l = ph / 14, k = ph - 14 * l;
        const bool fused_ok = (G >= 256);
        if (fused_ok && (k == 6 || k == 10 || (k == 13 && l + 1 == DEPTH))) continue;
        WS_PTRS TID_VARS
        const LayerW w = layer_w(ws, l);
        const bool is_gemm = (k == 0) | (k == 4) | (k == 5) | (k == 7) | (k == 9) | (k == 11) | (k == 12);
        if (is_gemm && ((PHM >> (k + 1)) & 1u)) {
            const int njobs = (k == 0 && l == 0) ? 1 + DEPTH : 1;
#pragma unroll 1
            for (int job = 0; job < njobs; ++job) {
                pg8::Gemm g; pg8::StaticOrder S; pg8::Epi E; E.G = nullptr; E.ldg = 0; E.MODE = 0;
                E.hold = nullptr; E.hout = nullptr; E.hn = nullptr; E.gpost = nullptr; E.gpre = nullptr; E.xb1 = nullptr; E.xb2 = nullptr; E.cnt1 = nullptr; E.cnt2 = nullptr; E.has_next = 0;
                int nsub = 1, c0 = 0, ksp = 1, ld = 0; long astr = 0, bstr = 0, ostr = 0; g.M = M;
                if (k == 0 && job == 0) { g.A = HN; g.Bt = w.win; g.N = NZ; g.K = DM; E.O = Z; E.MODE = 4; }
                else if (k == 0) { const int l2 = job - 1; const LayerW w2 = layer_w(ws, l2);
                    g.A = MEMN + (size_t)l2 * 512 * DM; g.Bt = w2.wxkv; g.M = 512; g.N = 1024; g.K = DM; E.O = MEMKV + (size_t)l2 * 512 * 1024; c0 = (G >= 208 ? 192 : 0) + 8 * l2; }
                else if (k == 4) { g.A = Y; g.Bt = w.wbr; g.N = DM; g.K = BW; E.O = MIX; E.G = Z + Z_GL; E.ldg = NZ; E.MODE = 2; nsub = 4; astr = (long)M * BW * 2; bstr = (long)DM * BW * 2; }
                else if (k == 5) { g.A = MIX; g.Bt = w.wout; g.N = DM; g.K = DM; E.O = SRC; }
                else if (k == 7) { g.A = HN; g.Bt = w.wxq; g.N = BW; g.K = BW; ld = DM; E.O = MIX; ksp = 4; astr = BW * 2; bstr = BW * 2; ostr = (long)M * BW; }
                else if (k == 9) { g.A = XO; g.Bt = w.wxo; g.N = DM; g.K = BW; E.O = SRC; }
                else if (k == 11) { g.A = HN; g.Bt = w.wup; g.N = HID; g.K = DM; E.O = Z; E.MODE = 1; }
                else { g.A = Z; g.Bt = w.wdn; g.N = DM; g.K = HID; E.O = SRC; }
                if (fused_ok && (k == 5 || k == 9 || k == 12)) { const int gi = (k == 5) ? 0 : (k == 9) ? 1 : 2;
                    E.MODE = 3; E.hold = (l == 0 && k == 5) ? P.x : P.out; E.hout = P.out; E.hn = HN; E.has_next = !(k == 12 && l + 1 == DEPTH);
                    E.gpost = (k == 5 ? P.mix_norm_post : k == 9 ? P.xa_norm_post : P.mlp_norm_post) + l * DM;
                    E.gpre = (k == 5 ? P.xa_norm_pre + l * DM : k == 9 ? P.mlp_norm_pre + l * DM : P.mix_norm_pre + (l + 1 < DEPTH ? l + 1 : 0) * DM);
                    E.xb1 = (float*)(ws + OFF_XB); E.xb2 = E.xb1 + (size_t)M * 8;
                    E.cnt1 = (unsigned*)(ws + OFF_BAR + 4096) + (size_t)(((l * 3 + gi) * 2 + 0) * 32) * 64; E.cnt2 = E.cnt1 + 32 * 64; }
                E.ldc = g.N; g.lda = ld ? ld : g.K; g.ldb = ld ? ld : g.K;
                S.init(g.M, g.N, G, bx, nsub, astr, bstr, c0, ksp, ostr);
                pg8::gemm_phase(lds, g, S, E);
            }
            if (k == 0 && l == 0 && G == 256 && bx >= 216) tr_run(P, ws, (LAS float*)(lds + wave * 8448), lane, TR_P0_END, TR_A_END, (bx - 216) * 8 + wave, 40 * 8);
            if (k == 0) { const int cb = (G >= 216) ? 208 : 0; if (bx >= cb && bx < cb + 8) cumsum_item(lds, FF, P.fox_f_bias + l * NH, CF, bx - cb); }
        } else if (k == 1 && (PHM & 4u)) {
#pragma unroll 1
            for (int it = bx; it < 1160; it += G) {
                if (it < 256) rope_item(lds, Z, KBAR, it);
                else if (it < 264) { }
                else if (it < 776) hgrn_local_item(lds, Z, P.lb_logits, l, HS, HDEC, it - 264);
                else if (it < 1032) pool_item(Z, Y + (size_t)3 * M * BW, it - 776);
                else kmax_item(Z, (unsigned*)(ws + OFF_BAR + 2048) + l * 8, it - 1032);
            }
        } else if (k == 2 && (PHM & 8u)) {
#pragma unroll 1
            for (int p = bx; p < 256; p += G) {
                const int type = p >> 7, bh = (p >> 4) & 7, s = p & 15, b = bh >> 2, hh = bh & 3;
                const bf16_t* zb = Z + (size_t)b * SEQ * NZ + hh * HD;
#pragma unroll 1
                for (int kk = 0; kk < 2; ++kk) { const int qi = kk ? s : 31 - s;
                    if (type == 0) attn_unit<0>(lds, zb + Z_MQ, NZ, zb + Z_MK, zb + Z_MV, NZ, Y + (size_t)b * SEQ * BW + hh * HD, BW, qi * 128, 2 * qi + 2, nullptr, KBAR + (size_t)bh * 2048);
                    else attn_unit<1>(lds, zb + Z_FQ, NZ, zb + Z_FK, zb + Z_FV, NZ, Y + (size_t)M * BW + (size_t)b * SEQ * BW + hh * HD, BW, qi * 128, 2 * qi + 2, CF + (size_t)bh * SEQ, nullptr, 0, (const unsigned*)(ws + OFF_BAR + 2048) + l * 8 + bh); }
            }
            if (G == 256) { if (bx >= 128) { hgrn_scan(HS, HDEC, (bx - 128) * 512 + tid, 128 * 512);
                if (l == 0) tr_run(P, ws, (LAS float*)(lds + wave * 8448), lane, TR_A_END, TR_TOTAL, (bx - 128) * 8 + wave, 128 * 8); } }
            else hgrn_scan(HS, HDEC, bx * 512 + tid, G * 512);
        } else if (k == 3 && (PHM & 16u)) {
#pragma unroll 1
            for (int it = bx; it < 512; it += G) hgrn_out_item(lds, Z, P.lb_logits, l, HS, P.hgrn_out_norm + l * BW, Y + (size_t)2 * M * BW, it);
        } else if (k == 8 && (PHM & 512u)) {
#pragma unroll 1
            for (int p = bx; p < 256; p += G) { const int b = p >> 7, hh = (p >> 5) & 3, qi = p & 31;
                const bf16_t* kv = MEMKV + ((size_t)l * 512 + b * NMEM) * 1024 + hh * HD;
                attn_unit<2>(lds, MIX + (size_t)b * SEQ * BW + hh * HD, BW, kv, kv + 512, 1024, XO + (size_t)b * SEQ * BW + hh * HD, BW, qi * 128, 4, nullptr, nullptr, (size_t)M * BW); }
        } else if (fused_ok && k == 13) {
            load_wff((LAS float*)lds, P.w_in + (size_t)(l + 1) * DM * DIN_SRC);
#pragma unroll 1
            for (int r = gw; r < M; r += NGW) ff_row(lane, HN + (size_t)r * DM, (const LAS float*)lds, FF + (size_t)r * 4);
        } else if ((k == 6 || k == 10 || k == 13) && (PHM & 64u)) {
            const float* gpost = (k == 6 ? P.mix_norm_post : k == 10 ? P.xa_norm_post : P.mlp_norm_post) + l * DM;
            const float* gpre = (k == 6 ? P.xa_norm_pre + l * DM : k == 10 ? P.mlp_norm_pre + l * DM : P.mix_norm_pre + (l + 1 < DEPTH ? l + 1 : 0) * DM);
            const float* hin = (l == 0 && k == 6) ? P.x : P.out;
            const bool has_next = !(k == 13 && l + 1 == DEPTH), has_ff = (k == 13) && has_next;
            if (has_ff) load_wff((LAS float*)lds, P.w_in + (size_t)(l + 1 < DEPTH ? l + 1 : 0) * DM * DIN_SRC);
#pragma unroll 1
            for (int r = gw; r < M; r += NGW)
                row_pass(true, has_next, has_ff, lane, SRC + (size_t)r * DM, gpost, hin + (size_t)r * DM, P.out + (size_t)r * DM, gpre, HN + (size_t)r * DM, (const LAS float*)lds, FF + (size_t)r * 4);
        }
        if (ph + 1 < (fused_ok ? 14 * DEPTH - 1 : 14 * DEPTH)) GRID_SYNC();
    }
#ifdef DBG_OFF
    { const bf16_t* dbg = (const bf16_t*)(P.ws + DBG_OFF); const int t0 = bx * 512 + otid();
      for (size_t i = t0; i < (size_t)M * DM; i += (size_t)G * 512) P.out[i] = i < (size_t)(DBG_LEN) ? bf2f(dbg[i]) : 0.f; }
#endif
}

extern "C" void kernel_launch(void* const* d_in, const int* in_sizes, int n_in, void* d_out, int out_size, void* d_ws, size_t ws_size, hipStream_t stream) {
    static int grid_blocks = 0;
    if (grid_blocks == 0) {
        if (n_in != 22 || ws_size < WS_END) { fprintf(stderr, "kernel_launch: unexpected inputs (n_in %d, ws %zu, need %zu)\n", n_in, ws_size, (size_t)WS_END); grid_blocks = -1; return; }
        int dev = 0, cus = 0, per_cu = 0;
        (void)hipGetDevice(&dev); (void)hipDeviceGetAttribute(&cus, hipDeviceAttributeMultiprocessorCount, dev);
        (void)hipFuncSetAttribute((const void*)fwd_megakernel, hipFuncAttributeMaxDynamicSharedMemorySize, LDS_BYTES);
        (void)hipOccupancyMaxActiveBlocksPerMultiprocessor(&per_cu, (const void*)fwd_megakernel, 512, LDS_BYTES);
        if (per_cu < 1) fprintf(stderr, "kernel_launch: occupancy query says %d blocks per CU\n", per_cu);
        (void)hipGetLastError();
        grid_blocks = cus > 0 ? cus : 256;
    }
    if (grid_blocks < 0) return;
    Params p{};
    const float** pp = (const float**)&p;
    for (int i = 0; i < 22; ++i) pp[i] = (const float*)d_in[i];
    p.out = (float*)d_out; p.ws = (unsigned char*)d_ws;
    void* args[] = {&p};
    hipError_t e = hipLaunchCooperativeKernel((const void*)fwd_megakernel, dim3(grid_blocks), dim3(512), args, LDS_BYTES, stream);
    if (e != hipSuccess) fprintf(stderr, "cooperative launch failed: %s (grid %d)\n", hipGetErrorString(e), grid_blocks);
}
```

```cpp
#include <hip/hip_runtime.h>
#include <hip/hip_cooperative_groups.h>
#include <cstdio>
#include <cstdint>
namespace cg = cooperative_groups;

#define LAS __attribute__((address_space(3)))
typedef unsigned short bf16_t;
typedef short bf16x8 __attribute__((ext_vector_type(8)));
typedef short s16x4 __attribute__((ext_vector_type(4)));
typedef float f32x4 __attribute__((ext_vector_type(4)));
typedef float f32x16 __attribute__((ext_vector_type(16)));
typedef unsigned u32x4 __attribute__((ext_vector_type(4)));
typedef unsigned u32x2 __attribute__((ext_vector_type(2)));

constexpr int BATCH = 2, SEQ = 4096, DM = 2048, M = BATCH * SEQ, DEPTH = 2;
constexpr int DIN_SRC = 13828, NZ = 13824;
constexpr int Z_MQ = 0, Z_MK = 512, Z_MV = 1024, Z_FQ = 1536, Z_FK = 2048, Z_FV = 2560, Z_HQ = 3072, Z_HF = 3584, Z_HI = 4096, Z_HG = 4608, Z_PIN = 5120, Z_GL = 5632;
constexpr int FF_SRC_COL = 3072;
constexpr int NH = 4, HD = 128, BW = 512, HID = 8192, NMEM = 256;
constexpr float EPS = 1e-6f, MASKV = -1e30f, LOG2E = 1.4426950408889634f;

constexpr size_t MiB = 1u << 20;
constexpr size_t SZ_WIN = (size_t)NZ * DM * 2, SZ_WBR = (size_t)4 * DM * BW * 2, SZ_WOUT = (size_t)DM * DM * 2, SZ_WXQ = (size_t)BW * DM * 2, SZ_WXKV = (size_t)1024 * DM * 2,
                 SZ_WXO = (size_t)DM * BW * 2, SZ_WUP = (size_t)HID * DM * 2, SZ_WDN = (size_t)DM * HID * 2;
constexpr size_t SZ_WL = SZ_WIN + SZ_WBR + SZ_WOUT + SZ_WXQ + SZ_WXKV + SZ_WXO + SZ_WUP + SZ_WDN;
constexpr size_t OFF_W = 0;
constexpr size_t OFF_Z = ((OFF_W + 2 * SZ_WL + MiB - 1) / MiB) * MiB;
constexpr size_t OFF_HN = OFF_Z + (((size_t)M * NZ * 2 + MiB - 1) / MiB) * MiB;
constexpr size_t OFF_Y = OFF_HN + (size_t)M * DM * 2;
constexpr size_t OFF_MIX = OFF_Y + (size_t)4 * M * BW * 2;
constexpr size_t OFF_SRC = OFF_MIX + (size_t)M * DM * 2;
constexpr size_t OFF_XQ = OFF_SRC + (size_t)M * DM * 2;
constexpr size_t OFF_XO = OFF_XQ + (size_t)M * BW * 2;
constexpr size_t OFF_HS = OFF_XO + (size_t)M * BW * 2;
constexpr size_t OFF_HDEC = OFF_HS + (size_t)512 * 128 * 128 * 4;
constexpr size_t OFF_KBAR = OFF_HDEC + (size_t)512 * 128 * 4;
constexpr size_t OFF_CF = OFF_KBAR + (size_t)2 * 4 * 16 * 128 * 4;
constexpr size_t OFF_FF = OFF_CF + (size_t)8 * 4096 * 4;
constexpr size_t OFF_MEMN = OFF_FF + (size_t)M * 4 * 4;
constexpr size_t OFF_MEMKV = OFF_MEMN + (size_t)2 * 512 * DM * 2;
constexpr size_t OFF_LB = OFF_MEMKV + (size_t)2 * 512 * 1024 * 2;
constexpr size_t OFF_BAR = OFF_LB + 2 * 512 * 4;
constexpr size_t CTL_BYTES = 131072;
constexpr size_t OFF_XB = OFF_BAR + CTL_BYTES;
constexpr size_t WS_END = OFF_XB + 2 * (size_t)M * 8 * 4;

__device__ __forceinline__ int otid0() { int t = threadIdx.x; asm volatile("" : "+v"(t)); return t; }
namespace pg8 {
constexpr int BM = 256, BK = 64, HALF = 128, HTB = HALF * BK * 2, STAGE_BYTES = 8 * HTB, NXCD = 8, WGM = 4;
__host__ __device__ __forceinline__ int lds_byte(int r, int c) { const int st = (r >> 4) * 2 + (c >> 5), rr = r & 15, cc = c & 31, ob = rr * 64 + cc * 2; return st * 1024 + (ob ^ (((ob >> 9) & 1) << 5)); }
__host__ __device__ __forceinline__ void stage_rc(int b, int& R, int& C) { const int st = b / 1024, sb = b % 1024, swz = sb ^ (((sb >> 9) & 1) << 5); R = (st >> 1) * 16 + swz / 64; C = (st & 1) * 32 + (swz % 64) / 2; }
__host__ __device__ __forceinline__ int perm32(int rho) { const int n = rho >> 4, i = rho & 15; return 8 * (i >> 2) + 4 * n + (i & 3); }

struct Unit { int pm, pn, n; long aoff, boff, ooff; };
struct Gemm { const bf16_t* A; const bf16_t* Bt; int M, N, K, lda, ldb; };

struct StaticOrder {
    int nM, nN, nwg, G, c, nsub, c0, ksp; long astr, bstr, ostr;
    __device__ void init(int M_, int N_, int G_, int c_, int nsub_ = 1, long astr_ = 0, long bstr_ = 0, int c0_ = 0, int ksp_ = 1, long ostr_ = 0) { nM = M_ / BM; nN = N_ / BM; nwg = nM * nN; G = G_; c = c_; nsub = nsub_; astr = astr_; bstr = bstr_; c0 = c0_; ksp = ksp_; ostr = ostr_; }
    __device__ bool next(int i, Unit& u) const {
        if (c < c0) return false;
        const int ti = i / nsub; u.n = i - ti * nsub;
        const long L = (long)ti * G + (c - c0); if (L >= (long)nwg * ksp) return false;
        const int split = (int)(L / nwg);
        int wgid = (int)(L - (long)split * nwg); { const int q = nwg / NXCD, r = nwg % NXCD, xcd = wgid % NXCD, off = wgid / NXCD; wgid = (xcd < r ? xcd * (q + 1) : r * (q + 1) + (xcd - r) * q) + off; }
        const int nig = WGM * nN, gid = wgid / nig, fm = gid * WGM, gsz = (nM - fm) < WGM ? (nM - fm) : WGM;
        u.pm = fm + ((wgid % nig) % gsz); u.pn = (wgid % nig) / gsz; u.aoff = (u.n + split) * astr; u.boff = (u.n + split) * bstr; u.ooff = split * ostr; return true;
    }
};

typedef float f32x2_t __attribute__((ext_vector_type(2))); typedef __bf16 bf16x2_t __attribute__((ext_vector_type(2)));
__device__ __forceinline__ unsigned cvt_pk_bf16(float lo, float hi) { f32x2_t v = {lo, hi}; bf16x2_t b = __builtin_convertvector(v, bf16x2_t); return __builtin_bit_cast(unsigned, b); }
__device__ __forceinline__ float bf_lo(unsigned w) { return __uint_as_float(w << 16); }
__device__ __forceinline__ float bf_hi(unsigned w) { return __uint_as_float(w & 0xffff0000u); }
__device__ __forceinline__ float sigmoidf_(float x) { return __builtin_amdgcn_rcpf(1.0f + __builtin_amdgcn_exp2f(-x * LOG2E)); }

#define RLX_AGENT __ATOMIC_RELAXED, __HIP_MEMORY_SCOPE_AGENT
struct Epi {
    static constexpr bool PERM = true;
    bf16_t* O; int ldc; const bf16_t* G; int ldg; int MODE;
    const float* hold; float* hout; bf16_t* hn; const float* gpost; const float* gpre; float* xb1; float* xb2; unsigned* cnt1; unsigned* cnt2; int has_next;
    const bf16_t* holdb; bf16_t* houtb;
    __device__ __forceinline__ void operator()(f32x4 (&acc)[2][2][4][2], const Unit& u, int wr, int wc, int fr, int fq) const {
        const int row0 = u.pm * BM + wr * 64 + fr, col0 = u.pn * BM + wc * 32 + 8 * fq;
        if (MODE == 2) {
            const bool lastb = (u.n == 3);
#pragma unroll
            for (int ai = 0; ai < 2; ++ai)
#pragma unroll
                for (int m = 0; m < 4; ++m) { const size_t row = (size_t)(row0 + ai * HALF + m * 16); const unsigned char* gp = (const unsigned char*)(G + row * ldg) + (size_t)u.n * DM + col0;
#pragma unroll
                    for (int bj = 0; bj < 2; ++bj) { const u32x2 ga = *(const u32x2*)(gp + bj * HALF); u32x2 gb = (u32x2){0x01010101u, 0x01010101u}; if (!lastb) gb = *(const u32x2*)(gp + DM + bj * HALF);
                        float f[8];
#pragma unroll
                        for (int e = 0; e < 4; ++e) { const float a0 = (float)((ga.x >> (8 * e)) & 0xffu), a1 = (float)((ga.y >> (8 * e)) & 0xffu), b0 = (float)((gb.x >> (8 * e)) & 0xffu), b1 = (float)((gb.y >> (8 * e)) & 0xffu);
                            f[e] = lastb ? a0 * (1.0f / 255.0f) : a0 * __builtin_amdgcn_rcpf(b0); f[4 + e] = lastb ? a1 * (1.0f / 255.0f) : a1 * __builtin_amdgcn_rcpf(b1); }
                        f32x4 v0 = acc[ai][bj][m][0], v1 = acc[ai][bj][m][1];
                        v0[0] *= f[0]; v0[1] *= f[1]; v0[2] *= f[2]; v0[3] *= f[3]; v1[0] *= f[4]; v1[1] *= f[5]; v1[2] *= f[6]; v1[3] *= f[7];
                        acc[ai][bj][m][0] = v0; acc[ai][bj][m][1] = v1;
                        if (lastb) { u32x4 w; w.x = cvt_pk_bf16(v0[0], v0[1]); w.y = cvt_pk_bf16(v0[2], v0[3]); w.z = cvt_pk_bf16(v1[0], v1[1]); w.w = cvt_pk_bf16(v1[2], v1[3]);
                            *(u32x4*)(O + row * ldc + col0 + bj * HALF) = w; } } }
            return;
        }
        if (MODE == 4 && u.pn * BM >= Z_GL) {
#pragma unroll
            for (int ai = 0; ai < 2; ++ai)
#pragma unroll
                for (int m = 0; m < 4; ++m) { unsigned char* gp = (unsigned char*)(O + (size_t)(row0 + ai * HALF + m * 16) * ldc + Z_GL) + (col0 - Z_GL);
#pragma unroll
                    for (int bj = 0; bj < 2; ++bj) { const f32x4 v0 = acc[ai][bj][m][0], v1 = acc[ai][bj][m][1]; unsigned q[8];
#pragma unroll
                        for (int e = 0; e < 4; ++e) { q[e] = (unsigned)fmaxf(sigmoidf_(v0[e]) * 255.0f + 0.5f, 1.0f); q[4 + e] = (unsigned)fmaxf(sigmoidf_(v1[e]) * 255.0f + 0.5f, 1.0f); }
                        u32x2 w; w.x = q[0] | (q[1] << 8) | (q[2] << 16) | (q[3] << 24); w.y = q[4] | (q[5] << 8) | (q[6] << 16) | (q[7] << 24);
                        *(u32x2*)(gp + bj * HALF) = w; } }
            return;
        }
#pragma unroll
        for (int ai = 0; ai < 2; ++ai)
#pragma unroll
            for (int m = 0; m < 4; ++m) { const size_t row = (size_t)(row0 + ai * HALF + m * 16); bf16_t* rowp = O + u.ooff + row * ldc + col0;
#pragma unroll
                for (int bj = 0; bj < 2; ++bj) { f32x4 v0 = acc[ai][bj][m][0], v1 = acc[ai][bj][m][1];
                    if (MODE == 1) {
#pragma unroll
                        for (int e = 0; e < 4; ++e) { const float a = fmaxf(v0[e], 0.f), b = fmaxf(v1[e], 0.f); v0[e] = a * a; v1[e] = b * b; } }
                    if (MODE == 2) {
                        const u32x2 g = *(const u32x2*)((const unsigned char*)(G + row * ldg) + (size_t)u.n * DM + col0 + bj * HALF);
                        const float k255 = 1.0f / 255.0f;
                        v0[0] *= (float)(g.x & 0xffu) * k255; v0[1] *= (float)((g.x >> 8) & 0xffu) * k255; v0[2] *= (float)((g.x >> 16) & 0xffu) * k255; v0[3] *= (float)(g.x >> 24) * k255;
                        v1[0] *= (float)(g.y & 0xffu) * k255; v1[1] *= (float)((g.y >> 8) & 0xffu) * k255; v1[2] *= (float)((g.y >> 16) & 0xffu) * k255; v1[3] *= (float)(g.y >> 24) * k255;
                        if (u.n > 0) { const u32x4 o = *(const u32x4*)(rowp + bj * HALF);
                            v0[0] += bf_lo(o.x); v0[1] += bf_hi(o.x); v0[2] += bf_lo(o.y); v0[3] += bf_hi(o.y); v1[0] += bf_lo(o.z); v1[1] += bf_hi(o.z); v1[2] += bf_lo(o.w); v1[3] += bf_hi(o.w); } }
                    u32x4 w; w.x = cvt_pk_bf16(v0[0], v0[1]); w.y = cvt_pk_bf16(v0[2], v0[3]); w.z = cvt_pk_bf16(v1[0], v1[1]); w.w = cvt_pk_bf16(v1[2], v1[3]);
                    *(u32x4*)(rowp + bj * HALF) = w; } }
    }
    __device__ __forceinline__ void panel_rstd(const f32x4 (&v)[2][2][4][2], const Unit& u, int wr, int wc, int fr, int fq, LAS unsigned char* lds, int tid, float* xb, unsigned* cnt) const {
        LAS float* Pt = (LAS float*)lds; LAS float* St = (LAS float*)(lds + 4096);
        const int wid = __builtin_amdgcn_readfirstlane(tid >> 6), lane = tid & 63;
#pragma unroll
        for (int ai = 0; ai < 2; ++ai)
#pragma unroll
            for (int m = 0; m < 4; ++m) { float s = 0.f;
#pragma unroll
                for (int bj = 0; bj < 2; ++bj)
#pragma unroll
                    for (int n = 0; n < 2; ++n) { const f32x4 x = v[ai][bj][m][n]; s += (x[0] * x[0] + x[1] * x[1]) + (x[2] * x[2] + x[3] * x[3]); }
                s += __shfl_xor(s, 16); s += __shfl_xor(s, 32);
                if (fq == 0) Pt[(ai * HALF + wr * 64 + m * 16 + fr) * 4 + wc] = s; }
        asm volatile("s_waitcnt lgkmcnt(0)" ::: "memory"); __builtin_amdgcn_s_barrier(); asm volatile("" ::: "memory");
        if (tid < 256) { const float tot = (Pt[tid * 4 + 0] + Pt[tid * 4 + 1]) + (Pt[tid * 4 + 2] + Pt[tid * 4 + 3]);
            __hip_atomic_store(xb + (size_t)(u.pm * BM + tid) * 8 + u.pn, tot, RLX_AGENT); }
        asm volatile("s_waitcnt vmcnt(0)" ::: "memory");
        if (tid < 256 && lane == 0) __hip_atomic_fetch_add(cnt + 64 * u.pm, 1u, RLX_AGENT);
        if (wid == 0) { unsigned sp = 0;
            while ((unsigned)__builtin_amdgcn_readfirstlane(__hip_atomic_load(cnt + 64 * u.pm, RLX_AGENT)) < 32u) { __builtin_amdgcn_s_sleep(1); if (++sp > (1u << 22)) break; }
            __builtin_amdgcn_fence(__ATOMIC_ACQUIRE, "agent"); }
        asm volatile("s_waitcnt vmcnt(0) lgkmcnt(0)" ::: "memory"); __builtin_amdgcn_s_barrier(); asm volatile("" ::: "memory");
        if (tid < 256) { const float* sl = xb + (size_t)(u.pm * BM + tid) * 8; float q = 0.f;
#pragma unroll
            for (int t = 0; t < 8; ++t) q += __hip_atomic_load(sl + t, RLX_AGENT);
            St[tid] = 1.0f / sqrtf(q * (1.0f / DM) + EPS); }
        asm volatile("s_waitcnt lgkmcnt(0)" ::: "memory"); __builtin_amdgcn_s_barrier(); asm volatile("" ::: "memory");
    }
    __device__ __forceinline__ void fused(f32x4 (&acc)[2][2][4][2], const Unit& u, int wr, int wc, int fr, int fq, LAS unsigned char* lds, int tid) const {
        const LAS float* St = (const LAS float*)(lds + 4096);
        const int col0 = u.pn * BM + wc * 32 + 8 * fq;
        panel_rstd(acc, u, wr, wc, fr, fq, lds, tid, xb1, cnt1);
        {   f32x4 gp[2][2];
#pragma unroll
            for (int bj = 0; bj < 2; ++bj)
#pragma unroll
                for (int n = 0; n < 2; ++n) gp[bj][n] = *(const f32x4*)(gpost + col0 + bj * HALF + 4 * n);
#pragma unroll
            for (int ai = 0; ai < 2; ++ai)
#pragma unroll
                for (int m = 0; m < 4; ++m) { const int r = ai * HALF + wr * 64 + m * 16 + fr; const float rs = St[r]; const size_t off = (size_t)(u.pm * BM + r) * DM + col0;
#pragma unroll
                    for (int bj = 0; bj < 2; ++bj) { f32x4 h0, h1;
                        if (holdb) { const u32x4 w = *(const u32x4*)(holdb + off + bj * HALF); h0 = (f32x4){bf_lo(w.x), bf_hi(w.x), bf_lo(w.y), bf_hi(w.y)}; h1 = (f32x4){bf_lo(w.z), bf_hi(w.z), bf_lo(w.w), bf_hi(w.w)}; }
                        else { h0 = *(const f32x4*)(hold + off + bj * HALF); h1 = *(const f32x4*)(hold + off + bj * HALF + 4); }
                        acc[ai][bj][m][0] = h0 + acc[ai][bj][m][0] * rs * gp[bj][0]; acc[ai][bj][m][1] = h1 + acc[ai][bj][m][1] * rs * gp[bj][1]; }
                    if (!has_next) {
#pragma unroll
                        for (int bj = 0; bj < 2; ++bj)
#pragma unroll
                            for (int n = 0; n < 2; ++n) *(f32x4*)(hout + off + bj * HALF + 4 * n) = acc[ai][bj][m][n]; }
                    if (m & 1) asm volatile("" ::: "memory"); } }
        if (!has_next) return;
        panel_rstd(acc, u, wr, wc, fr, fq, lds, tid, xb2, cnt2);
        {   f32x4 gp[2][2];
#pragma unroll
            for (int bj = 0; bj < 2; ++bj)
#pragma unroll
                for (int n = 0; n < 2; ++n) gp[bj][n] = *(const f32x4*)(gpre + col0 + bj * HALF + 4 * n);
#pragma unroll
            for (int ai = 0; ai < 2; ++ai)
#pragma unroll
                for (int m = 0; m < 4; ++m) { const int r = ai * HALF + wr * 64 + m * 16 + fr; const float rs = St[r]; const size_t off = (size_t)(u.pm * BM + r) * DM + col0;
#pragma unroll
                    for (int bj = 0; bj < 2; ++bj) { const f32x4 x0 = acc[ai][bj][m][0], x1 = acc[ai][bj][m][1];
                        { u32x4 hw; hw.x = cvt_pk_bf16(x0[0], x0[1]); hw.y = cvt_pk_bf16(x0[2], x0[3]); hw.z = cvt_pk_bf16(x1[0], x1[1]); hw.w = cvt_pk_bf16(x1[2], x1[3]); *(u32x4*)(houtb + off + bj * HALF) = hw; }
                        const f32x4 y0 = x0 * rs * gp[bj][0], y1 = x1 * rs * gp[bj][1];
                        u32x4 w; w.x = cvt_pk_bf16(y0[0], y0[1]); w.y = cvt_pk_bf16(y0[2], y0[3]); w.z = cvt_pk_bf16(y1[0], y1[1]); w.w = cvt_pk_bf16(y1[2], y1[3]);
                        *(u32x4*)(hn + off + bj * HALF) = w; }
                    if (m & 1) asm volatile("" ::: "memory"); } }
    }
};

template <class EpiT, class Sched>
__device__ __forceinline__ void gemm_phase(LAS unsigned char* lds, const Gemm g, const Sched& S, const EpiT& E) {
    const int tid = otid0(), wid = __builtin_amdgcn_readfirstlane(tid >> 6), lane = tid & 63, wr = wid >> 2, wc = wid & 3, fr = lane & 15, fq = lane >> 4;
    const int K = g.K, nt = K / BK;
    unsigned voffA[2], voffB[2];
#pragma unroll
    for (int i = 0; i < 2; ++i) { int R, C; stage_rc(tid * 16 + i * 8192, R, C); const int Rb = EpiT::PERM ? ((R & ~31) + perm32(R & 31)) : R;
        voffA[i] = (unsigned)(R * g.lda + C) * 2u; voffB[i] = (unsigned)(Rb * g.ldb + C) * 2u; }
    const size_t kstep = (size_t)(BK * 2);
    const size_t hstepA = (size_t)HALF * g.lda * 2, hstepB = (size_t)HALF * g.ldb * 2;
    const size_t tstepA = 2 * hstepA, tstepB = 2 * hstepB;
    const unsigned ldsw = (unsigned)wid * 1024u;
    const int aoff = lds_byte(wr * 64 + fr, fq * 8), boff = lds_byte(wc * 32 + fr, fq * 8);
#define PG8_SA(b, h) (((b) * 2 + (h)) * HTB)
#define PG8_SB(b, h) ((4 + (b) * 2 + (h)) * HTB)
#define PG8_STAGE(bufoff, gbase, voff) do { _Pragma("unroll") for (int _i = 0; _i < 2; ++_i) \
        __builtin_amdgcn_global_load_lds((const unsigned*)((const char*)(gbase) + (voff)[_i]), (LAS unsigned*)(lds + (bufoff) + ldsw + _i * 8192), 16, 0, 0); } while (0)
#define PG8_LDA(dst, b, h) do { _Pragma("unroll") for (int m = 0; m < 4; ++m) _Pragma("unroll") for (int k = 0; k < 2; ++k) dst[m][k] = *(const LAS bf16x8*)(lds + PG8_SA(b, h) + aoff + m * 2048 + k * 1024); } while (0)
#define PG8_LDB(dst, b, h) do { _Pragma("unroll") for (int n = 0; n < 2; ++n) _Pragma("unroll") for (int k = 0; k < 2; ++k) dst[n][k] = *(const LAS bf16x8*)(lds + PG8_SB(b, h) + boff + n * 2048 + k * 1024); } while (0)
#define PG8_MMA(ai, bj, At, Bt) do { __builtin_amdgcn_s_setprio(1); _Pragma("unroll") for (int m = 0; m < 4; ++m) _Pragma("unroll") for (int n = 0; n < 2; ++n) _Pragma("unroll") for (int k = 0; k < 2; ++k) \
        acc[ai][bj][m][n] = __builtin_amdgcn_mfma_f32_16x16x32_bf16(Bt[n][k], At[m][k], acc[ai][bj][m][n], 0, 0, 0); __builtin_amdgcn_s_setprio(0); } while (0)
#define PG8_WAIT_V(n) asm volatile("s_waitcnt vmcnt(" #n ")" ::: "memory")
#define PG8_WAIT_L(n) asm volatile("s_waitcnt lgkmcnt(" #n ")" ::: "memory")
#define PG8_BAR __builtin_amdgcn_s_barrier()
#define PG8_SCHED __builtin_amdgcn_sched_barrier(0)
    Unit cur, nxt; int ui = 0;
    if (!S.next(0, cur)) return;
    f32x4 acc[2][2][4][2];
#pragma unroll
    for (int a = 0; a < 2; ++a)
#pragma unroll
        for (int b = 0; b < 2; ++b)
#pragma unroll
            for (int m = 0; m < 4; ++m)
#pragma unroll
                for (int n = 0; n < 2; ++n) acc[a][b][m][n] = (f32x4){0.f, 0.f, 0.f, 0.f};
    bf16x8 At[4][2], B0[2][2], B1[2][2];
    const char* cA = (const char*)g.A + (size_t)cur.pm * tstepA + cur.aoff; const char* cB = (const char*)g.Bt + (size_t)cur.pn * tstepB + cur.boff;
    PG8_STAGE(PG8_SB(0, 0), cB, voffB); PG8_STAGE(PG8_SB(0, 1), cB + hstepB, voffB); PG8_STAGE(PG8_SA(0, 0), cA, voffA); PG8_STAGE(PG8_SA(0, 1), cA + hstepA, voffA);
    if (wr == 1) PG8_BAR;
    PG8_WAIT_V(2); PG8_BAR;
    PG8_STAGE(PG8_SB(1, 0), cB + kstep, voffB); PG8_STAGE(PG8_SA(1, 0), cA + kstep, voffA); PG8_STAGE(PG8_SB(1, 1), cB + hstepB + kstep, voffB);
    PG8_WAIT_V(6); PG8_BAR;
    for (;;) {
        const bool has_next = S.next(ui + 1, nxt);
        const char* nA = has_next ? (const char*)g.A + (size_t)nxt.pm * tstepA + nxt.aoff : cA; const char* nB = has_next ? (const char*)g.Bt + (size_t)nxt.pn * tstepB + nxt.boff : cB;
        for (int t = 0; t < nt; t += 2) {
            const bool last = (t == nt - 2);
            const char* a1 = cA + (size_t)(t + 1) * kstep;
            const char* a2 = last ? nA : cA + (size_t)(t + 2) * kstep; const char* b2 = last ? nB : cB + (size_t)(t + 2) * kstep;
            const char* a3 = a2 + kstep; const char* b3 = b2 + kstep;
            PG8_LDB(B0, 0, 0); PG8_LDB(B1, 0, 1); PG8_SCHED; PG8_LDA(At, 0, 0); PG8_STAGE(PG8_SA(1, 1), a1 + hstepA, voffA);
            PG8_WAIT_V(8); PG8_WAIT_L(0); PG8_BAR; PG8_MMA(0, 0, At, B0); PG8_MMA(0, 1, At, B1); PG8_BAR; PG8_SCHED;
            PG8_LDA(At, 0, 1); PG8_STAGE(PG8_SB(0, 0), b2, voffB); PG8_STAGE(PG8_SB(0, 1), b2 + hstepB, voffB); PG8_STAGE(PG8_SA(0, 0), a2, voffA);
            PG8_WAIT_V(8); PG8_WAIT_L(0); PG8_BAR; PG8_MMA(1, 0, At, B0); PG8_MMA(1, 1, At, B1); PG8_BAR; PG8_SCHED;
            PG8_LDB(B0, 1, 0); PG8_LDB(B1, 1, 1); PG8_SCHED; PG8_LDA(At, 1, 0); PG8_STAGE(PG8_SA(0, 1), a2 + hstepA, voffA);
            PG8_WAIT_V(8); PG8_WAIT_L(0); PG8_BAR; PG8_MMA(0, 0, At, B0); PG8_MMA(0, 1, At, B1); PG8_BAR; PG8_SCHED;
            PG8_LDA(At, 1, 1); PG8_STAGE(PG8_SB(1, 0), b3, voffB); PG8_STAGE(PG8_SB(1, 1), b3 + hstepB, voffB); PG8_STAGE(PG8_SA(1, 0), a3, voffA);
            PG8_WAIT_V(8); PG8_WAIT_L(0); PG8_BAR; PG8_MMA(1, 0, At, B0); PG8_MMA(1, 1, At, B1); PG8_BAR; PG8_SCHED;
        }
        if (wr == 0) PG8_BAR;
        if (E.MODE != 3) E(acc, cur, wr, wc, fr, fq);
        if (!has_next) break;
        if (!(E.MODE == 2 && nxt.n != 0))
#pragma unroll
        for (int a = 0; a < 2; ++a)
#pragma unroll
            for (int b = 0; b < 2; ++b)
#pragma unroll
                for (int m = 0; m < 4; ++m)
#pragma unroll
                    for (int n = 0; n < 2; ++n) acc[a][b][m][n] = (f32x4){0.f, 0.f, 0.f, 0.f};
        cur = nxt; cA = nA; cB = nB; ++ui;
        if (wr == 1) PG8_BAR;
    }
    PG8_WAIT_V(0);
    PG8_BAR;
    if (E.MODE == 3) E.fused(acc, cur, wr, wc, fr, fq, lds, tid);
#undef PG8_SA
#undef PG8_SB
#undef PG8_STAGE
#undef PG8_LDA
#undef PG8_LDB
#undef PG8_MMA
#undef PG8_WAIT_V
#undef PG8_WAIT_L
#undef PG8_BAR
#undef PG8_SCHED
}
}
using pg8::cvt_pk_bf16; using pg8::bf_lo; using pg8::bf_hi; using pg8::sigmoidf_;

struct Params {
    const float *x, *mem, *lb_logits, *mix_norm_pre, *mix_norm_post, *w_in, *fox_f_bias, *hgrn_out_norm, *pool_w, *pool_scale, *w_branch, *w_mix_out,
                *xa_norm_pre, *xa_norm_mem, *xa_norm_post, *xa_wq, *xa_wkv, *xa_wo, *mlp_norm_pre, *mlp_norm_post, *mlp_w_up, *mlp_w_down;
    float* out; unsigned char* ws;
};
__device__ __forceinline__ float wave_sum(float v) {
#pragma unroll
    for (int o = 1; o < 64; o <<= 1) v += __shfl_xor(v, o);
    return v;
}
__device__ __forceinline__ unsigned f2bf(float f) { unsigned u = __builtin_bit_cast(unsigned, f); return (u + 0x7fffu + ((u >> 16) & 1u)) >> 16; }
__device__ __forceinline__ unsigned pk2(float lo, float hi) { return f2bf(lo) | (f2bf(hi) << 16); }
__device__ __forceinline__ float bf2f(bf16_t v) { return __uint_as_float((unsigned)v << 16); }
#define LDS_WAIT() asm volatile("s_waitcnt lgkmcnt(0)" ::: "memory")
__device__ __forceinline__ int otid() { int t = threadIdx.x; asm volatile("" : "+v"(t)); return t; }

struct TrItem { const float* src; bf16_t* dst; int K; };
__device__ __forceinline__ TrItem tr_decode(const float* W, int ldw, int K, int ncols, bf16_t* WT, int item) {
    const int nblk = ncols / 32, kb = item / nblk, nb = item - kb * nblk; TrItem t; t.src = W + (size_t)(64 * kb) * ldw + 32 * nb; t.dst = WT + (size_t)(32 * nb) * K + 64 * kb; t.K = K; return t;
}
__device__ __forceinline__ void tr_load(const TrItem& t, int ldw, int lane, f32x4 (&v)[8]) {
#pragma unroll
    for (int i = 0; i < 8; ++i) v[i] = *(const f32x4*)(t.src + (size_t)(8 * i + (lane >> 3)) * ldw + 4 * (lane & 7));
}
__device__ __forceinline__ void tr_process(const TrItem& t, LAS float* scr, int lane, const f32x4 (&v)[8]) {
#pragma unroll
    for (int i = 0; i < 8; ++i) { LAS float* d = scr + (8 * i + (lane >> 3)) * 33 + 4 * (lane & 7); d[0] = v[i][0]; d[1] = v[i][1]; d[2] = v[i][2]; d[3] = v[i][3]; }
    LDS_WAIT(); asm volatile("" ::: "memory");
    const int c = lane & 7;
#pragma unroll
    for (int j = 0; j < 4; ++j) { const int n = (lane >> 3) + 8 * j; const LAS float* s = scr + (8 * c) * 33 + n;
        u32x4 o; o.x = pk2(s[0 * 33], s[1 * 33]); o.y = pk2(s[2 * 33], s[3 * 33]); o.z = pk2(s[4 * 33], s[5 * 33]); o.w = pk2(s[6 * 33], s[7 * 33]);
        *(u32x4*)(t.dst + (size_t)n * t.K + 8 * c) = o; }
    LDS_WAIT(); asm volatile("" ::: "memory");
}

__device__ __forceinline__ void row_pass(const bool HAS_SRC, const bool HAS_NEXT, const bool HAS_FF, int lane, const bf16_t* src, const float* gpost, const float* hin, float* hout, const float* gpre, bf16_t* hn, const LAS float* wff, float* ff) {
    asm volatile("" : "+v"(lane));
    f32x4 h[8];
#pragma unroll
    for (int j = 0; j < 8; ++j) h[j] = *(const f32x4*)(hin + 4 * lane + 256 * j);
    if (HAS_SRC) {
        f32x4 s[8]; float ss = 0.f;
#pragma unroll
        for (int j = 0; j < 8; ++j) { const u32x2 w = *(const u32x2*)(src + 4 * lane + 256 * j); s[j] = (f32x4){bf_lo(w.x), bf_hi(w.x), bf_lo(w.y), bf_hi(w.y)};
            ss += (s[j][0] * s[j][0] + s[j][1] * s[j][1]) + (s[j][2] * s[j][2] + s[j][3] * s[j][3]); }
        const float r1 = 1.0f / sqrtf(wave_sum(ss) * (1.0f / DM) + EPS);
#pragma unroll
        for (int j = 0; j < 8; ++j) { const f32x4 g = *(const f32x4*)(gpost + 4 * lane + 256 * j); h[j] = h[j] + s[j] * r1 * g; *(f32x4*)(hout + 4 * lane + 256 * j) = h[j]; }
    }
    if (HAS_NEXT) {
        float ss = 0.f;
#pragma unroll
        for (int j = 0; j < 8; ++j) ss += (h[j][0] * h[j][0] + h[j][1] * h[j][1]) + (h[j][2] * h[j][2] + h[j][3] * h[j][3]);
        const float r2 = 1.0f / sqrtf(wave_sum(ss) * (1.0f / DM) + EPS);
        f32x4 fa = (f32x4){0.f, 0.f, 0.f, 0.f};
#pragma unroll
        for (int j = 0; j < 8; ++j) { const f32x4 g = *(const f32x4*)(gpre + 4 * lane + 256 * j); const f32x4 y = h[j] * r2 * g;
            u32x2 w; w.x = pk2(y[0], y[1]); w.y = pk2(y[2], y[3]); *(u32x2*)(hn + 4 * lane + 256 * j) = w;
            if (HAS_FF) {
#pragma unroll
                for (int e = 0; e < 4; ++e) { const f32x4 wv = *(const LAS f32x4*)(wff + (4 * lane + 256 * j + e) * 4); fa = fa + wv * y[e]; } } }
        if (HAS_FF) { fa[0] = wave_sum(fa[0]); fa[1] = wave_sum(fa[1]); fa[2] = wave_sum(fa[2]); fa[3] = wave_sum(fa[3]); if (lane == 0) *(f32x4*)ff = fa; }
    }
}

constexpr int AT_KSTR = 272, AT_VSTR = 320, AT_KBUF = 64 * AT_KSTR, AT_VBUF = 64 * AT_VSTR;
constexpr int AT_K0 = 0, AT_V0 = 2 * AT_KBUF, AT_CK = AT_V0 + 2 * AT_VBUF, AT_KBAR = AT_CK + 512, AT_VOTE = AT_KBAR + 8192, AT_END = AT_VOTE + 64;
typedef short v4i16_t __attribute__((ext_vector_type(4)));
__device__ __forceinline__ s16x4 vtr(LAS const unsigned char* p) { return __builtin_bit_cast(s16x4, __builtin_amdgcn_ds_read_tr16_b64_v4i16((LAS v4i16_t*)p)); }

template <int MODE>
__device__ __forceinline__ void attn_unit(LAS unsigned char* lds, const bf16_t* Qb, int ldq, const bf16_t* Kb, const bf16_t* Vb, int ldkv, bf16_t* Ob, int ldo, int q0, int ntiles, const float* cf, const float* kbar, size_t qsplit = 0, const unsigned* kmaxp = nullptr) {
    const int tid = otid(), lane = tid & 63, wid = __builtin_amdgcn_readfirstlane(tid >> 6), qg = wid & 3, kh = wid >> 2, r32 = lane & 31, h = lane >> 5;
    const int qrow = q0 + 32 * qg + r32;
    const float C2 = 0.08838834764831845f * LOG2E;
    bf16x8 qf[8];
    { const bf16_t* qp = Qb + (size_t)qrow * ldq + 8 * h;
      if (MODE == 2 && qsplit) {
#pragma unroll
          for (int s = 0; s < 8; ++s) { float a[8];
#pragma unroll
              for (int e = 0; e < 8; ++e) a[e] = 0.f;
#pragma unroll
              for (int ks = 0; ks < 4; ++ks) { const u32x4 w = *(const u32x4*)(qp + ks * qsplit + 16 * s);
                  a[0] += bf_lo(w.x); a[1] += bf_hi(w.x); a[2] += bf_lo(w.y); a[3] += bf_hi(w.y); a[4] += bf_lo(w.z); a[5] += bf_hi(w.z); a[6] += bf_lo(w.w); a[7] += bf_hi(w.w); }
              u32x4 o; o.x = cvt_pk_bf16(a[0], a[1]); o.y = cvt_pk_bf16(a[2], a[3]); o.z = cvt_pk_bf16(a[4], a[5]); o.w = cvt_pk_bf16(a[6], a[7]); qf[s] = __builtin_bit_cast(bf16x8, o); }
      } else {
#pragma unroll
          for (int s = 0; s < 8; ++s) qf[s] = *(const bf16x8*)(qp + 16 * s); } }
    unsigned sel = 0; const int blk = q0 >> 8;
    if (MODE == 0) {
        LAS float* kbl = (LAS float*)(lds + AT_KBAR);
        *(LAS f32x4*)(kbl + 4 * tid) = *(const f32x4*)(kbar + 4 * tid);
        __syncthreads();
        if (blk <= 3) sel = (1u << blk) - 1u;
        else {
            unsigned qw[32];
            { const bf16_t* qp = Qb + (size_t)qrow * ldq + 64 * h;
#pragma unroll
              for (int c8 = 0; c8 < 8; ++c8) { const u32x4 w = *(const u32x4*)(qp + 8 * c8); qw[4 * c8] = w.x; qw[4 * c8 + 1] = w.y; qw[4 * c8 + 2] = w.z; qw[4 * c8 + 3] = w.w; } }
            float v1 = -3.0e38f, v2 = -3.0e38f, v3 = -3.0e38f; int i1 = 0, i2 = 0, i3 = 0;
#pragma unroll 1
            for (int j = 0; j < blk; ++j) { float g = 0.f; const LAS float* kb = kbl + j * 128 + 64 * h;
#pragma unroll
                for (int c4 = 0; c4 < 16; ++c4) { const f32x4 a = *(const LAS f32x4*)(kb + 4 * c4);
                    g += (bf_lo(qw[2 * c4]) * a[0] + bf_hi(qw[2 * c4]) * a[1]) + (bf_lo(qw[2 * c4 + 1]) * a[2] + bf_hi(qw[2 * c4 + 1]) * a[3]); }
                g += __shfl_xor(g, 32);
                if (g > v1) { v3 = v2; i3 = i2; v2 = v1; i2 = i1; v1 = g; i1 = j; }
                else if (g > v2) { v3 = v2; i3 = i2; v2 = g; i2 = j; }
                else if (g > v3) { v3 = g; i3 = j; } }
            sel = (1u << i1) | (1u << i2) | (1u << i3);
        }
    }
    float cq2 = 0.f, qkb = 0.f;
    if (MODE == 1) { cq2 = cf[qrow] * LOG2E;
        float qs = 0.f;
#pragma unroll
        for (int s8 = 0; s8 < 8; ++s8) { const u32x4 w = __builtin_bit_cast(u32x4, qf[s8]);
            const float a0 = bf_lo(w.x), a1 = bf_hi(w.x), a2 = bf_lo(w.y), a3 = bf_hi(w.y), a4 = bf_lo(w.z), a5 = bf_hi(w.z), a6 = bf_lo(w.w), a7 = bf_hi(w.w);
            qs += (a0 * a0 + a1 * a1) + (a2 * a2 + a3 * a3) + (a4 * a4 + a5 * a5) + (a6 * a6 + a7 * a7); }
        qs += __shfl_xor(qs, 32);
        qkb = C2 * sqrtf(qs) * sqrtf(__uint_as_float(*kmaxp)) * 1.01f + 1.0f; }
    LAS unsigned* vote = (LAS unsigned*)(lds + AT_VOTE);
    float m_run = MASKV, l_run = 0.f;
    f32x16 o[4];
#pragma unroll
    for (int d = 0; d < 4; ++d)
#pragma unroll
        for (int r = 0; r < 16; ++r) o[d][r] = 0.f;
    u32x4 kreg[2][2], vreg[2][2]; float ckreg[2] = {0.f, 0.f};
    const int srow = tid >> 4, sch = tid & 15;
#define AT_LOAD(j, S_) do { _Pragma("unroll") for (int i_ = 0; i_ < 2; ++i_) { const size_t go = (size_t)(64 * (j) + srow + 32 * i_) * ldkv + sch * 8; kreg[S_][i_] = *(const u32x4*)(Kb + go); vreg[S_][i_] = *(const u32x4*)(Vb + go); } \
        if (MODE == 1 && tid < 64) ckreg[S_] = cf[64 * (j) + tid] * LOG2E; } while (0)
#define AT_STORE(b, S_) do { _Pragma("unroll") for (int i_ = 0; i_ < 2; ++i_) { *(LAS u32x4*)(lds + AT_K0 + (b) * AT_KBUF + (srow + 32 * i_) * AT_KSTR + sch * 16) = kreg[S_][i_]; \
        *(LAS u32x4*)(lds + AT_V0 + (b) * AT_VBUF + (srow + 32 * i_) * AT_VSTR + sch * 16) = vreg[S_][i_]; } if (MODE == 1 && tid < 64) *(LAS float*)(lds + AT_CK + (b) * 256 + tid * 4) = ckreg[S_]; } while (0)
    AT_LOAD(ntiles - 1, 0); AT_LOAD(ntiles - 2, 1); AT_STORE(0, 0);
    __syncthreads();
    bool done = false;
#pragma unroll 1
    for (int it0 = 0; it0 < ntiles; it0 += 2) {
#pragma unroll
      for (int half = 0; half < 2; ++half) {
        const int it = it0 + half, j = ntiles - 1 - it, cur = half;
        if (it + 2 < ntiles) AT_LOAD(j - 2, half);
        const int kv0 = 64 * j + 32 * kh;
        bool act = true;
        if (MODE != 2) act = !(kv0 > q0 + 32 * qg + 31);
        if (MODE == 1) {
            const float ckmin = *(LAS const float*)(lds + AT_CK + cur * 256 + (32 * kh + 31) * 4);
            const bool dead = __all((qkb + cq2 - ckmin) < (m_run - 40.0f));
            act = act && !dead;
            if (lane == 0) vote[(it & 1) * 8 + wid] = dead ? 0u : 1u;
        }
        if (act) {
            f32x16 p;
#pragma unroll
            for (int r = 0; r < 16; ++r) p[r] = 0.f;
            { LAS const unsigned char* kp = lds + AT_K0 + cur * AT_KBUF + (32 * kh + r32) * AT_KSTR + 16 * h;
#pragma unroll
              for (int s = 0; s < 8; ++s) { const bf16x8 kf = *(LAS const bf16x8*)(kp + 32 * s); p = __builtin_amdgcn_mfma_f32_32x32x16_bf16(kf, qf[s], p, 0, 0, 0); } }
            bool lane_on = true;
            if (MODE == 0) { const int jb = j >> 2; lane_on = (jb == blk) || ((sel >> jb) & 1u); }
            const bool need_mask = (MODE != 2) && ((kv0 + 31 > q0 + 32 * qg) || (MODE == 0 && __any(!lane_on)));
            float mx = MASKV;
            if (MODE == 1) {
#pragma unroll
                for (int g4 = 0; g4 < 4; ++g4) { const f32x4 ck4 = *(LAS const f32x4*)(lds + AT_CK + cur * 256 + (32 * kh + 8 * g4 + 4 * h) * 4);
#pragma unroll
                    for (int e = 0; e < 4; ++e) p[4 * g4 + e] = p[4 * g4 + e] * C2 + (cq2 - ck4[e]); }
            } else {
#pragma unroll
                for (int r = 0; r < 16; ++r) p[r] *= C2;
            }
            if (need_mask) {
#pragma unroll
                for (int r = 0; r < 16; ++r) { const int kvl = (r & 3) + 8 * (r >> 2) + 4 * h; if ((kv0 + kvl > qrow) || !lane_on) p[r] = MASKV; }
            }
#pragma unroll
            for (int r = 0; r < 16; ++r) mx = fmaxf(mx, p[r]);
            mx = fmaxf(mx, __shfl_xor(mx, 32));
            if (__any(mx > m_run)) {
                const float m_new = fmaxf(m_run, mx), alpha = __builtin_amdgcn_exp2f(m_run - m_new); m_run = m_new; l_run *= alpha;
#pragma unroll
                for (int d = 0; d < 4; ++d)
#pragma unroll
                    for (int r = 0; r < 16; ++r) o[d][r] *= alpha;
            }
            float ps = 0.f;
#pragma unroll
            for (int r = 0; r < 16; ++r) { p[r] = __builtin_amdgcn_exp2f(p[r] - m_run); ps += p[r]; }
            l_run += ps;
            bf16x8 pb[2];
#pragma unroll
            for (int s2 = 0; s2 < 2; ++s2) { u32x4 w; w.x = cvt_pk_bf16(p[8 * s2 + 0], p[8 * s2 + 1]); w.y = cvt_pk_bf16(p[8 * s2 + 2], p[8 * s2 + 3]); w.z = cvt_pk_bf16(p[8 * s2 + 4], p[8 * s2 + 5]); w.w = cvt_pk_bf16(p[8 * s2 + 6], p[8 * s2 + 7]);
                pb[s2] = __builtin_bit_cast(bf16x8, w); }
            LAS const unsigned char* vp = lds + AT_V0 + cur * AT_VBUF + (32 * kh + 4 * h + ((lane & 15) >> 2)) * AT_VSTR + (16 * ((lane >> 4) & 1) + 4 * (lane & 3)) * 2;
#pragma unroll
            for (int d = 0; d < 4; ++d)
#pragma unroll
                for (int s2 = 0; s2 < 2; ++s2) { const s16x4 lo = vtr(vp + (16 * s2) * AT_VSTR + 64 * d), hi = vtr(vp + (16 * s2 + 8) * AT_VSTR + 64 * d);
                    const bf16x8 vf = (bf16x8){lo[0], lo[1], lo[2], lo[3], hi[0], hi[1], hi[2], hi[3]};
                    o[d] = __builtin_amdgcn_mfma_f32_32x32x16_bf16(vf, pb[s2], o[d], 0, 0, 0); }
        }
        if (it + 1 < ntiles) AT_STORE(half ^ 1, half ^ 1);
        __syncthreads();
        if (MODE == 1) { const u32x4 v0 = *(LAS const u32x4*)(vote + (it & 1) * 8), v1 = *(LAS const u32x4*)(vote + (it & 1) * 8 + 4);
            if (((v0.x | v0.y) | (v0.z | v0.w) | (v1.x | v1.y) | (v1.z | v1.w)) == 0u) { done = true; break; } }
      }
      if (done) break;
    }
#undef AT_LOAD
#undef AT_STORE
    l_run += __shfl_xor(l_run, 32);
    LAS float* mrg = (LAS float*)lds;
    const int mi = qg * 64 + lane;
    if (kh == 1) {
#pragma unroll
        for (int d = 0; d < 4; ++d)
#pragma unroll
            for (int r = 0; r < 16; ++r) mrg[(d * 16 + r) * 256 + mi] = o[d][r];
        mrg[64 * 256 + mi] = m_run; mrg[65 * 256 + mi] = l_run;
    }
    __syncthreads();
    if (kh == 0) {
        const float m1 = mrg[64 * 256 + mi], l1 = mrg[65 * 256 + mi];
        const float mt = fmaxf(m_run, m1), a0 = __builtin_amdgcn_exp2f(m_run - mt), a1 = __builtin_amdgcn_exp2f(m1 - mt);
        const float inv = 1.0f / (l_run * a0 + l1 * a1);
        bf16_t* op = Ob + (size_t)qrow * ldo + 4 * h;
#pragma unroll
        for (int d = 0; d < 4; ++d)
#pragma unroll
            for (int g4 = 0; g4 < 4; ++g4) { float v[4];
#pragma unroll
                for (int e = 0; e < 4; ++e) { const int r = 4 * g4 + e; v[e] = (o[d][r] * a0 + mrg[(d * 16 + r) * 256 + mi] * a1) * inv; }
                u32x2 w; w.x = cvt_pk_bf16(v[0], v[1]); w.y = cvt_pk_bf16(v[2], v[3]); *(u32x2*)(op + 32 * d + 8 * g4) = w; }
    }
    __syncthreads();
}

__device__ __forceinline__ void rope_item(LAS unsigned char* lds, bf16_t* z, float* kbar_all, int it) {
    const int isk = it >> 7, b = (it >> 6) & 1, blk = (it >> 2) & 15, hh = it & 3, tid = otid(), tg = tid >> 6, dp = tid & 63;
    const int col = (isk ? Z_MK : Z_MQ) + hh * HD + dp;
    const float inv_freq = exp2f(-(float)dp * (13.287712379549449f / 64.0f));
    float s1 = 0.f, s2 = 0.f;
#pragma unroll 1
    for (int i0 = 0; i0 < 32; i0 += 8) {
        float x1[8], x2[8];
#pragma unroll
        for (int i = 0; i < 8; ++i) { const bf16_t* p = z + (size_t)(b * SEQ + blk * 256 + tg * 32 + i0 + i) * NZ + col; x1[i] = bf2f(p[0]); x2[i] = bf2f(p[64]); }
#pragma unroll
        for (int i = 0; i < 8; ++i) { const int t = blk * 256 + tg * 32 + i0 + i; bf16_t* p = z + (size_t)(b * SEQ + t) * NZ + col;
            const float ang = (float)t * inv_freq;
            double rev = (double)ang * 0.15915494309189535; rev -= floor(rev);
            const float rf = (float)rev, sn = __builtin_amdgcn_sinf(rf), cs = __builtin_amdgcn_cosf(rf);
            const float o1 = x1[i] * cs - x2[i] * sn, o2 = x2[i] * cs + x1[i] * sn;
            p[0] = (bf16_t)f2bf(o1); p[64] = (bf16_t)f2bf(o2); s1 += o1; s2 += o2; }
    }
    if (isk) {
        LAS float* red = (LAS float*)lds;
        red[tg * 128 + dp] = s1; red[tg * 128 + 64 + dp] = s2;
        __syncthreads();
        if (tid < 128) { float a = 0.f;
#pragma unroll
            for (int g = 0; g < 8; ++g) a += red[g * 128 + tid];
            kbar_all[((size_t)(b * NH + hh) * 16 + blk) * 128 + tid] = a * (1.0f / 256.0f); }
        __syncthreads();
    }
}
__device__ __forceinline__ void kmax_item(const bf16_t* z, unsigned* kmax2, int it) {
    const int b = it >> 6, blk = (it >> 2) & 15, hh = it & 3, tid = otid(), row = tid >> 1, hf = tid & 1;
    const bf16_t* p = z + (size_t)(b * SEQ + blk * 256 + row) * NZ + Z_FK + hh * HD + 64 * hf; float ss = 0.f;
#pragma unroll
    for (int c8 = 0; c8 < 8; ++c8) { const u32x4 w = *(const u32x4*)(p + 8 * c8);
        const float a0 = bf_lo(w.x), a1 = bf_hi(w.x), a2 = bf_lo(w.y), a3 = bf_hi(w.y), a4 = bf_lo(w.z), a5 = bf_hi(w.z), a6 = bf_lo(w.w), a7 = bf_hi(w.w);
        ss += (a0 * a0 + a1 * a1) + (a2 * a2 + a3 * a3) + (a4 * a4 + a5 * a5) + (a6 * a6 + a7 * a7); }
    ss += __shfl_xor(ss, 1);
#pragma unroll
    for (int o = 2; o < 64; o <<= 1) ss = fmaxf(ss, __shfl_xor(ss, o));
    if ((tid & 63) == 0) atomicMax(kmax2 + b * NH + hh, __float_as_uint(ss));
}
__device__ __forceinline__ float log_sigmoid_(float x) { return fminf(x, 0.f) - log1pf(expf(-fabsf(x))); }
__device__ __forceinline__ void cumsum_item(LAS unsigned char* lds, const float* ff, const float* bias, float* cf, int it) {
    const int b = it >> 2, hh = it & 3, tid = otid(), lane = tid & 63, wid = tid >> 6;
    const float bi = bias[hh]; float v[8]; float run = 0.f;
#pragma unroll
    for (int i = 0; i < 8; ++i) { run += log_sigmoid_(ff[(size_t)(b * SEQ + tid * 8 + i) * 4 + hh] + bi); v[i] = run; }
    float sc = run;
#pragma unroll
    for (int o = 1; o < 64; o <<= 1) { const float t = __shfl_up(sc, o); if (lane >= o) sc += t; }
    LAS float* wt = (LAS float*)lds;
    if (lane == 63) wt[wid] = sc;
    __syncthreads();
    float off = sc - run;
    for (int w = 0; w < wid; ++w) off += wt[w];
#pragma unroll
    for (int i = 0; i < 8; ++i) cf[(size_t)(b * NH + hh) * SEQ + tid * 8 + i] = v[i] + off;
    __syncthreads();
}
template <int W>
__device__ __forceinline__ void pool_rows(const bf16_t* z, bf16_t* y3, int r0, int c) {
    float v[32 + W - 1];
    const int bstart = r0 & ~(SEQ - 1);
#pragma unroll
    for (int i = 0; i < 32 + W - 1; ++i) { const int row = r0 - (W - 1) + i; v[i] = (row >= bstart) ? bf2f(z[(size_t)row * NZ + Z_PIN + c]) : 0.f; }
    float s = 0.f;
#pragma unroll
    for (int i = 0; i < W - 1; ++i) s += v[i];
#pragma unroll
    for (int t = 0; t < 32; ++t) { s += v[t + W - 1]; const int tl = (r0 + t) & (SEQ - 1); const float cnt = (float)((tl + 1 < W) ? (tl + 1) : W);
        y3[(size_t)(r0 + t) * BW + c] = (bf16_t)f2bf(s / cnt - v[t + W - 1]); s -= v[t]; }
}
__device__ __forceinline__ void pool_item(const bf16_t* z, bf16_t* y3, int it) {
    const int c = otid(), g = __builtin_amdgcn_readfirstlane(c >> 7);
    if (g == 0) pool_rows<2>(z, y3, it * 32, c); else if (g == 1) pool_rows<4>(z, y3, it * 32, c); else if (g == 2) pool_rows<8>(z, y3, it * 32, c); else pool_rows<16>(z, y3, it * 32, c);
}

constexpr int HG_STR = 132;
constexpr int HG_Q = 0, HG_K = 64 * HG_STR * 4, HG_B = 2 * 64 * HG_STR * 4, HG_ATT = 3 * 64 * HG_STR * 4, HG_TOT = HG_ATT + 64 * 65 * 4;
__device__ __forceinline__ float hgrn_lb(const float* lbl, int layer, int c) { if (layer == 0) return 0.f; const float g0 = lbl[c], g1 = lbl[512 + c]; return 1.0f / (1.0f + expf(g0 - g1)); }
template <bool WITH_Q>
__device__ __forceinline__ void hgrn_load(LAS unsigned char* lds, const bf16_t* z, const float* lbl, int layer, int row0, int hh) {
    const int tid = otid();
    LAS float* Qm = (LAS float*)(lds + HG_Q); LAS float* Km = (LAS float*)(lds + HG_K); LAS float* Bm = (LAS float*)(lds + HG_B); LAS float* tot = (LAS float*)(lds + HG_TOT);
    { const int d8 = (tid & 15) * 8, r0 = tid >> 4;
#pragma unroll
      for (int rr = 0; rr < 2; ++rr) { const int r = r0 + 32 * rr; const bf16_t* zp = z + (size_t)(row0 + r) * NZ + hh * HD + d8;
          const u32x4 wf = *(const u32x4*)(zp + Z_HF); const unsigned wfa[4] = {wf.x, wf.y, wf.z, wf.w};
          u32x4 wq = (u32x4){0, 0, 0, 0}; if (WITH_Q) wq = *(const u32x4*)(zp + Z_HQ); const unsigned wqa[4] = {wq.x, wq.y, wq.z, wq.w};
#pragma unroll
          for (int e = 0; e < 8; ++e) { const unsigned w = wfa[e >> 1]; const float zf = (e & 1) ? bf_hi(w) : bf_lo(w);
              const float lb = hgrn_lb(lbl, layer, hh * HD + d8 + e), sg = 1.0f / (1.0f + expf(-zf));
              Bm[r * HG_STR + d8 + e] = __builtin_amdgcn_logf(lb + (1.0f - lb) * sg);     Km[r * HG_STR + d8 + e] = (1.0f - lb) * (1.0f - sg);
              if (WITH_Q) { const unsigned q = wqa[e >> 1]; Qm[r * HG_STR + d8 + e] = (e & 1) ? bf_hi(q) : bf_lo(q); } } } }
    __syncthreads();
    const int d = tid & 127, qr = tid >> 7; float run = 0.f;
#pragma unroll
    for (int i = 0; i < 16; ++i) { run += Bm[(16 * qr + i) * HG_STR + d]; Bm[(16 * qr + i) * HG_STR + d] = run; }
    tot[qr * 128 + d] = run;
    __syncthreads();
    float off = 0.f;
    for (int q2 = 0; q2 < qr; ++q2) off += tot[q2 * 128 + d];
#pragma unroll
    for (int i = 0; i < 16; ++i) Bm[(16 * qr + i) * HG_STR + d] += off;
    __syncthreads();
}
__device__ __forceinline__ void hgrn_local_item(LAS unsigned char* lds, const bf16_t* z, const float* lbl, int layer, float* HS, float* HDEC, int it) {
    const int b = it >> 8, hh = (it >> 6) & 3, c = it & 63, row0 = b * SEQ + c * 64, tid = otid();
    hgrn_load<false>(lds, z, lbl, layer, row0, hh);
    LAS float* Vm = (LAS float*)(lds + HG_Q); LAS float* Km = (LAS float*)(lds + HG_K); LAS float* Bm = (LAS float*)(lds + HG_B);
    { const int d8 = (tid & 15) * 8, r0 = tid >> 4;
#pragma unroll
      for (int rr = 0; rr < 2; ++rr) { const int r = r0 + 32 * rr; const u32x4 wv = *(const u32x4*)(z + (size_t)(row0 + r) * NZ + Z_HI + hh * HD + d8); const unsigned wa[4] = {wv.x, wv.y, wv.z, wv.w};
#pragma unroll
          for (int e = 0; e < 8; ++e) Vm[r * HG_STR + d8 + e] = (e & 1) ? bf_hi(wa[e >> 1]) : bf_lo(wa[e >> 1]); } }
    { const int d = tid & 127, qr = tid >> 7; const float bl = Bm[63 * HG_STR + d];
#pragma unroll
      for (int i = 0; i < 16; ++i) { const int s = 16 * qr + i; Km[s * HG_STR + d] *= __builtin_amdgcn_exp2f(bl - Bm[s * HG_STR + d]); }
      if (qr == 0) HDEC[(size_t)it * 128 + d] = __builtin_amdgcn_exp2f(bl); }
    __syncthreads();
    { const int wv = __builtin_amdgcn_readfirstlane(tid >> 6), ln = tid & 63, r32 = ln & 31, h2 = ln >> 5, eb = wv & 3;
      float* dst = HS + (size_t)it * 16384;
#pragma unroll
      for (int q = 0; q < 2; ++q) { const int db = (wv >> 2) * 2 + q; f32x16 c;
#pragma unroll
          for (int r = 0; r < 16; ++r) c[r] = 0.f;
#pragma unroll 8
          for (int kk = 0; kk < 32; ++kk) { const float av = Km[(2 * kk + h2) * HG_STR + 32 * db + r32], bv = Vm[(2 * kk + h2) * HG_STR + 32 * eb + r32];
              c = __builtin_amdgcn_mfma_f32_32x32x2f32(av, bv, c, 0, 0, 0); }
#pragma unroll
          for (int r = 0; r < 16; ++r) dst[(32 * db + (r & 3) + 8 * (r >> 2) + 4 * h2) * 128 + 32 * eb + r32] = c[r]; } }
    __syncthreads();
}
__device__ __forceinline__ void hgrn_scan(float* HS, const float* HDEC, int gtid, int gthreads) {
    for (int el = gtid; el < 8 * 16384; el += gthreads) { const int bh = el >> 14, de = el & 16383, d = de >> 7; float st = 0.f;
        float* p = HS + (size_t)bh * 64 * 16384 + de; const float* dc = HDEC + (size_t)bh * 64 * 128 + d;
#pragma unroll 8
        for (int c = 0; c < 64; ++c) { const float t = p[(size_t)c * 16384]; p[(size_t)c * 16384] = st; st = dc[c * 128] * st + t; } }
}
__device__ __forceinline__ void hgrn_out_item(LAS unsigned char* lds, const bf16_t* z, const float* lbl, int layer, const float* HS, const float* norm_g, bf16_t* y2, int it) {
    const int b = it >> 8, hh = (it >> 6) & 3, c = it & 63, row0 = b * SEQ + c * 64, tid = otid();
    hgrn_load<true>(lds, z, lbl, layer, row0, hh);
    LAS float* Qm = (LAS float*)(lds + HG_Q); LAS float* Km = (LAS float*)(lds + HG_K); LAS float* Bm = (LAS float*)(lds + HG_B); LAS float* At = (LAS float*)(lds + HG_ATT);
    { const int d8 = (tid & 15) * 8, r0 = tid >> 4;
#pragma unroll
      for (int rr = 0; rr < 2; ++rr) { const int r = r0 + 32 * rr;
#pragma unroll
          for (int e = 0; e < 8; ++e) { const float dl = Bm[r * HG_STR + d8 + e] - Bm[31 * HG_STR + d8 + e];
              Qm[r * HG_STR + d8 + e] *= __builtin_amdgcn_exp2f(dl); Km[r * HG_STR + d8 + e] *= __builtin_amdgcn_exp2f(-dl); } } }
    __syncthreads();
    { const int t = tid >> 3, sg = tid & 7; float a[8];
#pragma unroll
      for (int j = 0; j < 8; ++j) a[j] = 0.f;
      for (int d = 0; d < 128; d += 4) { const f32x4 q = *(const LAS f32x4*)(Qm + t * HG_STR + d);
#pragma unroll
          for (int j = 0; j < 8; ++j) { const int s = sg + 8 * j; if (s <= t) { const f32x4 k = *(const LAS f32x4*)(Km + s * HG_STR + d);
              a[j] += (q[0] * k[0] + q[1] * k[1]) + (q[2] * k[2] + q[3] * k[3]); } } }
#pragma unroll
      for (int j = 0; j < 8; ++j) At[t * 65 + sg + 8 * j] = a[j]; }
    __syncthreads();
    const float* Sg = HS + (size_t)it * 16384;
    f32x4 sreg[4];
#pragma unroll
    for (int i = 0; i < 4; ++i) sreg[i] = *(const f32x4*)(Sg + (size_t)(tid + 512 * i) * 4);
    { const int d8 = (tid & 15) * 8, r0 = tid >> 4;
#pragma unroll
      for (int rr = 0; rr < 2; ++rr) { const int r = r0 + 32 * rr; const u32x4 wv = *(const u32x4*)(z + (size_t)(row0 + r) * NZ + Z_HI + hh * HD + d8); const unsigned wa[4] = {wv.x, wv.y, wv.z, wv.w};
#pragma unroll
          for (int e = 0; e < 8; ++e) { Km[r * HG_STR + d8 + e] = (e & 1) ? bf_hi(wa[e >> 1]) : bf_lo(wa[e >> 1]); Qm[r * HG_STR + d8 + e] *= __builtin_amdgcn_exp2f(Bm[31 * HG_STR + d8 + e]); } } }
    __syncthreads();
    const int wv = __builtin_amdgcn_readfirstlane(tid >> 6), ln = tid & 63, r32 = ln & 31, h2 = ln >> 5, tb = wv >> 2, eb = wv & 3;
    f32x16 oc;
#pragma unroll
    for (int r = 0; r < 16; ++r) oc[r] = 0.f;
#pragma unroll 1
    for (int hf = 0; hf < 2; ++hf) {
#pragma unroll
        for (int i = 0; i < 4; ++i) { const int f4 = tid + 512 * i, dr = f4 >> 5, ec = (f4 & 31) * 4; *(LAS f32x4*)(Bm + dr * HG_STR + ec) = sreg[i]; }
        __syncthreads();
        if (hf == 0) {
#pragma unroll
            for (int i = 0; i < 4; ++i) sreg[i] = *(const f32x4*)(Sg + 8192 + (size_t)(tid + 512 * i) * 4); }
#pragma unroll 8
        for (int kk = 0; kk < 32; ++kk) { const float av = Qm[(32 * tb + r32) * HG_STR + 64 * hf + 2 * kk + h2], bv = Bm[(2 * kk + h2) * HG_STR + 32 * eb + r32];
            oc = __builtin_amdgcn_mfma_f32_32x32x2f32(av, bv, oc, 0, 0, 0); }
        __syncthreads();
    }
#pragma unroll 8
    for (int kk = 0; kk < 32; ++kk) { const float av = At[(32 * tb + r32) * 65 + 2 * kk + h2], bv = Km[(2 * kk + h2) * HG_STR + 32 * eb + r32];
        oc = __builtin_amdgcn_mfma_f32_32x32x2f32(av, bv, oc, 0, 0, 0); }
    { LAS float* red = Bm;
#pragma unroll
      for (int r = 0; r < 16; ++r) { float ss = oc[r] * oc[r];
#pragma unroll
          for (int o = 1; o < 32; o <<= 1) ss += __shfl_xor(ss, o);
          if (r32 == 0) red[(32 * tb + (r & 3) + 8 * (r >> 2) + 4 * h2) * 4 + eb] = ss; }
      __syncthreads();
      const int e = 32 * eb + r32; const float ng = norm_g[hh * HD + e];
#pragma unroll
      for (int r = 0; r < 16; ++r) { const int t = 32 * tb + (r & 3) + 8 * (r >> 2) + 4 * h2; const f32x4 pr = *(const LAS f32x4*)(red + t * 4);
          const float rs = 1.0f / sqrtf(((pr[0] + pr[1]) + (pr[2] + pr[3])) * (1.0f / 128.0f) + EPS);
          const size_t row = (size_t)(row0 + t); const float g = bf2f(z[row * NZ + Z_HG + hh * HD + e]);
          y2[row * BW + hh * HD + e] = (bf16_t)f2bf(oc[r] * rs * ng * g * sigmoidf_(g)); } }
    __syncthreads();
}

__device__ __forceinline__ void wpool_item(const float* pool_w, const float* pool_scale, const float* wb3, bf16_t* dst, int it) {
    const int g = (it >> 5) & 3, c0 = ((it >> 2) & 7) * 16, nn = (it & 3) * 512 + otid();
    float acc[16];
#pragma unroll
    for (int i = 0; i < 16; ++i) acc[i] = 0.f;
    for (int e = 0; e < 128; ++e) { const float wb = wb3[(size_t)(g * 128 + e) * DM + nn] * pool_scale[g * 128 + e];
#pragma unroll
        for (int i = 0; i < 16; ++i) acc[i] += pool_w[((size_t)g * 128 + c0 + i) * 128 + e] * wb; }
    u32x4 w0, w1; w0.x = pk2(acc[0], acc[1]); w0.y = pk2(acc[2], acc[3]); w0.z = pk2(acc[4], acc[5]); w0.w = pk2(acc[6], acc[7]);
    w1.x = pk2(acc[8], acc[9]); w1.y = pk2(acc[10], acc[11]); w1.z = pk2(acc[12], acc[13]); w1.w = pk2(acc[14], acc[15]);
    bf16_t* p = dst + (size_t)nn * BW + g * 128 + c0; *(u32x4*)p = w0; *(u32x4*)(p + 8) = w1;
}

__device__ __forceinline__ void load_wff(LAS float* dst, const float* win) {
    const int tid = otid();
#pragma unroll
    for (int i = 0; i < 4; ++i) { const int k = tid + 512 * i; *(LAS f32x4*)(dst + 4 * k) = *(const f32x4*)(win + (size_t)k * DIN_SRC + FF_SRC_COL); }
    __syncthreads();
}
__device__ __forceinline__ void ff_row(int lane, const bf16_t* hn, const LAS float* wff, float* ff) {
    asm volatile("" : "+v"(lane));
    f32x4 fa = (f32x4){0.f, 0.f, 0.f, 0.f};
#pragma unroll
    for (int j = 0; j < 8; ++j) { const u32x2 w = *(const u32x2*)(hn + 4 * lane + 256 * j); const float y[4] = {bf_lo(w.x), bf_hi(w.x), bf_lo(w.y), bf_hi(w.y)};
#pragma unroll
        for (int e = 0; e < 4; ++e) { const f32x4 wv = *(const LAS f32x4*)(wff + (4 * lane + 256 * j + e) * 4); fa = fa + wv * y[e]; } }
    fa[0] = wave_sum(fa[0]); fa[1] = wave_sum(fa[1]); fa[2] = wave_sum(fa[2]); fa[3] = wave_sum(fa[3]); if (lane == 0) *(f32x4*)ff = fa;
}
constexpr int LDS_BYTES = 147456;
struct LayerW { bf16_t *win, *wbr, *wout, *wxq, *wxkv, *wxo, *wup, *wdn; };
__device__ __forceinline__ LayerW layer_w(unsigned char* ws, int l) {
    LayerW w; unsigned char* p = ws + OFF_W + (size_t)l * SZ_WL;
    w.win = (bf16_t*)p; p += SZ_WIN; w.wbr = (bf16_t*)p; p += SZ_WBR; w.wout = (bf16_t*)p; p += SZ_WOUT; w.wxq = (bf16_t*)p; p += SZ_WXQ;
    w.wxkv = (bf16_t*)p; p += SZ_WXKV; w.wxo = (bf16_t*)p; p += SZ_WXO; w.wup = (bf16_t*)p; p += SZ_WUP; w.wdn = (bf16_t*)p; return w;
}
constexpr int I_INA = 32 * 96, I_INB = 32 * 336, I_BR = 8 * 64, I_OUT = 32 * 64, I_XQ = 32 * 16, I_XKV = 32 * 32, I_XO = 8 * 64, I_UP = 32 * 256, I_DN = 128 * 64;
constexpr int I_LAYER = I_INA + I_INB + 3 * I_BR + I_OUT + I_XQ + I_XKV + I_XO + I_UP + I_DN;
constexpr int TR_TOTAL = 2 * I_LAYER;
constexpr int TR_DEFER_C = 12288, TR_DEFER_A = 3200;
constexpr int TR_P0_END = TR_TOTAL - TR_DEFER_C - TR_DEFER_A, TR_A_END = TR_TOTAL - TR_DEFER_C;
static_assert(TR_P0_END >= I_LAYER + (I_LAYER - I_UP - I_DN), "only layer-1 MLP weights may be deferred");
__device__ __forceinline__ TrItem tr_item(const Params& P, unsigned char* ws, int it, int& ldw_) {
    const int l = it / I_LAYER; int r = it - l * I_LAYER; const LayerW w = layer_w(ws, l);
    const float* src; int K, nc; bf16_t* dst;
    if (r < I_INA) { src = P.w_in + (size_t)l * DM * DIN_SRC; ldw_ = DIN_SRC; K = DM; nc = 3072; dst = w.win; }
    else if ((r -= I_INA) < I_INB) { src = P.w_in + (size_t)l * DM * DIN_SRC + 3076; ldw_ = DIN_SRC; K = DM; nc = 10752; dst = w.win + (size_t)3072 * DM; }
    else if ((r -= I_INB) < 3 * I_BR) { const int n = r / I_BR; r -= n * I_BR; src = P.w_branch + ((size_t)l * 4 + n) * BW * DM; ldw_ = DM; K = BW; nc = DM; dst = w.wbr + (size_t)n * DM * BW; }
    else if ((r -= 3 * I_BR) < I_OUT) { src = P.w_mix_out + (size_t)l * DM * DM; ldw_ = DM; K = DM; nc = DM; dst = w.wout; }
    else if ((r -= I_OUT) < I_XQ) { src = P.xa_wq + (size_t)l * DM * BW; ldw_ = BW; K = DM; nc = BW; dst = w.wxq; }
    else if ((r -= I_XQ) < I_XKV) { src = P.xa_wkv + (size_t)l * DM * 1024; ldw_ = 1024; K = DM; nc = 1024; dst = w.wxkv; }
    else if ((r -= I_XKV) < I_XO) { src = P.xa_wo + (size_t)l * BW * DM; ldw_ = DM; K = BW; nc = DM; dst = w.wxo; }
    else if ((r -= I_XO) < I_UP) { src = P.mlp_w_up + (size_t)l * DM * HID; ldw_ = HID; K = DM; nc = HID; dst = w.wup; }
    else { r -= I_UP; src = P.mlp_w_down + (size_t)l * HID * DM; ldw_ = DM; K = HID; nc = DM; dst = w.wdn; }
    return tr_decode(src, ldw_, K, nc, dst, r);
}
__device__ __forceinline__ void tr_run(const Params& P, unsigned char* ws, LAS float* scr, int lane, int it0, int it_end, int worker, int nworkers) {
    int it = it0 + worker; TrItem cur; cur.src = nullptr; cur.dst = nullptr; cur.K = 0; f32x4 v[8]; int ldw = 0;
    if (it < it_end) { cur = tr_item(P, ws, it, ldw); tr_load(cur, ldw, lane, v); }
#pragma unroll 1
    while (it < it_end) {
        const int nit = it + nworkers; TrItem nx = cur; f32x4 vn[8]; int ldn = 0;
#pragma unroll
        for (int i = 0; i < 8; ++i) vn[i] = v[i];
        if (nit < it_end) { nx = tr_item(P, ws, nit, ldn); tr_load(nx, ldn, lane, vn); }
        tr_process(cur, scr, lane, v);
        it = nit; cur = nx;
#pragma unroll
        for (int i = 0; i < 8; ++i) v[i] = vn[i];
    }
}
#ifndef PHM
#define PHM 0xFFFFFFFFu
#endif
#define GRID_SYNC() do { asm volatile("s_waitcnt vmcnt(0) lgkmcnt(0)" ::: "memory"); __syncthreads(); \
    if (otid() == 0) { __builtin_amdgcn_fence(__ATOMIC_RELEASE, "agent"); asm volatile("s_waitcnt vmcnt(0)" ::: "memory"); \
        bar_gen += 1u; const unsigned target_ = bar_gen * (unsigned)G; \
        __hip_atomic_fetch_add(bar_ctr, 1u, __ATOMIC_RELAXED, __HIP_MEMORY_SCOPE_AGENT); \
        while (__hip_atomic_load(bar_ctr, __ATOMIC_RELAXED, __HIP_MEMORY_SCOPE_AGENT) < target_) __builtin_amdgcn_s_sleep(1); \
        __builtin_amdgcn_fence(__ATOMIC_ACQUIRE, "agent"); asm volatile("s_waitcnt vmcnt(0)" ::: "memory"); } \
    __syncthreads(); } while (0)

__global__ void __launch_bounds__(512, 2) fwd_megakernel(Params P) {
    extern __shared__ __attribute__((aligned(16))) unsigned char lds_raw[];
    LAS unsigned char* lds = (LAS unsigned char*)lds_raw;
    cg::grid_group grid = cg::this_grid();
    unsigned* bar_ctr = (unsigned*)(P.ws + OFF_BAR); unsigned bar_gen = 0u;
    if (blockIdx.x == 0) { unsigned* ctl = (unsigned*)(P.ws + OFF_BAR); const int t_ = otid();
        for (int i = t_; i < (int)(CTL_BYTES / 16); i += 512) *(u32x4*)(ctl + 4 * i) = (u32x4){0u, 0u, 0u, 0u};
        asm volatile("s_waitcnt vmcnt(0)" ::: "memory"); __syncthreads();
        if (t_ < 64) { __builtin_amdgcn_fence(__ATOMIC_RELEASE, "agent"); asm volatile("s_waitcnt vmcnt(0)" ::: "memory"); } __syncthreads(); }
    grid.sync();
    __builtin_amdgcn_fence(__ATOMIC_ACQUIRE, "agent"); asm volatile("s_waitcnt vmcnt(0)" ::: "memory"); __syncthreads();
    const int G = gridDim.x, bx = blockIdx.x, NGW = G * 8;
#define TID_VARS const int tid = otid(), lane = tid & 63, wave = __builtin_amdgcn_readfirstlane(tid >> 6), gw = bx * 8 + wave; (void)lane; (void)gw;
#define WS_PTRS unsigned char* ws = P.ws; asm volatile("" : "+s"(ws)); \
    bf16_t* Z = (bf16_t*)(ws + OFF_Z); bf16_t* HN = (bf16_t*)(ws + OFF_HN); bf16_t* Y = (bf16_t*)(ws + OFF_Y); bf16_t* MIX = (bf16_t*)(ws + OFF_MIX); \
    bf16_t* SRC = (bf16_t*)(ws + OFF_SRC); bf16_t* XQ = (bf16_t*)(ws + OFF_XQ); bf16_t* XO = (bf16_t*)(ws + OFF_XO); \
    float* HS = (float*)(ws + OFF_HS); float* HDEC = (float*)(ws + OFF_HDEC); float* KBAR = (float*)(ws + OFF_KBAR); float* CF = (float*)(ws + OFF_CF); float* FF = (float*)(ws + OFF_FF); \
    bf16_t* MEMN = (bf16_t*)(ws + OFF_MEMN); bf16_t* MEMKV = (bf16_t*)(ws + OFF_MEMKV); (void)Z; (void)HN; (void)Y; (void)MIX; (void)SRC; (void)XQ; (void)XO; (void)HS; (void)HDEC; (void)KBAR; (void)CF; (void)FF; (void)MEMN; (void)MEMKV;
    if (PHM & 1u) {
        WS_PTRS TID_VARS
        LAS float* scr = (LAS float*)(lds + wave * 8448);
        LAS float* wffl = (LAS float*)(lds + 69632);
        load_wff(wffl, P.w_in);
        tr_run(P, ws, scr, lane, 0, (G == 256 ? TR_P0_END : TR_TOTAL), gw, NGW);
#pragma unroll 1
        for (int it = bx; it < 256; it += G) { const int l = it >> 7; const LayerW w = layer_w(ws, l);
            wpool_item(P.pool_w + (size_t)l * 4 * 128 * 128, P.pool_scale + l * BW, P.w_branch + ((size_t)l * 4 + 3) * BW * DM, w.wbr + (size_t)3 * DM * BW, it); }
#pragma unroll 1
        for (int r = gw; r < 1024 + M; r += NGW) {
            if (r < 1024) { const int l = r >> 9, rr = r & 511;
                row_pass(false, true, false, lane, nullptr, nullptr, P.mem + (size_t)rr * DM, nullptr, P.xa_norm_mem + l * DM, MEMN + (size_t)r * DM, nullptr, nullptr); }
            else { const int r2 = r - 1024; row_pass(false, true, true, lane, nullptr, nullptr, P.x + (size_t)r2 * DM, nullptr, P.mix_norm_pre, HN + (size_t)r2 * DM, wffl, FF + (size_t)r2 * 4); }
        }
    }
    GRID_SYNC();

#pragma unroll 1
#ifndef PH_END
#define PH_END (14 * DEPTH)
#endif
    for (int ph = 0; ph < PH_END; ++ph) {
        const int l = ph / 14, k = ph - 14 * l;
        const bool fused_ok = (G >= 256);
        if (fused_ok && (k == 6 || k == 10 || (k == 13 && l + 1 == DEPTH))) continue;
        WS_PTRS TID_VARS
        const LayerW w = layer_w(ws, l);
        const bool is_gemm = (k == 0) | (k == 4) | (k == 5) | (k == 7) | (k == 9) | (k == 11) | (k == 12);
        if (is_gemm && ((PHM >> (k + 1)) & 1u)) {
            const int njobs = (k == 0 && l == 0) ? 1 + DEPTH : 1;
#pragma unroll 1
            for (int job = 0; job < njobs; ++job) {
                pg8::Gemm g; pg8::StaticOrder S; pg8::Epi E; E.G = nullptr; E.ldg = 0; E.MODE = 0;
                E.hold = nullptr; E.hout = nullptr; E.hn = nullptr; E.gpost = nullptr; E.gpre = nullptr; E.xb1 = nullptr; E.xb2 = nullptr; E.cnt1 = nullptr; E.cnt2 = nullptr; E.has_next = 0; E.holdb = nullptr; E.houtb = nullptr;
                int nsub = 1, c0 = 0, ksp = 1, ld = 0; long astr = 0, bstr = 0, ostr = 0; g.M = M;
                if (k == 0 && job == 0) { g.A = HN; g.Bt = w.win; g.N = NZ; g.K = DM; E.O = Z; E.MODE = 4; }
                else if (k == 0) { const int l2 = job - 1; const LayerW w2 = layer_w(ws, l2);
                    g.A = MEMN + (size_t)l2 * 512 * DM; g.Bt = w2.wxkv; g.M = 512; g.N = 1024; g.K = DM; E.O = MEMKV + (size_t)l2 * 512 * 1024; c0 = (G >= 208 ? 192 : 0) + 8 * l2; }
                else if (k == 4) { g.A = Y; g.Bt = w.wbr; g.N = DM; g.K = BW; E.O = MIX; E.G = Z + Z_GL; E.ldg = NZ; E.MODE = 2; nsub = 4; astr = (long)M * BW * 2; bstr = (long)DM * BW * 2; }
                else if (k == 5) { g.A = MIX; g.Bt = w.wout; g.N = DM; g.K = DM; E.O = SRC; }
                else if (k == 7) { g.A = HN; g.Bt = w.wxq; g.N = BW; g.K = BW; ld = DM; E.O = MIX; ksp = 4; astr = BW * 2; bstr = BW * 2; ostr = (long)M * BW; }
                else if (k == 9) { g.A = XO; g.Bt = w.wxo; g.N = DM; g.K = BW; E.O = SRC; }
                else if (k == 11) { g.A = HN; g.Bt = w.wup; g.N = HID; g.K = DM; E.O = Z; E.MODE = 1; }
                else { g.A = Z; g.Bt = w.wdn; g.N = DM; g.K = HID; E.O = SRC; }
                if (fused_ok && (k == 5 || k == 9 || k == 12)) { const int gi = (k == 5) ? 0 : (k == 9) ? 1 : 2;
                    E.MODE = 3; E.hold = P.x; E.holdb = (l == 0 && k == 5) ? nullptr : SRC; E.houtb = SRC; E.hout = P.out; E.hn = HN; E.has_next = !(k == 12 && l + 1 == DEPTH);
                    E.gpost = (k == 5 ? P.mix_norm_post : k == 9 ? P.xa_norm_post : P.mlp_norm_post) + l * DM;
                    E.gpre = (k == 5 ? P.xa_norm_pre + l * DM : k == 9 ? P.mlp_norm_pre + l * DM : P.mix_norm_pre + (l + 1 < DEPTH ? l + 1 : 0) * DM);
                    E.xb1 = (float*)(ws + OFF_XB); E.xb2 = E.xb1 + (size_t)M * 8;
                    E.cnt1 = (unsigned*)(ws + OFF_BAR + 4096) + (size_t)(((l * 3 + gi) * 2 + 0) * 32) * 64; E.cnt2 = E.cnt1 + 32 * 64; }
                E.ldc = g.N; g.lda = ld ? ld : g.K; g.ldb = ld ? ld : g.K;
                S.init(g.M, g.N, G, bx, nsub, astr, bstr, c0, ksp, ostr);
                pg8::gemm_phase(lds, g, S, E);
            }
            if (k == 0 && l == 0 && G == 256 && bx >= 216) tr_run(P, ws, (LAS float*)(lds + wave * 8448), lane, TR_P0_END, TR_A_END, (bx - 216) * 8 + wave, 40 * 8);
            if (k == 0) { const int cb = (G >= 216) ? 208 : 0; if (bx >= cb && bx < cb + 8) cumsum_item(lds, FF, P.fox_f_bias + l * NH, CF, bx - cb); }
        } else if (k == 1 && (PHM & 4u)) {
#pragma unroll 1
            for (int it = bx; it < 1160; it += G) {
                if (it < 256) rope_item(lds, Z, KBAR, it);
                else if (it < 264) { }
                else if (it < 776) hgrn_local_item(lds, Z, P.lb_logits, l, HS, HDEC, it - 264);
                else if (it < 1032) pool_item(Z, Y + (size_t)3 * M * BW, it - 776);
                else kmax_item(Z, (unsigned*)(ws + OFF_BAR + 2048) + l * 8, it - 1032);
            }
        } else if (k == 2 && (PHM & 8u)) {
#pragma unroll 1
            for (int p = bx; p < 256; p += G) {
                const int type = p >> 7, bh = (p >> 4) & 7, s = p & 15, b = bh >> 2, hh = bh & 3;
                const bf16_t* zb = Z + (size_t)b * SEQ * NZ + hh * HD;
#pragma unroll 1
                for (int kk = 0; kk < 2; ++kk) { const int qi = kk ? s : 31 - s;
                    if (type == 0) attn_unit<0>(lds, zb + Z_MQ, NZ, zb + Z_MK, zb + Z_MV, NZ, Y + (size_t)b * SEQ * BW + hh * HD, BW, qi * 128, 2 * qi + 2, nullptr, KBAR + (size_t)bh * 2048);
                    else attn_unit<1>(lds, zb + Z_FQ, NZ, zb + Z_FK, zb + Z_FV, NZ, Y + (size_t)M * BW + (size_t)b * SEQ * BW + hh * HD, BW, qi * 128, 2 * qi + 2, CF + (size_t)bh * SEQ, nullptr, 0, (const unsigned*)(ws + OFF_BAR + 2048) + l * 8 + bh); }
            }
            if (G == 256) { if (bx >= 128) { hgrn_scan(HS, HDEC, (bx - 128) * 512 + tid, 128 * 512);
                if (l == 0) tr_run(P, ws, (LAS float*)(lds + wave * 8448), lane, TR_A_END, TR_TOTAL, (bx - 128) * 8 + wave, 128 * 8); } }
            else hgrn_scan(HS, HDEC, bx * 512 + tid, G * 512);
        } else if (k == 3 && (PHM & 16u)) {
#pragma unroll 1
            for (int it = bx; it < 512; it += G) hgrn_out_item(lds, Z, P.lb_logits, l, HS, P.hgrn_out_norm + l * BW, Y + (size_t)2 * M * BW, it);
        } else if (k == 8 && (PHM & 512u)) {
#pragma unroll 1
            for (int p = bx; p < 256; p += G) { const int b = p >> 7, hh = (p >> 5) & 3, qi = p & 31;
                const bf16_t* kv = MEMKV + ((size_t)l * 512 + b * NMEM) * 1024 + hh * HD;
                attn_unit<2>(lds, MIX + (size_t)b * SEQ * BW + hh * HD, BW, kv, kv + 512, 1024, XO + (size_t)b * SEQ * BW + hh * HD, BW, qi * 128, 4, nullptr, nullptr, (size_t)M * BW); }
        } else if (fused_ok && k == 13) {
            load_wff((LAS float*)lds, P.w_in + (size_t)(l + 1) * DM * DIN_SRC);
#pragma unroll 1
            for (int r = gw; r < M; r += NGW) ff_row(lane, HN + (size_t)r * DM, (const LAS float*)lds, FF + (size_t)r * 4);
        } else if ((k == 6 || k == 10 || k == 13) && (PHM & 64u)) {
            const float* gpost = (k == 6 ? P.mix_norm_post : k == 10 ? P.xa_norm_post : P.mlp_norm_post) + l * DM;
            const float* gpre = (k == 6 ? P.xa_norm_pre + l * DM : k == 10 ? P.mlp_norm_pre + l * DM : P.mix_norm_pre + (l + 1 < DEPTH ? l + 1 : 0) * DM);
            const float* hin = (l == 0 && k == 6) ? P.x : P.out;
            const bool has_next = !(k == 13 && l + 1 == DEPTH), has_ff = (k == 13) && has_next;
            if (has_ff) load_wff((LAS float*)lds, P.w_in + (size_t)(l + 1 < DEPTH ? l + 1 : 0) * DM * DIN_SRC);
#pragma unroll 1
            for (int r = gw; r < M; r += NGW)
                row_pass(true, has_next, has_ff, lane, SRC + (size_t)r * DM, gpost, hin + (size_t)r * DM, P.out + (size_t)r * DM, gpre, HN + (size_t)r * DM, (const LAS float*)lds, FF + (size_t)r * 4);
        }
        if (ph + 1 < (fused_ok ? 14 * DEPTH - 1 : 14 * DEPTH)) GRID_SYNC();
    }
#ifdef DBG_OFF
    { const bf16_t* dbg = (const bf16_t*)(P.ws + DBG_OFF); const int t0 = bx * 512 + otid();
      for (size_t i = t0; i < (size_t)M * DM; i += (size_t)G * 512) P.out[i] = i < (size_t)(DBG_LEN) ? bf2f(dbg[i]) : 0.f; }
#endif
}

extern "C" void kernel_launch(void* const* d_in, const int* in_sizes, int n_in, void* d_out, int out_size, void* d_ws, size_t ws_size, hipStream_t stream) {
    static int grid_blocks = 0;
    if (grid_blocks == 0) {
        if (n_in != 22 || ws_size < WS_END) { fprintf(stderr, "kernel_launch: unexpected inputs (n_in %d, ws %zu, need %zu)\n", n_in, ws_size, (size_t)WS_END); grid_blocks = -1; return; }
        int dev = 0, cus = 0, per_cu = 0;
        (void)hipGetDevice(&dev); (void)hipDeviceGetAttribute(&cus, hipDeviceAttributeMultiprocessorCount, dev);
        (void)hipFuncSetAttribute((const void*)fwd_megakernel, hipFuncAttributeMaxDynamicSharedMemorySize, LDS_BYTES);
        (void)hipOccupancyMaxActiveBlocksPerMultiprocessor(&per_cu, (const void*)fwd_megakernel, 512, LDS_BYTES);
        if (per_cu < 1) fprintf(stderr, "kernel_launch: occupancy query says %d blocks per CU\n", per_cu);
        (void)hipGetLastError();
        grid_blocks = cus > 0 ? cus : 256;
    }
    if (grid_blocks < 0) return;
    Params p{};
    const float** pp = (const float**)&p;
    for (int i = 0; i < 22; ++i) pp[i] = (const float*)d_in[i];
    p.out = (float*)d_out; p.ws = (unsigned char*)d_ws;
    void* args[] = {&p};
    hipError_t e = hipLaunchCooperativeKernel((const void*)fwd_megakernel, dim3(grid_blocks), dim3(512), args, LDS_BYTES, stream);
    if (e != hipSuccess) fprintf(stderr, "cooperative launch failed: %s (grid %d)\n", hipGetErrorString(e), grid_blocks);
}
```

```cpp
#include <hip/hip_runtime.h>
#include <hip/hip_cooperative_groups.h>
#include <cstdio>
#include <cstdint>
namespace cg = cooperative_groups;

#define LAS __attribute__((address_space(3)))
typedef unsigned short bf16_t;
typedef short bf16x8 __attribute__((ext_vector_type(8)));
typedef short s16x4 __attribute__((ext_vector_type(4)));
typedef float f32x4 __attribute__((ext_vector_type(4)));
typedef float f32x16 __attribute__((ext_vector_type(16)));
typedef unsigned u32x4 __attribute__((ext_vector_type(4)));
typedef unsigned u32x2 __attribute__((ext_vector_type(2)));

constexpr int BATCH = 2, SEQ = 4096, DM = 2048, M = BATCH * SEQ, DEPTH = 2;
constexpr int DIN_SRC = 13828, NZ = 13824;
constexpr int Z_MQ = 0, Z_MK = 512, Z_MV = 1024, Z_FQ = 1536, Z_FK = 2048, Z_FV = 2560, Z_HQ = 3072, Z_HF = 3584, Z_HI = 4096, Z_HG = 4608, Z_PIN = 5120, Z_GL = 5632;
constexpr int FF_SRC_COL = 3072;
constexpr int NH = 4, HD = 128, BW = 512, HID = 8192, NMEM = 256;
constexpr float EPS = 1e-6f, MASKV = -1e30f, LOG2E = 1.4426950408889634f;

constexpr size_t MiB = 1u << 20;
constexpr size_t SZ_WIN = (size_t)NZ * DM * 2, SZ_WBR = (size_t)4 * DM * BW * 2, SZ_WOUT = (size_t)DM * DM * 2, SZ_WXQ = (size_t)BW * DM * 2, SZ_WXKV = (size_t)1024 * DM * 2,
                 SZ_WXO = (size_t)DM * BW * 2, SZ_WUP = (size_t)HID * DM * 2, SZ_WDN = (size_t)DM * HID * 2;
constexpr size_t SZ_WL = SZ_WIN + SZ_WBR + SZ_WOUT + SZ_WXQ + SZ_WXKV + SZ_WXO + SZ_WUP + SZ_WDN;
constexpr size_t OFF_W = 0;
constexpr size_t OFF_Z = ((OFF_W + 2 * SZ_WL + MiB - 1) / MiB) * MiB;
constexpr size_t OFF_HN = OFF_Z + (((size_t)M * NZ * 2 + MiB - 1) / MiB) * MiB;
constexpr size_t OFF_Y = OFF_HN + (size_t)M * DM * 2;
constexpr size_t OFF_MIX = OFF_Y + (size_t)4 * M * BW * 2;
constexpr size_t OFF_SRC = OFF_MIX + (size_t)M * DM * 2;
constexpr size_t OFF_XQ = OFF_SRC + (size_t)M * DM * 2;
constexpr size_t OFF_XO = OFF_XQ + (size_t)M * BW * 2;
constexpr size_t OFF_HS = OFF_XO + (size_t)M * BW * 2;
constexpr size_t OFF_HDEC = OFF_HS + (size_t)512 * 128 * 128 * 4;
constexpr size_t OFF_KBAR = OFF_HDEC + (size_t)512 * 128 * 4;
constexpr size_t OFF_CF = OFF_KBAR + (size_t)2 * 4 * 16 * 128 * 4;
constexpr size_t OFF_FF = OFF_CF + (size_t)8 * 4096 * 4;
constexpr size_t OFF_MEMN = OFF_FF + (size_t)M * 4 * 4;
constexpr size_t OFF_MEMKV = OFF_MEMN + (size_t)2 * 512 * DM * 2;
constexpr size_t OFF_LB = OFF_MEMKV + (size_t)2 * 512 * 1024 * 2;
constexpr size_t OFF_BAR = OFF_LB + 2 * 512 * 4;
constexpr size_t CTL_BYTES = 131072;
constexpr size_t OFF_XB = OFF_BAR + CTL_BYTES;
constexpr size_t WS_END = OFF_XB + 2 * (size_t)M * 8 * 4;

__device__ __forceinline__ int otid0() { int t = threadIdx.x; asm volatile("" : "+v"(t)); return t; }
namespace pg8 {
constexpr int BM = 256, BK = 64, HALF = 128, HTB = HALF * BK * 2, STAGE_BYTES = 8 * HTB, NXCD = 8, WGM = 4;
__host__ __device__ __forceinline__ int lds_byte(int r, int c) { const int st = (r >> 4) * 2 + (c >> 5), rr = r & 15, cc = c & 31, ob = rr * 64 + cc * 2; return st * 1024 + (ob ^ (((ob >> 9) & 1) << 5)); }
__host__ __device__ __forceinline__ void stage_rc(int b, int& R, int& C) { const int st = b / 1024, sb = b % 1024, swz = sb ^ (((sb >> 9) & 1) << 5); R = (st >> 1) * 16 + swz / 64; C = (st & 1) * 32 + (swz % 64) / 2; }
__host__ __device__ __forceinline__ int perm32(int rho) { const int n = rho >> 4, i = rho & 15; return 8 * (i >> 2) + 4 * n + (i & 3); }

struct Unit { int pm, pn, n; long aoff, boff, ooff; };
struct Gemm { const bf16_t* A; const bf16_t* Bt; int M, N, K, lda, ldb; };

struct StaticOrder {
    int nM, nN, nwg, G, c, nsub, c0, ksp; long astr, bstr, ostr;
    __device__ void init(int M_, int N_, int G_, int c_, int nsub_ = 1, long astr_ = 0, long bstr_ = 0, int c0_ = 0, int ksp_ = 1, long ostr_ = 0) { nM = M_ / BM; nN = N_ / BM; nwg = nM * nN; G = G_; c = c_; nsub = nsub_; astr = astr_; bstr = bstr_; c0 = c0_; ksp = ksp_; ostr = ostr_; }
    __device__ bool next(int i, Unit& u) const {
        if (c < c0) return false;
        const int ti = i / nsub; u.n = i - ti * nsub;
        const long L = (long)ti * G + (c - c0); if (L >= (long)nwg * ksp) return false;
        const int split = (int)(L / nwg);
        int wgid = (int)(L - (long)split * nwg); { const int q = nwg / NXCD, r = nwg % NXCD, xcd = wgid % NXCD, off = wgid / NXCD; wgid = (xcd < r ? xcd * (q + 1) : r * (q + 1) + (xcd - r) * q) + off; }
        const int nig = WGM * nN, gid = wgid / nig, fm = gid * WGM, gsz = (nM - fm) < WGM ? (nM - fm) : WGM;
        u.pm = fm + ((wgid % nig) % gsz); u.pn = (wgid % nig) / gsz; u.aoff = (u.n + split) * astr; u.boff = (u.n + split) * bstr; u.ooff = split * ostr; return true;
    }
};

typedef float f32x2_t __attribute__((ext_vector_type(2))); typedef __bf16 bf16x2_t __attribute__((ext_vector_type(2)));
__device__ __forceinline__ unsigned cvt_pk_bf16(float lo, float hi) { f32x2_t v = {lo, hi}; bf16x2_t b = __builtin_convertvector(v, bf16x2_t); return __builtin_bit_cast(unsigned, b); }
__device__ __forceinline__ float bf_lo(unsigned w) { return __uint_as_float(w << 16); }
__device__ __forceinline__ float bf_hi(unsigned w) { return __uint_as_float(w & 0xffff0000u); }
__device__ __forceinline__ float sigmoidf_(float x) { return __builtin_amdgcn_rcpf(1.0f + __builtin_amdgcn_exp2f(-x * LOG2E)); }

#define RLX_AGENT __ATOMIC_RELAXED, __HIP_MEMORY_SCOPE_AGENT
struct Epi {
    static constexpr bool PERM = true;
    bf16_t* O; int ldc; const bf16_t* G; int ldg; int MODE;
    const float* hold; float* hout; bf16_t* hn; const float* gpost; const float* gpre; float* xb1; float* xb2; unsigned* cnt1; unsigned* cnt2; int has_next;
    const bf16_t* holdb; bf16_t* houtb;
    __device__ __forceinline__ void operator()(f32x4 (&acc)[2][2][4][2], const Unit& u, int wr, int wc, int fr, int fq) const {
        const int row0 = u.pm * BM + wr * 64 + fr, col0 = u.pn * BM + wc * 32 + 8 * fq;
        if (MODE == 2) {
            const bool lastb = (u.n == 3);
#pragma unroll
            for (int ai = 0; ai < 2; ++ai)
#pragma unroll
                for (int m = 0; m < 4; ++m) { const size_t row = (size_t)(row0 + ai * HALF + m * 16); const unsigned char* gp = (const unsigned char*)(G + row * ldg) + (size_t)u.n * DM + col0;
#pragma unroll
                    for (int bj = 0; bj < 2; ++bj) { const u32x2 ga = *(const u32x2*)(gp + bj * HALF); u32x2 gb = (u32x2){0x01010101u, 0x01010101u}; if (!lastb) gb = *(const u32x2*)(gp + DM + bj * HALF);
                        float f[8];
#pragma unroll
                        for (int e = 0; e < 4; ++e) { const float a0 = (float)((ga.x >> (8 * e)) & 0xffu), a1 = (float)((ga.y >> (8 * e)) & 0xffu), b0 = (float)((gb.x >> (8 * e)) & 0xffu), b1 = (float)((gb.y >> (8 * e)) & 0xffu);
                            f[e] = lastb ? a0 * (1.0f / 255.0f) : a0 * __builtin_amdgcn_rcpf(b0); f[4 + e] = lastb ? a1 * (1.0f / 255.0f) : a1 * __builtin_amdgcn_rcpf(b1); }
                        f32x4 v0 = acc[ai][bj][m][0], v1 = acc[ai][bj][m][1];
                        v0[0] *= f[0]; v0[1] *= f[1]; v0[2] *= f[2]; v0[3] *= f[3]; v1[0] *= f[4]; v1[1] *= f[5]; v1[2] *= f[6]; v1[3] *= f[7];
                        acc[ai][bj][m][0] = v0; acc[ai][bj][m][1] = v1;
                        if (lastb) { u32x4 w; w.x = cvt_pk_bf16(v0[0], v0[1]); w.y = cvt_pk_bf16(v0[2], v0[3]); w.z = cvt_pk_bf16(v1[0], v1[1]); w.w = cvt_pk_bf16(v1[2], v1[3]);
                            *(u32x4*)(O + row * ldc + col0 + bj * HALF) = w; } } }
            return;
        }
        if (MODE == 4 && u.pn * BM >= Z_GL) {
#pragma unroll
            for (int ai = 0; ai < 2; ++ai)
#pragma unroll
                for (int m = 0; m < 4; ++m) { unsigned char* gp = (unsigned char*)(O + (size_t)(row0 + ai * HALF + m * 16) * ldc + Z_GL) + (col0 - Z_GL);
#pragma unroll
                    for (int bj = 0; bj < 2; ++bj) { const f32x4 v0 = acc[ai][bj][m][0], v1 = acc[ai][bj][m][1]; unsigned q[8];
#pragma unroll
                        for (int e = 0; e < 4; ++e) { q[e] = (unsigned)fmaxf(sigmoidf_(v0[e]) * 255.0f + 0.5f, 1.0f); q[4 + e] = (unsigned)fmaxf(sigmoidf_(v1[e]) * 255.0f + 0.5f, 1.0f); }
                        u32x2 w; w.x = q[0] | (q[1] << 8) | (q[2] << 16) | (q[3] << 24); w.y = q[4] | (q[5] << 8) | (q[6] << 16) | (q[7] << 24);
                        *(u32x2*)(gp + bj * HALF) = w; } }
            return;
        }
#pragma unroll
        for (int ai = 0; ai < 2; ++ai)
#pragma unroll
            for (int m = 0; m < 4; ++m) { const size_t row = (size_t)(row0 + ai * HALF + m * 16); bf16_t* rowp = O + u.ooff + row * ldc + col0;
#pragma unroll
                for (int bj = 0; bj < 2; ++bj) { f32x4 v0 = acc[ai][bj][m][0], v1 = acc[ai][bj][m][1];
                    if (MODE == 1) {
#pragma unroll
                        for (int e = 0; e < 4; ++e) { const float a = fmaxf(v0[e], 0.f), b = fmaxf(v1[e], 0.f); v0[e] = a * a; v1[e] = b * b; } }
                    if (MODE == 2) {
                        const u32x2 g = *(const u32x2*)((const unsigned char*)(G + row * ldg) + (size_t)u.n * DM + col0 + bj * HALF);
                        const float k255 = 1.0f / 255.0f;
                        v0[0] *= (float)(g.x & 0xffu) * k255; v0[1] *= (float)((g.x >> 8) & 0xffu) * k255; v0[2] *= (float)((g.x >> 16) & 0xffu) * k255; v0[3] *= (float)(g.x >> 24) * k255;
                        v1[0] *= (float)(g.y & 0xffu) * k255; v1[1] *= (float)((g.y >> 8) & 0xffu) * k255; v1[2] *= (float)((g.y >> 16) & 0xffu) * k255; v1[3] *= (float)(g.y >> 24) * k255;
                        if (u.n > 0) { const u32x4 o = *(const u32x4*)(rowp + bj * HALF);
                            v0[0] += bf_lo(o.x); v0[1] += bf_hi(o.x); v0[2] += bf_lo(o.y); v0[3] += bf_hi(o.y); v1[0] += bf_lo(o.z); v1[1] += bf_hi(o.z); v1[2] += bf_lo(o.w); v1[3] += bf_hi(o.w); } }
                    u32x4 w; w.x = cvt_pk_bf16(v0[0], v0[1]); w.y = cvt_pk_bf16(v0[2], v0[3]); w.z = cvt_pk_bf16(v1[0], v1[1]); w.w = cvt_pk_bf16(v1[2], v1[3]);
                    *(u32x4*)(rowp + bj * HALF) = w; } }
    }
    __device__ __forceinline__ void panel_rstd(const f32x4 (&v)[2][2][4][2], const Unit& u, int wr, int wc, int fr, int fq, LAS unsigned char* lds, int tid, float* xb, unsigned* cnt) const {
        LAS float* Pt = (LAS float*)lds; LAS float* St = (LAS float*)(lds + 4096);
        const int wid = __builtin_amdgcn_readfirstlane(tid >> 6), lane = tid & 63;
#pragma unroll
        for (int ai = 0; ai < 2; ++ai)
#pragma unroll
            for (int m = 0; m < 4; ++m) { float s = 0.f;
#pragma unroll
                for (int bj = 0; bj < 2; ++bj)
#pragma unroll
                    for (int n = 0; n < 2; ++n) { const f32x4 x = v[ai][bj][m][n]; s += (x[0] * x[0] + x[1] * x[1]) + (x[2] * x[2] + x[3] * x[3]); }
                s += __shfl_xor(s, 16); s += __shfl_xor(s, 32);
                if (fq == 0) Pt[(ai * HALF + wr * 64 + m * 16 + fr) * 4 + wc] = s; }
        asm volatile("s_waitcnt lgkmcnt(0)" ::: "memory"); __builtin_amdgcn_s_barrier(); asm volatile("" ::: "memory");
        if (tid < 256) { const float tot = (Pt[tid * 4 + 0] + Pt[tid * 4 + 1]) + (Pt[tid * 4 + 2] + Pt[tid * 4 + 3]);
            __hip_atomic_store(xb + (size_t)(u.pm * BM + tid) * 8 + u.pn, tot, RLX_AGENT); }
        asm volatile("s_waitcnt vmcnt(0)" ::: "memory");
        if (tid < 256 && lane == 0) __hip_atomic_fetch_add(cnt + 64 * u.pm, 1u, RLX_AGENT);
        if (wid == 0) { unsigned sp = 0;
            while ((unsigned)__builtin_amdgcn_readfirstlane(__hip_atomic_load(cnt + 64 * u.pm, RLX_AGENT)) < 32u) { __builtin_amdgcn_s_sleep(1); if (++sp > (1u << 22)) break; }
            __builtin_amdgcn_fence(__ATOMIC_ACQUIRE, "agent"); }
        asm volatile("s_waitcnt vmcnt(0) lgkmcnt(0)" ::: "memory"); __builtin_amdgcn_s_barrier(); asm volatile("" ::: "memory");
        if (tid < 256) { const float* sl = xb + (size_t)(u.pm * BM + tid) * 8; float q = 0.f;
#pragma unroll
            for (int t = 0; t < 8; ++t) q += __hip_atomic_load(sl + t, RLX_AGENT);
            St[tid] = 1.0f / sqrtf(q * (1.0f / DM) + EPS); }
        asm volatile("s_waitcnt lgkmcnt(0)" ::: "memory"); __builtin_amdgcn_s_barrier(); asm volatile("" ::: "memory");
    }
    __device__ __forceinline__ void fused(f32x4 (&acc)[2][2][4][2], const Unit& u, int wr, int wc, int fr, int fq, LAS unsigned char* lds, int tid) const {
        const LAS float* St = (const LAS float*)(lds + 4096);
        const int col0 = u.pn * BM + wc * 32 + 8 * fq;
        panel_rstd(acc, u, wr, wc, fr, fq, lds, tid, xb1, cnt1);
        {   f32x4 gp[2][2];
#pragma unroll
            for (int bj = 0; bj < 2; ++bj)
#pragma unroll
                for (int n = 0; n < 2; ++n) gp[bj][n] = *(const f32x4*)(gpost + col0 + bj * HALF + 4 * n);
#pragma unroll
            for (int ai = 0; ai < 2; ++ai)
#pragma unroll
                for (int m = 0; m < 4; ++m) { const int r = ai * HALF + wr * 64 + m * 16 + fr; const float rs = St[r]; const size_t off = (size_t)(u.pm * BM + r) * DM + col0;
#pragma unroll
                    for (int bj = 0; bj < 2; ++bj) { f32x4 h0, h1;
                        if (holdb) { const u32x4 w = *(const u32x4*)(holdb + off + bj * HALF); h0 = (f32x4){bf_lo(w.x), bf_hi(w.x), bf_lo(w.y), bf_hi(w.y)}; h1 = (f32x4){bf_lo(w.z), bf_hi(w.z), bf_lo(w.w), bf_hi(w.w)}; }
                        else { h0 = *(const f32x4*)(hold + off + bj * HALF); h1 = *(const f32x4*)(hold + off + bj * HALF + 4); }
                        acc[ai][bj][m][0] = h0 + acc[ai][bj][m][0] * rs * gp[bj][0]; acc[ai][bj][m][1] = h1 + acc[ai][bj][m][1] * rs * gp[bj][1]; }
                    if (!has_next) {
#pragma unroll
                        for (int bj = 0; bj < 2; ++bj)
#pragma unroll
                            for (int n = 0; n < 2; ++n) *(f32x4*)(hout + off + bj * HALF + 4 * n) = acc[ai][bj][m][n]; }
                    if (m & 1) asm volatile("" ::: "memory"); } }
        if (!has_next) return;
        panel_rstd(acc, u, wr, wc, fr, fq, lds, tid, xb2, cnt2);
        {   f32x4 gp[2][2];
#pragma unroll
            for (int bj = 0; bj < 2; ++bj)
#pragma unroll
                for (int n = 0; n < 2; ++n) gp[bj][n] = *(const f32x4*)(gpre + col0 + bj * HALF + 4 * n);
#pragma unroll
            for (int ai = 0; ai < 2; ++ai)
#pragma unroll
                for (int m = 0; m < 4; ++m) { const int r = ai * HALF + wr * 64 + m * 16 + fr; const float rs = St[r]; const size_t off = (size_t)(u.pm * BM + r) * DM + col0;
#pragma unroll
                    for (int bj = 0; bj < 2; ++bj) { const f32x4 x0 = acc[ai][bj][m][0], x1 = acc[ai][bj][m][1];
                        { u32x4 hw; hw.x = cvt_pk_bf16(x0[0], x0[1]); hw.y = cvt_pk_bf16(x0[2], x0[3]); hw.z = cvt_pk_bf16(x1[0], x1[1]); hw.w = cvt_pk_bf16(x1[2], x1[3]); *(u32x4*)(houtb + off + bj * HALF) = hw; }
                        const f32x4 y0 = x0 * rs * gp[bj][0], y1 = x1 * rs * gp[bj][1];
                        u32x4 w; w.x = cvt_pk_bf16(y0[0], y0[1]); w.y = cvt_pk_bf16(y0[2], y0[3]); w.z = cvt_pk_bf16(y1[0], y1[1]); w.w = cvt_pk_bf16(y1[2], y1[3]);
                        *(u32x4*)(hn + off + bj * HALF) = w; }
                    if (m & 1) asm volatile("" ::: "memory"); } }
    }
};

template <class EpiT, class Sched>
__device__ __forceinline__ void gemm_phase(LAS unsigned char* lds, const Gemm g, const Sched& S, const EpiT& E) {
    const int tid = otid0(), wid = __builtin_amdgcn_readfirstlane(tid >> 6), lane = tid & 63, wr = wid >> 2, wc = wid & 3, fr = lane & 15, fq = lane >> 4;
    const int K = g.K, nt = K / BK;
    unsigned voffA[2], voffB[2];
#pragma unroll
    for (int i = 0; i < 2; ++i) { int R, C; stage_rc(tid * 16 + i * 8192, R, C); const int Rb = EpiT::PERM ? ((R & ~31) + perm32(R & 31)) : R;
        voffA[i] = (unsigned)(R * g.lda + C) * 2u; voffB[i] = (unsigned)(Rb * g.ldb + C) * 2u; }
    const size_t kstep = (size_t)(BK * 2);
    const size_t hstepA = (size_t)HALF * g.lda * 2, hstepB = (size_t)HALF * g.ldb * 2;
    const size_t tstepA = 2 * hstepA, tstepB = 2 * hstepB;
    const unsigned ldsw = (unsigned)wid * 1024u;
    const int aoff = lds_byte(wr * 64 + fr, fq * 8), boff = lds_byte(wc * 32 + fr, fq * 8);
#define PG8_SA(b, h) (((b) * 2 + (h)) * HTB)
#define PG8_SB(b, h) ((4 + (b) * 2 + (h)) * HTB)
#define PG8_STAGE(bufoff, gbase, voff) do { _Pragma("unroll") for (int _i = 0; _i < 2; ++_i) \
        __builtin_amdgcn_global_load_lds((const unsigned*)((const char*)(gbase) + (voff)[_i]), (LAS unsigned*)(lds + (bufoff) + ldsw + _i * 8192), 16, 0, 0); } while (0)
#define PG8_LDA(dst, b, h) do { _Pragma("unroll") for (int m = 0; m < 4; ++m) _Pragma("unroll") for (int k = 0; k < 2; ++k) dst[m][k] = *(const LAS bf16x8*)(lds + PG8_SA(b, h) + aoff + m * 2048 + k * 1024); } while (0)
#define PG8_LDB(dst, b, h) do { _Pragma("unroll") for (int n = 0; n < 2; ++n) _Pragma("unroll") for (int k = 0; k < 2; ++k) dst[n][k] = *(const LAS bf16x8*)(lds + PG8_SB(b, h) + boff + n * 2048 + k * 1024); } while (0)
#define PG8_MMA(ai, bj, At, Bt) do { __builtin_amdgcn_s_setprio(1); _Pragma("unroll") for (int m = 0; m < 4; ++m) _Pragma("unroll") for (int n = 0; n < 2; ++n) _Pragma("unroll") for (int k = 0; k < 2; ++k) \
        acc[ai][bj][m][n] = __builtin_amdgcn_mfma_f32_16x16x32_bf16(Bt[n][k], At[m][k], acc[ai][bj][m][n], 0, 0, 0); __builtin_amdgcn_s_setprio(0); } while (0)
#define PG8_WAIT_V(n) asm volatile("s_waitcnt vmcnt(" #n ")" ::: "memory")
#define PG8_WAIT_L(n) asm volatile("s_waitcnt lgkmcnt(" #n ")" ::: "memory")
#define PG8_BAR __builtin_amdgcn_s_barrier()
#define PG8_SCHED __builtin_amdgcn_sched_barrier(0)
    Unit cur, nxt; int ui = 0;
    if (!S.next(0, cur)) return;
    f32x4 acc[2][2][4][2];
#pragma unroll
    for (int a = 0; a < 2; ++a)
#pragma unroll
        for (int b = 0; b < 2; ++b)
#pragma unroll
            for (int m = 0; m < 4; ++m)
#pragma unroll
                for (int n = 0; n < 2; ++n) acc[a][b][m][n] = (f32x4){0.f, 0.f, 0.f, 0.f};
    bf16x8 At[4][2], B0[2][2], B1[2][2];
    const char* cA = (const char*)g.A + (size_t)cur.pm * tstepA + cur.aoff; const char* cB = (const char*)g.Bt + (size_t)cur.pn * tstepB + cur.boff;
    PG8_STAGE(PG8_SB(0, 0), cB, voffB); PG8_STAGE(PG8_SB(0, 1), cB + hstepB, voffB); PG8_STAGE(PG8_SA(0, 0), cA, voffA); PG8_STAGE(PG8_SA(0, 1), cA + hstepA, voffA);
    if (wr == 1) PG8_BAR;
    PG8_WAIT_V(2); PG8_BAR;
    PG8_STAGE(PG8_SB(1, 0), cB + kstep, voffB); PG8_STAGE(PG8_SA(1, 0), cA + kstep, voffA); PG8_STAGE(PG8_SB(1, 1), cB + hstepB + kstep, voffB);
    PG8_WAIT_V(6); PG8_BAR;
    for (;;) {
        const bool has_next = S.next(ui + 1, nxt);
        const char* nA = has_next ? (const char*)g.A + (size_t)nxt.pm * tstepA + nxt.aoff : cA; const char* nB = has_next ? (const char*)g.Bt + (size_t)nxt.pn * tstepB + nxt.boff : cB;
        for (int t = 0; t < nt; t += 2) {
            const bool last = (t == nt - 2);
            const char* a1 = cA + (size_t)(t + 1) * kstep;
            const char* a2 = last ? nA : cA + (size_t)(t + 2) * kstep; const char* b2 = last ? nB : cB + (size_t)(t + 2) * kstep;
            const char* a3 = a2 + kstep; const char* b3 = b2 + kstep;
            PG8_LDB(B0, 0, 0); PG8_LDB(B1, 0, 1); PG8_SCHED; PG8_LDA(At, 0, 0); PG8_STAGE(PG8_SA(1, 1), a1 + hstepA, voffA);
            PG8_WAIT_V(8); PG8_WAIT_L(0); PG8_BAR; PG8_MMA(0, 0, At, B0); PG8_MMA(0, 1, At, B1); PG8_BAR; PG8_SCHED;
            PG8_LDA(At, 0, 1); PG8_STAGE(PG8_SB(0, 0), b2, voffB); PG8_STAGE(PG8_SB(0, 1), b2 + hstepB, voffB); PG8_STAGE(PG8_SA(0, 0), a2, voffA);
            PG8_WAIT_V(8); PG8_WAIT_L(0); PG8_BAR; PG8_MMA(1, 0, At, B0); PG8_MMA(1, 1, At, B1); PG8_BAR; PG8_SCHED;
            PG8_LDB(B0, 1, 0); PG8_LDB(B1, 1, 1); PG8_SCHED; PG8_LDA(At, 1, 0); PG8_STAGE(PG8_SA(0, 1), a2 + hstepA, voffA);
            PG8_WAIT_V(8); PG8_WAIT_L(0); PG8_BAR; PG8_MMA(0, 0, At, B0); PG8_MMA(0, 1, At, B1); PG8_BAR; PG8_SCHED;
            PG8_LDA(At, 1, 1); PG8_STAGE(PG8_SB(1, 0), b3, voffB); PG8_STAGE(PG8_SB(1, 1), b3 + hstepB, voffB); PG8_STAGE(PG8_SA(1, 0), a3, voffA);
            PG8_WAIT_V(8); PG8_WAIT_L(0); PG8_BAR; PG8_MMA(1, 0, At, B0); PG8_MMA(1, 1, At, B1); PG8_BAR; PG8_SCHED;
        }
        if (wr == 0) PG8_BAR;
        if (E.MODE != 3) E(acc, cur, wr, wc, fr, fq);
        if (!has_next) break;
        if (!(E.MODE == 2 && nxt.n != 0))
#pragma unroll
        for (int a = 0; a < 2; ++a)
#pragma unroll
            for (int b = 0; b < 2; ++b)
#pragma unroll
                for (int m = 0; m < 4; ++m)
#pragma unroll
                    for (int n = 0; n < 2; ++n) acc[a][b][m][n] = (f32x4){0.f, 0.f, 0.f, 0.f};
        cur = nxt; cA = nA; cB = nB; ++ui;
        if (wr == 1) PG8_BAR;
    }
    PG8_WAIT_V(0);
    PG8_BAR;
    if (E.MODE == 3) E.fused(acc, cur, wr, wc, fr, fq, lds, tid);
#undef PG8_SA
#undef PG8_SB
#undef PG8_STAGE
#undef PG8_LDA
#undef PG8_LDB
#undef PG8_MMA
#undef PG8_WAIT_V
#undef PG8_WAIT_L
#undef PG8_BAR
#undef PG8_SCHED
}
}
using pg8::cvt_pk_bf16; using pg8::bf_lo; using pg8::bf_hi; using pg8::sigmoidf_;

struct Params {
    const float *x, *mem, *lb_logits, *mix_norm_pre, *mix_norm_post, *w_in, *fox_f_bias, *hgrn_out_norm, *pool_w, *pool_scale, *w_branch, *w_mix_out,
                *xa_norm_pre, *xa_norm_mem, *xa_norm_post, *xa_wq, *xa_wkv, *xa_wo, *mlp_norm_pre, *mlp_norm_post, *mlp_w_up, *mlp_w_down;
    float* out; unsigned char* ws;
};
__device__ __forceinline__ float wave_sum(float v) {
#pragma unroll
    for (int o = 1; o < 64; o <<= 1) v += __shfl_xor(v, o);
    return v;
}
__device__ __forceinline__ unsigned f2bf(float f) { unsigned u = __builtin_bit_cast(unsigned, f); return (u + 0x7fffu + ((u >> 16) & 1u)) >> 16; }
__device__ __forceinline__ unsigned pk2(float lo, float hi) { return f2bf(lo) | (f2bf(hi) << 16); }
__device__ __forceinline__ float bf2f(bf16_t v) { return __uint_as_float((unsigned)v << 16); }
#define LDS_WAIT() asm volatile("s_waitcnt lgkmcnt(0)" ::: "memory")
__device__ __forceinline__ int otid() { int t = threadIdx.x; asm volatile("" : "+v"(t)); return t; }

struct TrItem { const float* src; bf16_t* dst; int K; };
__device__ __forceinline__ TrItem tr_decode(const float* W, int ldw, int K, int ncols, bf16_t* WT, int item) {
    const int nblk = ncols / 32, kb = item / nblk, nb = item - kb * nblk; TrItem t; t.src = W + (size_t)(64 * kb) * ldw + 32 * nb; t.dst = WT + (size_t)(32 * nb) * K + 64 * kb; t.K = K; return t;
}
__device__ __forceinline__ void tr_load(const TrItem& t, int ldw, int lane, f32x4 (&v)[8]) {
#pragma unroll
    for (int i = 0; i < 8; ++i) v[i] = *(const f32x4*)(t.src + (size_t)(8 * i + (lane >> 3)) * ldw + 4 * (lane & 7));
}
__device__ __forceinline__ void tr_process(const TrItem& t, LAS float* scr, int lane, const f32x4 (&v)[8]) {
#pragma unroll
    for (int i = 0; i < 8; ++i) { LAS float* d = scr + (8 * i + (lane >> 3)) * 33 + 4 * (lane & 7); d[0] = v[i][0]; d[1] = v[i][1]; d[2] = v[i][2]; d[3] = v[i][3]; }
    LDS_WAIT(); asm volatile("" ::: "memory");
    const int c = lane & 7;
#pragma unroll
    for (int j = 0; j < 4; ++j) { const int n = (lane >> 3) + 8 * j; const LAS float* s = scr + (8 * c) * 33 + n;
        u32x4 o; o.x = pk2(s[0 * 33], s[1 * 33]); o.y = pk2(s[2 * 33], s[3 * 33]); o.z = pk2(s[4 * 33], s[5 * 33]); o.w = pk2(s[6 * 33], s[7 * 33]);
        *(u32x4*)(t.dst + (size_t)n * t.K + 8 * c) = o; }
    LDS_WAIT(); asm volatile("" ::: "memory");
}

__device__ __forceinline__ void row_pass(const bool HAS_SRC, const bool HAS_NEXT, const bool HAS_FF, int lane, const bf16_t* src, const float* gpost, const float* hin, float* hout, const float* gpre, bf16_t* hn, const LAS float* wff, float* ff) {
    asm volatile("" : "+v"(lane));
    f32x4 h[8];
#pragma unroll
    for (int j = 0; j < 8; ++j) h[j] = *(const f32x4*)(hin + 4 * lane + 256 * j);
    if (HAS_SRC) {
        f32x4 s[8]; float ss = 0.f;
#pragma unroll
        for (int j = 0; j < 8; ++j) { const u32x2 w = *(const u32x2*)(src + 4 * lane + 256 * j); s[j] = (f32x4){bf_lo(w.x), bf_hi(w.x), bf_lo(w.y), bf_hi(w.y)};
            ss += (s[j][0] * s[j][0] + s[j][1] * s[j][1]) + (s[j][2] * s[j][2] + s[j][3] * s[j][3]); }
        const float r1 = 1.0f / sqrtf(wave_sum(ss) * (1.0f / DM) + EPS);
#pragma unroll
        for (int j = 0; j < 8; ++j) { const f32x4 g = *(const f32x4*)(gpost + 4 * lane + 256 * j); h[j] = h[j] + s[j] * r1 * g; *(f32x4*)(hout + 4 * lane + 256 * j) = h[j]; }
    }
    if (HAS_NEXT) {
        float ss = 0.f;
#pragma unroll
        for (int j = 0; j < 8; ++j) ss += (h[j][0] * h[j][0] + h[j][1] * h[j][1]) + (h[j][2] * h[j][2] + h[j][3] * h[j][3]);
        const float r2 = 1.0f / sqrtf(wave_sum(ss) * (1.0f / DM) + EPS);
        f32x4 fa = (f32x4){0.f, 0.f, 0.f, 0.f};
#pragma unroll
        for (int j = 0; j < 8; ++j) { const f32x4 g = *(const f32x4*)(gpre + 4 * lane + 256 * j); const f32x4 y = h[j] * r2 * g;
            u32x2 w; w.x = pk2(y[0], y[1]); w.y = pk2(y[2], y[3]); *(u32x2*)(hn + 4 * lane + 256 * j) = w;
            if (HAS_FF) {
#pragma unroll
                for (int e = 0; e < 4; ++e) { const f32x4 wv = *(const LAS f32x4*)(wff + (4 * lane + 256 * j + e) * 4); fa = fa + wv * y[e]; } } }
        if (HAS_FF) { fa[0] = wave_sum(fa[0]); fa[1] = wave_sum(fa[1]); fa[2] = wave_sum(fa[2]); fa[3] = wave_sum(fa[3]); if (lane == 0) *(f32x4*)ff = fa; }
    }
}

constexpr int AT_KSTR = 272, AT_VSTR = 320, AT_KBUF = 64 * AT_KSTR, AT_VBUF = 64 * AT_VSTR;
constexpr int AT_K0 = 0, AT_V0 = 2 * AT_KBUF, AT_CK = AT_V0 + 2 * AT_VBUF, AT_KBAR = AT_CK + 512, AT_VOTE = AT_KBAR + 8192, AT_END = AT_VOTE + 64;
typedef short v4i16_t __attribute__((ext_vector_type(4)));
__device__ __forceinline__ s16x4 vtr(LAS const unsigned char* p) { return __builtin_bit_cast(s16x4, __builtin_amdgcn_ds_read_tr16_b64_v4i16((LAS v4i16_t*)p)); }

template <int MODE>
__device__ __forceinline__ void attn_unit(LAS unsigned char* lds, const bf16_t* Qb, int ldq, const bf16_t* Kb, const bf16_t* Vb, int ldkv, bf16_t* Ob, int ldo, int q0, int ntiles, const float* cf, const float* kbar, size_t qsplit = 0, const unsigned* kmaxp = nullptr) {
    const int tid = otid(), lane = tid & 63, wid = __builtin_amdgcn_readfirstlane(tid >> 6), qg = wid & 3, kh = wid >> 2, r32 = lane & 31, h = lane >> 5;
    const int qrow = q0 + 32 * qg + r32;
    const float C2 = 0.08838834764831845f * LOG2E;
    bf16x8 qf[8];
    { const bf16_t* qp = Qb + (size_t)qrow * ldq + 8 * h;
      if (MODE == 2 && qsplit) {
#pragma unroll
          for (int s = 0; s < 8; ++s) { float a[8];
#pragma unroll
              for (int e = 0; e < 8; ++e) a[e] = 0.f;
#pragma unroll
              for (int ks = 0; ks < 4; ++ks) { const u32x4 w = *(const u32x4*)(qp + ks * qsplit + 16 * s);
                  a[0] += bf_lo(w.x); a[1] += bf_hi(w.x); a[2] += bf_lo(w.y); a[3] += bf_hi(w.y); a[4] += bf_lo(w.z); a[5] += bf_hi(w.z); a[6] += bf_lo(w.w); a[7] += bf_hi(w.w); }
              u32x4 o; o.x = cvt_pk_bf16(a[0], a[1]); o.y = cvt_pk_bf16(a[2], a[3]); o.z = cvt_pk_bf16(a[4], a[5]); o.w = cvt_pk_bf16(a[6], a[7]); qf[s] = __builtin_bit_cast(bf16x8, o); }
      } else {
#pragma unroll
          for (int s = 0; s < 8; ++s) qf[s] = *(const bf16x8*)(qp + 16 * s); } }
    unsigned sel = 0; const int blk = q0 >> 8;
    if (MODE == 0) {
        LAS float* kbl = (LAS float*)(lds + AT_KBAR);
        *(LAS f32x4*)(kbl + 4 * tid) = *(const f32x4*)(kbar + 4 * tid);
        __syncthreads();
        if (blk <= 3) sel = (1u << blk) - 1u;
        else {
            unsigned qw[32];
            { const bf16_t* qp = Qb + (size_t)qrow * ldq + 64 * h;
#pragma unroll
              for (int c8 = 0; c8 < 8; ++c8) { const u32x4 w = *(const u32x4*)(qp + 8 * c8); qw[4 * c8] = w.x; qw[4 * c8 + 1] = w.y; qw[4 * c8 + 2] = w.z; qw[4 * c8 + 3] = w.w; } }
            float v1 = -3.0e38f, v2 = -3.0e38f, v3 = -3.0e38f; int i1 = 0, i2 = 0, i3 = 0;
#pragma unroll 1
            for (int j = 0; j < blk; ++j) { float g = 0.f; const LAS float* kb = kbl + j * 128 + 64 * h;
#pragma unroll
                for (int c4 = 0; c4 < 16; ++c4) { const f32x4 a = *(const LAS f32x4*)(kb + 4 * c4);
                    g += (bf_lo(qw[2 * c4]) * a[0] + bf_hi(qw[2 * c4]) * a[1]) + (bf_lo(qw[2 * c4 + 1]) * a[2] + bf_hi(qw[2 * c4 + 1]) * a[3]); }
                g += __shfl_xor(g, 32);
                if (g > v1) { v3 = v2; i3 = i2; v2 = v1; i2 = i1; v1 = g; i1 = j; }
                else if (g > v2) { v3 = v2; i3 = i2; v2 = g; i2 = j; }
                else if (g > v3) { v3 = g; i3 = j; } }
            sel = (1u << i1) | (1u << i2) | (1u << i3);
        }
    }
    float cq2 = 0.f, qkb = 0.f;
    if (MODE == 1) { cq2 = cf[qrow] * LOG2E;
        float qs = 0.f;
#pragma unroll
        for (int s8 = 0; s8 < 8; ++s8) { const u32x4 w = __builtin_bit_cast(u32x4, qf[s8]);
            const float a0 = bf_lo(w.x), a1 = bf_hi(w.x), a2 = bf_lo(w.y), a3 = bf_hi(w.y), a4 = bf_lo(w.z), a5 = bf_hi(w.z), a6 = bf_lo(w.w), a7 = bf_hi(w.w);
            qs += (a0 * a0 + a1 * a1) + (a2 * a2 + a3 * a3) + (a4 * a4 + a5 * a5) + (a6 * a6 + a7 * a7); }
        qs += __shfl_xor(qs, 32);
        qkb = C2 * sqrtf(qs) * sqrtf(__uint_as_float(*kmaxp)) * 1.01f + 1.0f; }
    LAS unsigned* vote = (LAS unsigned*)(lds + AT_VOTE);
    float m_run = MASKV, l_run = 0.f;
    f32x16 o[4];
#pragma unroll
    for (int d = 0; d < 4; ++d)
#pragma unroll
        for (int r = 0; r < 16; ++r) o[d][r] = 0.f;
    u32x4 kreg[2][2], vreg[2][2]; float ckreg[2] = {0.f, 0.f};
    const int srow = tid >> 4, sch = tid & 15;
#define AT_LOAD(j, S_) do { _Pragma("unroll") for (int i_ = 0; i_ < 2; ++i_) { const size_t go = (size_t)(64 * (j) + srow + 32 * i_) * ldkv + sch * 8; kreg[S_][i_] = *(const u32x4*)(Kb + go); vreg[S_][i_] = *(const u32x4*)(Vb + go); } \
        if (MODE == 1 && tid < 64) ckreg[S_] = cf[64 * (j) + tid] * LOG2E; } while (0)
#define AT_STORE(b, S_) do { _Pragma("unroll") for (int i_ = 0; i_ < 2; ++i_) { *(LAS u32x4*)(lds + AT_K0 + (b) * AT_KBUF + (srow + 32 * i_) * AT_KSTR + sch * 16) = kreg[S_][i_]; \
        *(LAS u32x4*)(lds + AT_V0 + (b) * AT_VBUF + (srow + 32 * i_) * AT_VSTR + sch * 16) = vreg[S_][i_]; } if (MODE == 1 && tid < 64) *(LAS float*)(lds + AT_CK + (b) * 256 + tid * 4) = ckreg[S_]; } while (0)
#define AT_TILE(i_) ((MODE == 0) ? (i_) : ntiles - 1 - (i_))
    AT_LOAD(AT_TILE(0), 0); AT_LOAD(AT_TILE(1), 1); AT_STORE(0, 0);
    __syncthreads();
    bool done = false;
#pragma unroll 1
    for (int it0 = 0; it0 < ntiles; it0 += 2) {
#pragma unroll
      for (int half = 0; half < 2; ++half) {
        const int it = it0 + half, j = AT_TILE(it), cur = half;
        if (it + 2 < ntiles) AT_LOAD(AT_TILE(it + 2), half);
        const int kv0 = 64 * j + 32 * kh;
        bool act = true;
        if (MODE != 2) act = !(kv0 > q0 + 32 * qg + 31);
        if (MODE == 1) {
            const float ckmin = *(LAS const float*)(lds + AT_CK + cur * 256 + (32 * kh + 31) * 4);
            const bool dead = __all((qkb + cq2 - ckmin) < (m_run - 40.0f));
            act = act && !dead;
            if (lane == 0) vote[(it & 1) * 8 + wid] = dead ? 0u : 1u;
        }
        if (act) {
            f32x16 p;
#pragma unroll
            for (int r = 0; r < 16; ++r) p[r] = 0.f;
            { LAS const unsigned char* kp = lds + AT_K0 + cur * AT_KBUF + (32 * kh + r32) * AT_KSTR + 16 * h;
#pragma unroll
              for (int s = 0; s < 8; ++s) { const bf16x8 kf = *(LAS const bf16x8*)(kp + 32 * s); p = __builtin_amdgcn_mfma_f32_32x32x16_bf16(kf, qf[s], p, 0, 0, 0); } }
            bool lane_on = true;
            if (MODE == 0) { const int jb = j >> 2; lane_on = (jb == blk) || ((sel >> jb) & 1u); }
            const bool need_mask = (MODE != 2) && ((kv0 + 31 > q0 + 32 * qg) || (MODE == 0 && __any(!lane_on)));
            float mx = MASKV;
            if (MODE == 1) {
#pragma unroll
                for (int g4 = 0; g4 < 4; ++g4) { const f32x4 ck4 = *(LAS const f32x4*)(lds + AT_CK + cur * 256 + (32 * kh + 8 * g4 + 4 * h) * 4);
#pragma unroll
                    for (int e = 0; e < 4; ++e) p[4 * g4 + e] = p[4 * g4 + e] * C2 + (cq2 - ck4[e]); }
            } else {
#pragma unroll
                for (int r = 0; r < 16; ++r) p[r] *= C2;
            }
            if (need_mask) {
#pragma unroll
                for (int r = 0; r < 16; ++r) { const int kvl = (r & 3) + 8 * (r >> 2) + 4 * h; if ((kv0 + kvl > qrow) || !lane_on) p[r] = MASKV; }
            }
#pragma unroll
            for (int r = 0; r < 16; ++r) mx = fmaxf(mx, p[r]);
            mx = fmaxf(mx, __shfl_xor(mx, 32));
            if (__any(mx > m_run)) {
                const float m_new = fmaxf(m_run, mx), alpha = __builtin_amdgcn_exp2f(m_run - m_new); m_run = m_new; l_run *= alpha;
#pragma unroll
                for (int d = 0; d < 4; ++d)
#pragma unroll
                    for (int r = 0; r < 16; ++r) o[d][r] *= alpha;
            }
            float ps = 0.f;
#pragma unroll
            for (int r = 0; r < 16; ++r) { p[r] = __builtin_amdgcn_exp2f(p[r] - m_run); ps += p[r]; }
            l_run += ps;
            bf16x8 pb[2];
#pragma unroll
            for (int s2 = 0; s2 < 2; ++s2) { u32x4 w; w.x = cvt_pk_bf16(p[8 * s2 + 0], p[8 * s2 + 1]); w.y = cvt_pk_bf16(p[8 * s2 + 2], p[8 * s2 + 3]); w.z = cvt_pk_bf16(p[8 * s2 + 4], p[8 * s2 + 5]); w.w = cvt_pk_bf16(p[8 * s2 + 6], p[8 * s2 + 7]);
                pb[s2] = __builtin_bit_cast(bf16x8, w); }
            LAS const unsigned char* vp = lds + AT_V0 + cur * AT_VBUF + (32 * kh + 4 * h + ((lane & 15) >> 2)) * AT_VSTR + (16 * ((lane >> 4) & 1) + 4 * (lane & 3)) * 2;
#pragma unroll
            for (int d = 0; d < 4; ++d)
#pragma unroll
                for (int s2 = 0; s2 < 2; ++s2) { const s16x4 lo = vtr(vp + (16 * s2) * AT_VSTR + 64 * d), hi = vtr(vp + (16 * s2 + 8) * AT_VSTR + 64 * d);
                    const bf16x8 vf = (bf16x8){lo[0], lo[1], lo[2], lo[3], hi[0], hi[1], hi[2], hi[3]};
                    o[d] = __builtin_amdgcn_mfma_f32_32x32x16_bf16(vf, pb[s2], o[d], 0, 0, 0); }
        }
        if (it + 1 < ntiles) AT_STORE(half ^ 1, half ^ 1);
        __syncthreads();
        if (MODE == 1) { const u32x4 v0 = *(LAS const u32x4*)(vote + (it & 1) * 8), v1 = *(LAS const u32x4*)(vote + (it & 1) * 8 + 4);
            if (((v0.x | v0.y) | (v0.z | v0.w) | (v1.x | v1.y) | (v1.z | v1.w)) == 0u) { done = true; break; } }
      }
      if (done) break;
    }
#undef AT_LOAD
#undef AT_STORE
#undef AT_TILE
    l_run += __shfl_xor(l_run, 32);
    LAS float* mrg = (LAS float*)lds;
    const int mi = qg * 64 + lane;
    if (kh == 1) {
#pragma unroll
        for (int d = 0; d < 4; ++d)
#pragma unroll
            for (int r = 0; r < 16; ++r) mrg[(d * 16 + r) * 256 + mi] = o[d][r];
        mrg[64 * 256 + mi] = m_run; mrg[65 * 256 + mi] = l_run;
    }
    __syncthreads();
    if (kh == 0) {
        const float m1 = mrg[64 * 256 + mi], l1 = mrg[65 * 256 + mi];
        const float mt = fmaxf(m_run, m1), a0 = __builtin_amdgcn_exp2f(m_run - mt), a1 = __builtin_amdgcn_exp2f(m1 - mt);
        const float inv = 1.0f / (l_run * a0 + l1 * a1);
        bf16_t* op = Ob + (size_t)qrow * ldo + 4 * h;
#pragma unroll
        for (int d = 0; d < 4; ++d)
#pragma unroll
            for (int g4 = 0; g4 < 4; ++g4) { float v[4];
#pragma unroll
                for (int e = 0; e < 4; ++e) { const int r = 4 * g4 + e; v[e] = (o[d][r] * a0 + mrg[(d * 16 + r) * 256 + mi] * a1) * inv; }
                u32x2 w; w.x = cvt_pk_bf16(v[0], v[1]); w.y = cvt_pk_bf16(v[2], v[3]); *(u32x2*)(op + 32 * d + 8 * g4) = w; }
    }
    __syncthreads();
}

__device__ __forceinline__ void rope_item(LAS unsigned char* lds, bf16_t* z, float* kbar_all, int it) {
    const int isk = it >> 7, b = (it >> 6) & 1, blk = (it >> 2) & 15, hh = it & 3, tid = otid(), tg = tid >> 6, dp = tid & 63;
    const int col = (isk ? Z_MK : Z_MQ) + hh * HD + dp;
    const float inv_freq = exp2f(-(float)dp * (13.287712379549449f / 64.0f));
    float s1 = 0.f, s2 = 0.f;
#pragma unroll 1
    for (int i0 = 0; i0 < 32; i0 += 8) {
        float x1[8], x2[8];
#pragma unroll
        for (int i = 0; i < 8; ++i) { const bf16_t* p = z + (size_t)(b * SEQ + blk * 256 + tg * 32 + i0 + i) * NZ + col; x1[i] = bf2f(p[0]); x2[i] = bf2f(p[64]); }
#pragma unroll
        for (int i = 0; i < 8; ++i) { const int t = blk * 256 + tg * 32 + i0 + i; bf16_t* p = z + (size_t)(b * SEQ + t) * NZ + col;
            const float ang = (float)t * inv_freq;
            double rev = (double)ang * 0.15915494309189535; rev -= floor(rev);
            const float rf = (float)rev, sn = __builtin_amdgcn_sinf(rf), cs = __builtin_amdgcn_cosf(rf);
            const float o1 = x1[i] * cs - x2[i] * sn, o2 = x2[i] * cs + x1[i] * sn;
            p[0] = (bf16_t)f2bf(o1); p[64] = (bf16_t)f2bf(o2); s1 += o1; s2 += o2; }
    }
    if (isk) {
        LAS float* red = (LAS float*)lds;
        red[tg * 128 + dp] = s1; red[tg * 128 + 64 + dp] = s2;
        __syncthreads();
        if (tid < 128) { float a = 0.f;
#pragma unroll
            for (int g = 0; g < 8; ++g) a += red[g * 128 + tid];
            kbar_all[((size_t)(b * NH + hh) * 16 + blk) * 128 + tid] = a * (1.0f / 256.0f); }
        __syncthreads();
    }
}
__device__ __forceinline__ void kmax_item(const bf16_t* z, unsigned* kmax2, int it) {
    const int b = it >> 6, blk = (it >> 2) & 15, hh = it & 3, tid = otid(), row = tid >> 1, hf = tid & 1;
    const bf16_t* p = z + (size_t)(b * SEQ + blk * 256 + row) * NZ + Z_FK + hh * HD + 64 * hf; float ss = 0.f;
#pragma unroll
    for (int c8 = 0; c8 < 8; ++c8) { const u32x4 w = *(const u32x4*)(p + 8 * c8);
        const float a0 = bf_lo(w.x), a1 = bf_hi(w.x), a2 = bf_lo(w.y), a3 = bf_hi(w.y), a4 = bf_lo(w.z), a5 = bf_hi(w.z), a6 = bf_lo(w.w), a7 = bf_hi(w.w);
        ss += (a0 * a0 + a1 * a1) + (a2 * a2 + a3 * a3) + (a4 * a4 + a5 * a5) + (a6 * a6 + a7 * a7); }
    ss += __shfl_xor(ss, 1);
#pragma unroll
    for (int o = 2; o < 64; o <<= 1) ss = fmaxf(ss, __shfl_xor(ss, o));
    if ((tid & 63) == 0) atomicMax(kmax2 + b * NH + hh, __float_as_uint(ss));
}
__device__ __forceinline__ float log_sigmoid_(float x) { return fminf(x, 0.f) - log1pf(expf(-fabsf(x))); }
__device__ __forceinline__ void cumsum_item(LAS unsigned char* lds, const float* ff, const float* bias, float* cf, int it) {
    const int b = it >> 2, hh = it & 3, tid = otid(), lane = tid & 63, wid = tid >> 6;
    const float bi = bias[hh]; float v[8]; float run = 0.f;
#pragma unroll
    for (int i = 0; i < 8; ++i) { run += log_sigmoid_(ff[(size_t)(b * SEQ + tid * 8 + i) * 4 + hh] + bi); v[i] = run; }
    float sc = run;
#pragma unroll
    for (int o = 1; o < 64; o <<= 1) { const float t = __shfl_up(sc, o); if (lane >= o) sc += t; }
    LAS float* wt = (LAS float*)lds;
    if (lane == 63) wt[wid] = sc;
    __syncthreads();
    float off = sc - run;
    for (int w = 0; w < wid; ++w) off += wt[w];
#pragma unroll
    for (int i = 0; i < 8; ++i) cf[(size_t)(b * NH + hh) * SEQ + tid * 8 + i] = v[i] + off;
    __syncthreads();
}
template <int W>
__device__ __forceinline__ void pool_rows(const bf16_t* z, bf16_t* y3, int r0, int c) {
    float v[32 + W - 1];
    const int bstart = r0 & ~(SEQ - 1);
#pragma unroll
    for (int i = 0; i < 32 + W - 1; ++i) { const int row = r0 - (W - 1) + i; v[i] = (row >= bstart) ? bf2f(z[(size_t)row * NZ + Z_PIN + c]) : 0.f; }
    float s = 0.f;
#pragma unroll
    for (int i = 0; i < W - 1; ++i) s += v[i];
#pragma unroll
    for (int t = 0; t < 32; ++t) { s += v[t + W - 1]; const int tl = (r0 + t) & (SEQ - 1); const float cnt = (float)((tl + 1 < W) ? (tl + 1) : W);
        y3[(size_t)(r0 + t) * BW + c] = (bf16_t)f2bf(s / cnt - v[t + W - 1]); s -= v[t]; }
}
__device__ __forceinline__ void pool_item(const bf16_t* z, bf16_t* y3, int it) {
    const int c = otid(), g = __builtin_amdgcn_readfirstlane(c >> 7);
    if (g == 0) pool_rows<2>(z, y3, it * 32, c); else if (g == 1) pool_rows<4>(z, y3, it * 32, c); else if (g == 2) pool_rows<8>(z, y3, it * 32, c); else pool_rows<16>(z, y3, it * 32, c);
}

constexpr int HG_STR = 132;
constexpr int HG_Q = 0, HG_K = 64 * HG_STR * 4, HG_B = 2 * 64 * HG_STR * 4, HG_ATT = 3 * 64 * HG_STR * 4, HG_TOT = HG_ATT + 64 * 65 * 4;
__device__ __forceinline__ float hgrn_lb(const float* lbl, int layer, int c) { if (layer == 0) return 0.f; const float g0 = lbl[c], g1 = lbl[512 + c]; return 1.0f / (1.0f + expf(g0 - g1)); }
template <bool WITH_Q>
__device__ __forceinline__ void hgrn_load(LAS unsigned char* lds, const bf16_t* z, const float* lbl, int layer, int row0, int hh) {
    const int tid = otid();
    LAS float* Qm = (LAS float*)(lds + HG_Q); LAS float* Km = (LAS float*)(lds + HG_K); LAS float* Bm = (LAS float*)(lds + HG_B); LAS float* tot = (LAS float*)(lds + HG_TOT);
    { const int d8 = (tid & 15) * 8, r0 = tid >> 4;
#pragma unroll
      for (int rr = 0; rr < 2; ++rr) { const int r = r0 + 32 * rr; const bf16_t* zp = z + (size_t)(row0 + r) * NZ + hh * HD + d8;
          const u32x4 wf = *(const u32x4*)(zp + Z_HF); const unsigned wfa[4] = {wf.x, wf.y, wf.z, wf.w};
          u32x4 wq = (u32x4){0, 0, 0, 0}; if (WITH_Q) wq = *(const u32x4*)(zp + Z_HQ); const unsigned wqa[4] = {wq.x, wq.y, wq.z, wq.w};
#pragma unroll
          for (int e = 0; e < 8; ++e) { const unsigned w = wfa[e >> 1]; const float zf = (e & 1) ? bf_hi(w) : bf_lo(w);
              const float lb = hgrn_lb(lbl, layer, hh * HD + d8 + e), sg = 1.0f / (1.0f + expf(-zf));
              Bm[r * HG_STR + d8 + e] = __builtin_amdgcn_logf(lb + (1.0f - lb) * sg);     Km[r * HG_STR + d8 + e] = (1.0f - lb) * (1.0f - sg);
              if (WITH_Q) { const unsigned q = wqa[e >> 1]; Qm[r * HG_STR + d8 + e] = (e & 1) ? bf_hi(q) : bf_lo(q); } } } }
    __syncthreads();
    const int d = tid & 127, qr = tid >> 7; float run = 0.f;
#pragma unroll
    for (int i = 0; i < 16; ++i) { run += Bm[(16 * qr + i) * HG_STR + d]; Bm[(16 * qr + i) * HG_STR + d] = run; }
    tot[qr * 128 + d] = run;
    __syncthreads();
    float off = 0.f;
    for (int q2 = 0; q2 < qr; ++q2) off += tot[q2 * 128 + d];
#pragma unroll
    for (int i = 0; i < 16; ++i) Bm[(16 * qr + i) * HG_STR + d] += off;
    __syncthreads();
}
__device__ __forceinline__ void hgrn_local_item(LAS unsigned char* lds, const bf16_t* z, const float* lbl, int layer, float* HS, float* HDEC, int it) {
    const int b = it >> 8, hh = (it >> 6) & 3, c = it & 63, row0 = b * SEQ + c * 64, tid = otid();
    hgrn_load<false>(lds, z, lbl, layer, row0, hh);
    LAS float* Vm = (LAS float*)(lds + HG_Q); LAS float* Km = (LAS float*)(lds + HG_K); LAS float* Bm = (LAS float*)(lds + HG_B);
    { const int d8 = (tid & 15) * 8, r0 = tid >> 4;
#pragma unroll
      for (int rr = 0; rr < 2; ++rr) { const int r = r0 + 32 * rr; const u32x4 wv = *(const u32x4*)(z + (size_t)(row0 + r) * NZ + Z_HI + hh * HD + d8); const unsigned wa[4] = {wv.x, wv.y, wv.z, wv.w};
#pragma unroll
          for (int e = 0; e < 8; ++e) Vm[r * HG_STR + d8 + e] = (e & 1) ? bf_hi(wa[e >> 1]) : bf_lo(wa[e >> 1]); } }
    { const int d = tid & 127, qr = tid >> 7; const float bl = Bm[63 * HG_STR + d];
#pragma unroll
      for (int i = 0; i < 16; ++i) { const int s = 16 * qr + i; Km[s * HG_STR + d] *= __builtin_amdgcn_exp2f(bl - Bm[s * HG_STR + d]); }
      if (qr == 0) HDEC[(size_t)it * 128 + d] = __builtin_amdgcn_exp2f(bl); }
    __syncthreads();
    { const int wv = __builtin_amdgcn_readfirstlane(tid >> 6), ln = tid & 63, r32 = ln & 31, h2 = ln >> 5, eb = wv & 3;
      float* dst = HS + (size_t)it * 16384;
#pragma unroll
      for (int q = 0; q < 2; ++q) { const int db = (wv >> 2) * 2 + q; f32x16 c;
#pragma unroll
          for (int r = 0; r < 16; ++r) c[r] = 0.f;
#pragma unroll 8
          for (int kk = 0; kk < 32; ++kk) { const float av = Km[(2 * kk + h2) * HG_STR + 32 * db + r32], bv = Vm[(2 * kk + h2) * HG_STR + 32 * eb + r32];
              c = __builtin_amdgcn_mfma_f32_32x32x2f32(av, bv, c, 0, 0, 0); }
#pragma unroll
          for (int r = 0; r < 16; ++r) dst[(32 * db + (r & 3) + 8 * (r >> 2) + 4 * h2) * 128 + 32 * eb + r32] = c[r]; } }
    __syncthreads();
}
__device__ __forceinline__ void hgrn_scan(float* HS, const float* HDEC, int gtid, int gthreads) {
    for (int el = gtid; el < 8 * 16384; el += gthreads) { const int bh = el >> 14, de = el & 16383, d = de >> 7; float st = 0.f;
        float* p = HS + (size_t)bh * 64 * 16384 + de; const float* dc = HDEC + (size_t)bh * 64 * 128 + d;
#pragma unroll 8
        for (int c = 0; c < 64; ++c) { const float t = p[(size_t)c * 16384]; p[(size_t)c * 16384] = st; st = dc[c * 128] * st + t; } }
}
__device__ __forceinline__ void hgrn_out_item(LAS unsigned char* lds, const bf16_t* z, const float* lbl, int layer, const float* HS, const float* norm_g, bf16_t* y2, int it) {
    const int b = it >> 8, hh = (it >> 6) & 3, c = it & 63, row0 = b * SEQ + c * 64, tid = otid();
    hgrn_load<true>(lds, z, lbl, layer, row0, hh);
    LAS float* Qm = (LAS float*)(lds + HG_Q); LAS float* Km = (LAS float*)(lds + HG_K); LAS float* Bm = (LAS float*)(lds + HG_B); LAS float* At = (LAS float*)(lds + HG_ATT);
    { const int d8 = (tid & 15) * 8, r0 = tid >> 4;
#pragma unroll
      for (int rr = 0; rr < 2; ++rr) { const int r = r0 + 32 * rr;
#pragma unroll
          for (int e = 0; e < 8; ++e) { const float dl = Bm[r * HG_STR + d8 + e] - Bm[31 * HG_STR + d8 + e];
              Qm[r * HG_STR + d8 + e] *= __builtin_amdgcn_exp2f(dl); Km[r * HG_STR + d8 + e] *= __builtin_amdgcn_exp2f(-dl); } } }
    __syncthreads();
    { const int t = tid >> 3, sg = tid & 7; float a[8];
#pragma unroll
      for (int j = 0; j < 8; ++j) a[j] = 0.f;
      for (int d = 0; d < 128; d += 4) { const f32x4 q = *(const LAS f32x4*)(Qm + t * HG_STR + d);
#pragma unroll
          for (int j = 0; j < 8; ++j) { const int s = sg + 8 * j; if (s <= t) { const f32x4 k = *(const LAS f32x4*)(Km + s * HG_STR + d);
              a[j] += (q[0] * k[0] + q[1] * k[1]) + (q[2] * k[2] + q[3] * k[3]); } } }
#pragma unroll
      for (int j = 0; j < 8; ++j) At[t * 65 + sg + 8 * j] = a[j]; }
    __syncthreads();
    const float* Sg = HS + (size_t)it * 16384;
    f32x4 sreg[4];
#pragma unroll
    for (int i = 0; i < 4; ++i) sreg[i] = *(const f32x4*)(Sg + (size_t)(tid + 512 * i) * 4);
    { const int d8 = (tid & 15) * 8, r0 = tid >> 4;
#pragma unroll
      for (int rr = 0; rr < 2; ++rr) { const int r = r0 + 32 * rr; const u32x4 wv = *(const u32x4*)(z + (size_t)(row0 + r) * NZ + Z_HI + hh * HD + d8); const unsigned wa[4] = {wv.x, wv.y, wv.z, wv.w};
#pragma unroll
          for (int e = 0; e < 8; ++e) { Km[r * HG_STR + d8 + e] = (e & 1) ? bf_hi(wa[e >> 1]) : bf_lo(wa[e >> 1]); Qm[r * HG_STR + d8 + e] *= __builtin_amdgcn_exp2f(Bm[31 * HG_STR + d8 + e]); } } }
    __syncthreads();
    const int wv = __builtin_amdgcn_readfirstlane(tid >> 6), ln = tid & 63, r32 = ln & 31, h2 = ln >> 5, tb = wv >> 2, eb = wv & 3;
    f32x16 oc;
#pragma unroll
    for (int r = 0; r < 16; ++r) oc[r] = 0.f;
#pragma unroll 1
    for (int hf = 0; hf < 2; ++hf) {
#pragma unroll
        for (int i = 0; i < 4; ++i) { const int f4 = tid + 512 * i, dr = f4 >> 5, ec = (f4 & 31) * 4; *(LAS f32x4*)(Bm + dr * HG_STR + ec) = sreg[i]; }
        __syncthreads();
        if (hf == 0) {
#pragma unroll
            for (int i = 0; i < 4; ++i) sreg[i] = *(const f32x4*)(Sg + 8192 + (size_t)(tid + 512 * i) * 4); }
#pragma unroll 8
        for (int kk = 0; kk < 32; ++kk) { const float av = Qm[(32 * tb + r32) * HG_STR + 64 * hf + 2 * kk + h2], bv = Bm[(2 * kk + h2) * HG_STR + 32 * eb + r32];
            oc = __builtin_amdgcn_mfma_f32_32x32x2f32(av, bv, oc, 0, 0, 0); }
        __syncthreads();
    }
#pragma unroll 8
    for (int kk = 0; kk < 32; ++kk) { const float av = At[(32 * tb + r32) * 65 + 2 * kk + h2], bv = Km[(2 * kk + h2) * HG_STR + 32 * eb + r32];
        oc = __builtin_amdgcn_mfma_f32_32x32x2f32(av, bv, oc, 0, 0, 0); }
    { LAS float* red = Bm;
#pragma unroll
      for (int r = 0; r < 16; ++r) { float ss = oc[r] * oc[r];
#pragma unroll
          for (int o = 1; o < 32; o <<= 1) ss += __shfl_xor(ss, o);
          if (r32 == 0) red[(32 * tb + (r & 3) + 8 * (r >> 2) + 4 * h2) * 4 + eb] = ss; }
      __syncthreads();
      const int e = 32 * eb + r32; const float ng = norm_g[hh * HD + e];
#pragma unroll
      for (int r = 0; r < 16; ++r) { const int t = 32 * tb + (r & 3) + 8 * (r >> 2) + 4 * h2; const f32x4 pr = *(const LAS f32x4*)(red + t * 4);
          const float rs = 1.0f / sqrtf(((pr[0] + pr[1]) + (pr[2] + pr[3])) * (1.0f / 128.0f) + EPS);
          const size_t row = (size_t)(row0 + t); const float g = bf2f(z[row * NZ + Z_HG + hh * HD + e]);
          y2[row * BW + hh * HD + e] = (bf16_t)f2bf(oc[r] * rs * ng * g * sigmoidf_(g)); } }
    __syncthreads();
}

__device__ __forceinline__ void wpool_item(const float* pool_w, const float* pool_scale, const float* wb3, bf16_t* dst, int it) {
    const int g = (it >> 5) & 3, c0 = ((it >> 2) & 7) * 16, nn = (it & 3) * 512 + otid();
    float acc[16];
#pragma unroll
    for (int i = 0; i < 16; ++i) acc[i] = 0.f;
    for (int e = 0; e < 128; ++e) { const float wb = wb3[(size_t)(g * 128 + e) * DM + nn] * pool_scale[g * 128 + e];
#pragma unroll
        for (int i = 0; i < 16; ++i) acc[i] += pool_w[((size_t)g * 128 + c0 + i) * 128 + e] * wb; }
    u32x4 w0, w1; w0.x = pk2(acc[0], acc[1]); w0.y = pk2(acc[2], acc[3]); w0.z = pk2(acc[4], acc[5]); w0.w = pk2(acc[6], acc[7]);
    w1.x = pk2(acc[8], acc[9]); w1.y = pk2(acc[10], acc[11]); w1.z = pk2(acc[12], acc[13]); w1.w = pk2(acc[14], acc[15]);
    bf16_t* p = dst + (size_t)nn * BW + g * 128 + c0; *(u32x4*)p = w0; *(u32x4*)(p + 8) = w1;
}

__device__ __forceinline__ void load_wff(LAS float* dst, const float* win) {
    const int tid = otid();
#pragma unroll
    for (int i = 0; i < 4; ++i) { const int k = tid + 512 * i; *(LAS f32x4*)(dst + 4 * k) = *(const f32x4*)(win + (size_t)k * DIN_SRC + FF_SRC_COL); }
    __syncthreads();
}
__device__ __forceinline__ void ff_row(int lane, const bf16_t* hn, const LAS float* wff, float* ff) {
    asm volatile("" : "+v"(lane));
    f32x4 fa = (f32x4){0.f, 0.f, 0.f, 0.f};
#pragma unroll
    for (int j = 0; j < 8; ++j) { const u32x2 w = *(const u32x2*)(hn + 4 * lane + 256 * j); const float y[4] = {bf_lo(w.x), bf_hi(w.x), bf_lo(w.y), bf_hi(w.y)};
#pragma unroll
        for (int e = 0; e < 4; ++e) { const f32x4 wv = *(const LAS f32x4*)(wff + (4 * lane + 256 * j + e) * 4); fa = fa + wv * y[e]; } }
    fa[0] = wave_sum(fa[0]); fa[1] = wave_sum(fa[1]); fa[2] = wave_sum(fa[2]); fa[3] = wave_sum(fa[3]); if (lane == 0) *(f32x4*)ff = fa;
}
constexpr int LDS_BYTES = 147456;
struct LayerW { bf16_t *win, *wbr, *wout, *wxq, *wxkv, *wxo, *wup, *wdn; };
__device__ __forceinline__ LayerW layer_w(unsigned char* ws, int l) {
    LayerW w; unsigned char* p = ws + OFF_W + (size_t)l * SZ_WL;
    w.win = (bf16_t*)p; p += SZ_WIN; w.wbr = (bf16_t*)p; p += SZ_WBR; w.wout = (bf16_t*)p; p += SZ_WOUT; w.wxq = (bf16_t*)p; p += SZ_WXQ;
    w.wxkv = (bf16_t*)p; p += SZ_WXKV; w.wxo = (bf16_t*)p; p += SZ_WXO; w.wup = (bf16_t*)p; p += SZ_WUP; w.wdn = (bf16_t*)p; return w;
}
constexpr int I_INA = 32 * 96, I_INB = 32 * 336, I_BR = 8 * 64, I_OUT = 32 * 64, I_XQ = 32 * 16, I_XKV = 32 * 32, I_XO = 8 * 64, I_UP = 32 * 256, I_DN = 128 * 64;
constexpr int I_LAYER = I_INA + I_INB + 3 * I_BR + I_OUT + I_XQ + I_XKV + I_XO + I_UP + I_DN;
constexpr int TR_TOTAL = 2 * I_LAYER;
constexpr int TR_DEFER_C = 12288, TR_DEFER_A = 3200;
constexpr int TR_P0_END = TR_TOTAL - TR_DEFER_C - TR_DEFER_A, TR_A_END = TR_TOTAL - TR_DEFER_C;
static_assert(TR_P0_END >= I_LAYER + (I_LAYER - I_UP - I_DN), "only layer-1 MLP weights may be deferred");
__device__ __forceinline__ TrItem tr_item(const Params& P, unsigned char* ws, int it, int& ldw_) {
    const int l = it / I_LAYER; int r = it - l * I_LAYER; const LayerW w = layer_w(ws, l);
    const float* src; int K, nc; bf16_t* dst;
    if (r < I_INA) { src = P.w_in + (size_t)l * DM * DIN_SRC; ldw_ = DIN_SRC; K = DM; nc = 3072; dst = w.win; }
    else if ((r -= I_INA) < I_INB) { src = P.w_in + (size_t)l * DM * DIN_SRC + 3076; ldw_ = DIN_SRC; K = DM; nc = 10752; dst = w.win + (size_t)3072 * DM; }
    else if ((r -= I_INB) < 3 * I_BR) { const int n = r / I_BR; r -= n * I_BR; src = P.w_branch + ((size_t)l * 4 + n) * BW * DM; ldw_ = DM; K = BW; nc = DM; dst = w.wbr + (size_t)n * DM * BW; }
    else if ((r -= 3 * I_BR) < I_OUT) { src = P.w_mix_out + (size_t)l * DM * DM; ldw_ = DM; K = DM; nc = DM; dst = w.wout; }
    else if ((r -= I_OUT) < I_XQ) { src = P.xa_wq + (size_t)l * DM * BW; ldw_ = BW; K = DM; nc = BW; dst = w.wxq; }
    else if ((r -= I_XQ) < I_XKV) { src = P.xa_wkv + (size_t)l * DM * 1024; ldw_ = 1024; K = DM; nc = 1024; dst = w.wxkv; }
    else if ((r -= I_XKV) < I_XO) { src = P.xa_wo + (size_t)l * BW * DM; ldw_ = DM; K = BW; nc = DM; dst = w.wxo; }
    else if ((r -= I_XO) < I_UP) { src = P.mlp_w_up + (size_t)l * DM * HID; ldw_ = HID; K = DM; nc = HID; dst = w.wup; }
    else { r -= I_UP; src = P.mlp_w_down + (size_t)l * HID * DM; ldw_ = DM; K = HID; nc = DM; dst = w.wdn; }
    return tr_decode(src, ldw_, K, nc, dst, r);
}
__device__ __forceinline__ void tr_run(const Params& P, unsigned char* ws, LAS float* scr, int lane, int it0, int it_end, int worker, int nworkers) {
    int it = it0 + worker; TrItem cur; cur.src = nullptr; cur.dst = nullptr; cur.K = 0; f32x4 v[8]; int ldw = 0;
    if (it < it_end) { cur = tr_item(P, ws, it, ldw); tr_load(cur, ldw, lane, v); }
#pragma unroll 1
    while (it < it_end) {
        const int nit = it + nworkers; TrItem nx = cur; f32x4 vn[8]; int ldn = 0;
#pragma unroll
        for (int i = 0; i < 8; ++i) vn[i] = v[i];
        if (nit < it_end) { nx = tr_item(P, ws, nit, ldn); tr_load(nx, ldn, lane, vn); }
        tr_process(cur, scr, lane, v);
        it = nit; cur = nx;
#pragma unroll
        for (int i = 0; i < 8; ++i) v[i] = vn[i];
    }
}
#ifndef PHM
#define PHM 0xFFFFFFFFu
#endif
#define GRID_SYNC() do { asm volatile("s_waitcnt vmcnt(0) lgkmcnt(0)" ::: "memory"); __syncthreads(); \
    if (otid() == 0) { __builtin_amdgcn_fence(__ATOMIC_RELEASE, "agent"); asm volatile("s_waitcnt vmcnt(0)" ::: "memory"); \
        bar_gen += 1u; const unsigned target_ = bar_gen * (unsigned)G; \
        __hip_atomic_fetch_add(bar_ctr, 1u, __ATOMIC_RELAXED, __HIP_MEMORY_SCOPE_AGENT); \
        while (__hip_atomic_load(bar_ctr, __ATOMIC_RELAXED, __HIP_MEMORY_SCOPE_AGENT) < target_) __builtin_amdgcn_s_sleep(1); \
        __builtin_amdgcn_fence(__ATOMIC_ACQUIRE, "agent"); asm volatile("s_waitcnt vmcnt(0)" ::: "memory"); } \
    __syncthreads(); } while (0)

__global__ void __launch_bounds__(512, 2) fwd_megakernel(Params P) {
    extern __shared__ __attribute__((aligned(16))) unsigned char lds_raw[];
    LAS unsigned char* lds = (LAS unsigned char*)lds_raw;
    cg::grid_group grid = cg::this_grid();
    unsigned* bar_ctr = (unsigned*)(P.ws + OFF_BAR); unsigned bar_gen = 0u;
    if (blockIdx.x == 0) { unsigned* ctl = (unsigned*)(P.ws + OFF_BAR); const int t_ = otid();
        for (int i = t_; i < (int)(CTL_BYTES / 16); i += 512) *(u32x4*)(ctl + 4 * i) = (u32x4){0u, 0u, 0u, 0u};
        asm volatile("s_waitcnt vmcnt(0)" ::: "memory"); __syncthreads();
        if (t_ < 64) { __builtin_amdgcn_fence(__ATOMIC_RELEASE, "agent"); asm volatile("s_waitcnt vmcnt(0)" ::: "memory"); } __syncthreads(); }
    grid.sync();
    __builtin_amdgcn_fence(__ATOMIC_ACQUIRE, "agent"); asm volatile("s_waitcnt vmcnt(0)" ::: "memory"); __syncthreads();
    const int G = gridDim.x, bx = blockIdx.x, NGW = G * 8;
#define TID_VARS const int tid = otid(), lane = tid & 63, wave = __builtin_amdgcn_readfirstlane(tid >> 6), gw = bx * 8 + wave; (void)lane; (void)gw;
#define WS_PTRS unsigned char* ws = P.ws; asm volatile("" : "+s"(ws)); \
    bf16_t* Z = (bf16_t*)(ws + OFF_Z); bf16_t* HN = (bf16_t*)(ws + OFF_HN); bf16_t* Y = (bf16_t*)(ws + OFF_Y); bf16_t* MIX = (bf16_t*)(ws + OFF_MIX); \
    bf16_t* SRC = (bf16_t*)(ws + OFF_SRC); bf16_t* XQ = (bf16_t*)(ws + OFF_XQ); bf16_t* XO = (bf16_t*)(ws + OFF_XO); \
    float* HS = (float*)(ws + OFF_HS); float* HDEC = (float*)(ws + OFF_HDEC); float* KBAR = (float*)(ws + OFF_KBAR); float* CF = (float*)(ws + OFF_CF); float* FF = (float*)(ws + OFF_FF); \
    bf16_t* MEMN = (bf16_t*)(ws + OFF_MEMN); bf16_t* MEMKV = (bf16_t*)(ws + OFF_MEMKV); (void)Z; (void)HN; (void)Y; (void)MIX; (void)SRC; (void)XQ; (void)XO; (void)HS; (void)HDEC; (void)KBAR; (void)CF; (void)FF; (void)MEMN; (void)MEMKV;
    if (PHM & 1u) {
        WS_PTRS TID_VARS
        LAS float* scr = (LAS float*)(lds + wave * 8448);
        LAS float* wffl = (LAS float*)(lds + 69632);
        load_wff(wffl, P.w_in);
        tr_run(P, ws, scr, lane, 0, (G == 256 ? TR_P0_END : TR_TOTAL), gw, NGW);
#pragma unroll 1
        for (int it = bx; it < 256; it += G) { const int l = it >> 7; const LayerW w = layer_w(ws, l);
            wpool_item(P.pool_w + (size_t)l * 4 * 128 * 128, P.pool_scale + l * BW, P.w_branch + ((size_t)l * 4 + 3) * BW * DM, w.wbr + (size_t)3 * DM * BW, it); }
#pragma unroll 1
        for (int r = gw; r < 1024 + M; r += NGW) {
            if (r < 1024) { const int l = r >> 9, rr = r & 511;
                row_pass(false, true, false, lane, nullptr, nullptr, P.mem + (size_t)rr * DM, nullptr, P.xa_norm_mem + l * DM, MEMN + (size_t)r * DM, nullptr, nullptr); }
            else { const int r2 = r - 1024; row_pass(false, true, true, lane, nullptr, nullptr, P.x + (size_t)r2 * DM, nullptr, P.mix_norm_pre, HN + (size_t)r2 * DM, wffl, FF + (size_t)r2 * 4); }
        }
    }
    GRID_SYNC();

#pragma unroll 1
#ifndef PH_END
#define PH_END (14 * DEPTH)
#endif
    for (int ph = 0; ph < PH_END; ++ph) {
        const int l = ph / 14, k = ph - 14 * l;
        const bool fused_ok = (G >= 256);
        if (fused_ok && (k == 6 || k == 10 || (k == 13 && l + 1 == DEPTH))) continue;
        WS_PTRS TID_VARS
        const LayerW w = layer_w(ws, l);
        const bool is_gemm = (k == 0) | (k == 4) | (k == 5) | (k == 7) | (k == 9) | (k == 11) | (k == 12);
        if (is_gemm && ((PHM >> (k + 1)) & 1u)) {
            const int njobs = (k == 0 && l == 0) ? 1 + DEPTH : 1;
#pragma unroll 1
            for (int job = 0; job < njobs; ++job) {
                pg8::Gemm g; pg8::StaticOrder S; pg8::Epi E; E.G = nullptr; E.ldg = 0; E.MODE = 0;
                E.hold = nullptr; E.hout = nullptr; E.hn = nullptr; E.gpost = nullptr; E.gpre = nullptr; E.xb1 = nullptr; E.xb2 = nullptr; E.cnt1 = nullptr; E.cnt2 = nullptr; E.has_next = 0; E.holdb = nullptr; E.houtb = nullptr;
                int nsub = 1, c0 = 0, ksp = 1, ld = 0; long astr = 0, bstr = 0, ostr = 0; g.M = M;
                if (k == 0 && job == 0) { g.A = HN; g.Bt = w.win; g.N = NZ; g.K = DM; E.O = Z; E.MODE = 4; }
                else if (k == 0) { const int l2 = job - 1; const LayerW w2 = layer_w(ws, l2);
                    g.A = MEMN + (size_t)l2 * 512 * DM; g.Bt = w2.wxkv; g.M = 512; g.N = 1024; g.K = DM; E.O = MEMKV + (size_t)l2 * 512 * 1024; c0 = (G >= 208 ? 192 : 0) + 8 * l2; }
                else if (k == 4) { g.A = Y; g.Bt = w.wbr; g.N = DM; g.K = BW; E.O = MIX; E.G = Z + Z_GL; E.ldg = NZ; E.MODE = 2; nsub = 4; astr = (long)M * BW * 2; bstr = (long)DM * BW * 2; }
                else if (k == 5) { g.A = MIX; g.Bt = w.wout; g.N = DM; g.K = DM; E.O = SRC; }
                else if (k == 7) { g.A = HN; g.Bt = w.wxq; g.N = BW; g.K = BW; ld = DM; E.O = MIX; ksp = 4; astr = BW * 2; bstr = BW * 2; ostr = (long)M * BW; }
                else if (k == 9) { g.A = XO; g.Bt = w.wxo; g.N = DM; g.K = BW; E.O = SRC; }
                else if (k == 11) { g.A = HN; g.Bt = w.wup; g.N = HID; g.K = DM; E.O = Z; E.MODE = 1; }
                else { g.A = Z; g.Bt = w.wdn; g.N = DM; g.K = HID; E.O = SRC; }
                if (fused_ok && (k == 5 || k == 9 || k == 12)) { const int gi = (k == 5) ? 0 : (k == 9) ? 1 : 2;
                    E.MODE = 3; E.hold = P.x; E.holdb = (l == 0 && k == 5) ? nullptr : SRC; E.houtb = SRC; E.hout = P.out; E.hn = HN; E.has_next = !(k == 12 && l + 1 == DEPTH);
                    E.gpost = (k == 5 ? P.mix_norm_post : k == 9 ? P.xa_norm_post : P.mlp_norm_post) + l * DM;
                    E.gpre = (k == 5 ? P.xa_norm_pre + l * DM : k == 9 ? P.mlp_norm_pre + l * DM : P.mix_norm_pre + (l + 1 < DEPTH ? l + 1 : 0) * DM);
                    E.xb1 = (float*)(ws + OFF_XB); E.xb2 = E.xb1 + (size_t)M * 8;
                    E.cnt1 = (unsigned*)(ws + OFF_BAR + 4096) + (size_t)(((l * 3 + gi) * 2 + 0) * 32) * 64; E.cnt2 = E.cnt1 + 32 * 64; }
                E.ldc = g.N; g.lda = ld ? ld : g.K; g.ldb = ld ? ld : g.K;
                S.init(g.M, g.N, G, bx, nsub, astr, bstr, c0, ksp, ostr);
                pg8::gemm_phase(lds, g, S, E);
            }
            if (k == 0 && l == 0 && G == 256 && bx >= 216) tr_run(P, ws, (LAS float*)(lds + wave * 8448), lane, TR_P0_END, TR_A_END, (bx - 216) * 8 + wave, 40 * 8);
            if (k == 0) { const int cb = (G >= 216) ? 208 : 0; if (bx >= cb && bx < cb + 8) cumsum_item(lds, FF, P.fox_f_bias + l * NH, CF, bx - cb); }
        } else if (k == 1 && (PHM & 4u)) {
#pragma unroll 1
            for (int it = bx; it < 1160; it += G) {
                if (it < 256) rope_item(lds, Z, KBAR, it);
                else if (it < 264) { }
                else if (it < 776) hgrn_local_item(lds, Z, P.lb_logits, l, HS, HDEC, it - 264);
                else if (it < 1032) pool_item(Z, Y + (size_t)3 * M * BW, it - 776);
                else kmax_item(Z, (unsigned*)(ws + OFF_BAR + 2048) + l * 8, it - 1032);
            }
        } else if (k == 2 && (PHM & 8u)) {
#pragma unroll 1
            for (int p = bx; p < 256; p += G) {
                const int xcd_ = p & 7, idx_ = p >> 3, g_ = 2 * xcd_ + (idx_ >> 4);
                const int type = g_ >> 3, bh = g_ & 7, s = idx_ & 15, b = bh >> 2, hh = bh & 3;
                const bf16_t* zb = Z + (size_t)b * SEQ * NZ + hh * HD;
#pragma unroll 1
                for (int kk = 0; kk < 2; ++kk) { const int qi = kk ? s : 31 - s;
                    if (type == 0) attn_unit<0>(lds, zb + Z_MQ, NZ, zb + Z_MK, zb + Z_MV, NZ, Y + (size_t)b * SEQ * BW + hh * HD, BW, qi * 128, 2 * qi + 2, nullptr, KBAR + (size_t)bh * 2048);
                    else attn_unit<1>(lds, zb + Z_FQ, NZ, zb + Z_FK, zb + Z_FV, NZ, Y + (size_t)M * BW + (size_t)b * SEQ * BW + hh * HD, BW, qi * 128, 2 * qi + 2, CF + (size_t)bh * SEQ, nullptr, 0, (const unsigned*)(ws + OFF_BAR + 2048) + l * 8 + bh); }
            }
            if (G == 256) { if ((bx & 7) >= 4) { const int fidx = ((bx & 7) - 4) * 32 + (bx >> 3);
                hgrn_scan(HS, HDEC, fidx * 512 + tid, 128 * 512);
                if (l == 0) tr_run(P, ws, (LAS float*)(lds + wave * 8448), lane, TR_A_END, TR_TOTAL, fidx * 8 + wave, 128 * 8); } }
            else hgrn_scan(HS, HDEC, bx * 512 + tid, G * 512);
        } else if (k == 3 && (PHM & 16u)) {
#pragma unroll 1
            for (int it = bx; it < 512; it += G) hgrn_out_item(lds, Z, P.lb_logits, l, HS, P.hgrn_out_norm + l * BW, Y + (size_t)2 * M * BW, it);
        } else if (k == 8 && (PHM & 512u)) {
#pragma unroll 1
            for (int p = bx; p < 256; p += G) { const int b = p >> 7, hh = (p >> 5) & 3, qi = p & 31;
                const bf16_t* kv = MEMKV + ((size_t)l * 512 + b * NMEM) * 1024 + hh * HD;
                attn_unit<2>(lds, MIX + (size_t)b * SEQ * BW + hh * HD, BW, kv, kv + 512, 1024, XO + (size_t)b * SEQ * BW + hh * HD, BW, qi * 128, 4, nullptr, nullptr, (size_t)M * BW); }
        } else if (fused_ok && k == 13) {
            load_wff((LAS float*)lds, P.w_in + (size_t)(l + 1) * DM * DIN_SRC);
#pragma unroll 1
            for (int r = gw; r < M; r += NGW) ff_row(lane, HN + (size_t)r * DM, (const LAS float*)lds, FF + (size_t)r * 4);
        } else if ((k == 6 || k == 10 || k == 13) && (PHM & 64u)) {
            const float* gpost = (k == 6 ? P.mix_norm_post : k == 10 ? P.xa_norm_post : P.mlp_norm_post) + l * DM;
            const float* gpre = (k == 6 ? P.xa_norm_pre + l * DM : k == 10 ? P.mlp_norm_pre + l * DM : P.mix_norm_pre + (l + 1 < DEPTH ? l + 1 : 0) * DM);
            const float* hin = (l == 0 && k == 6) ? P.x : P.out;
            const bool has_next = !(k == 13 && l + 1 == DEPTH), has_ff = (k == 13) && has_next;
            if (has_ff) load_wff((LAS float*)lds, P.w_in + (size_t)(l + 1 < DEPTH ? l + 1 : 0) * DM * DIN_SRC);
#pragma unroll 1
            for (int r = gw; r < M; r += NGW)
                row_pass(true, has_next, has_ff, lane, SRC + (size_t)r * DM, gpost, hin + (size_t)r * DM, P.out + (size_t)r * DM, gpre, HN + (size_t)r * DM, (const LAS float*)lds, FF + (size_t)r * 4);
        }
        if (ph + 1 < (fused_ok ? 14 * DEPTH - 1 : 14 * DEPTH)) GRID_SYNC();
    }
#ifdef DBG_OFF
    { const bf16_t* dbg = (const bf16_t*)(P.ws + DBG_OFF); const int t0 = bx * 512 + otid();
      for (size_t i = t0; i < (size_t)M * DM; i += (size_t)G * 512) P.out[i] = i < (size_t)(DBG_LEN) ? bf2f(dbg[i]) : 0.f; }
#endif
}

extern "C" void kernel_launch(void* const* d_in, const int* in_sizes, int n_in, void* d_out, int out_size, void* d_ws, size_t ws_size, hipStream_t stream) {
    static int grid_blocks = 0;
    if (grid_blocks == 0) {
        if (n_in != 22 || ws_size < WS_END) { fprintf(stderr, "kernel_launch: unexpected inputs (n_in %d, ws %zu, need %zu)\n", n_in, ws_size, (size_t)WS_END); grid_blocks = -1; return; }
        int dev = 0, cus = 0, per_cu = 0;
        (void)hipGetDevice(&dev); (void)hipDeviceGetAttribute(&cus, hipDeviceAttributeMultiprocessorCount, dev);
        (void)hipFuncSetAttribute((const void*)fwd_megakernel, hipFuncAttributeMaxDynamicSharedMemorySize, LDS_BYTES);
        (void)hipOccupancyMaxActiveBlocksPerMultiprocessor(&per_cu, (const void*)fwd_megakernel, 512, LDS_BYTES);
        if (per_cu < 1) fprintf(stderr, "kernel_launch: occupancy query says %d blocks per CU\n", per_cu);
        (void)hipGetLastError();
        grid_blocks = cus > 0 ? cus : 256;
    }
    if (grid_blocks < 0) return;
    Params p{};
    const float** pp = (const float**)&p;
    for (int i = 0; i < 22; ++i) pp[i] = (const float*)d_in[i];
    p.out = (float*)d_out; p.ws = (unsigned char*)d_ws;
    void* args[] = {&p};
    hipError_t e = hipLaunchCooperativeKernel((const void*)fwd_megakernel, dim3(grid_blocks), dim3(512), args, LDS_BYTES, stream);
    if (e != hipSuccess) fprintf(stderr, "cooperative launch failed: %s (grid %d)\n", hipGetErrorString(e), grid_blocks);
}
```
